# Optimizing an MI355X kernel written in HIP

```python
import jax, jax.numpy as jnp
from jax import lax
import numpy as np

D_MODEL = 1024
BATCH = 32
SEQ = 2048
DEPTH = 2

N_HEADS = 8
HEAD_DIM = 64
KV_LATENT = 128
ATTN_SCALE = HEAD_DIM ** -0.5
IDX_HEADS = 8
IDX_DIM = 64
IDX_SCALE = (IDX_HEADS ** -0.5) * (IDX_DIM ** -0.5)
TOPK_MAX = 256
Q_BLOCK = 128
POOL_WINDOWS = (2, 4, 8, 16)
POOL_GROUP = 128
POOL_WIDTH = POOL_GROUP * len(POOL_WINDOWS)
D_FF = 2816
EPS = 1e-6
SPLITS = (N_HEADS * HEAD_DIM, KV_LATENT, IDX_HEADS * IDX_DIM, IDX_DIM, IDX_HEADS, POOL_WIDTH, D_MODEL, D_MODEL)
D_IN = sum(SPLITS)

kernel_name = 'hybrid_dsa_pool_macaron'


def rms_norm(x, g):
    xf = x.astype(jnp.float32)
    y = xf * lax.rsqrt(jnp.mean(xf * xf, axis=-1, keepdims=True) + EPS)
    return (y * g.astype(jnp.float32)).astype(x.dtype)


def swiglu(h, wg, wu, wd):
    return (jax.nn.silu(h @ wg) * (h @ wu)) @ wd


def dsa_attention(q_lat, c_kv, q_idx, k_idx, w_idx):
    B, T = c_kv.shape[0], c_kv.shape[1]
    k_sel = min(TOPK_MAX, T // 4)
    n_blk = T // Q_BLOCK
    key_pos = jnp.arange(T, dtype=jnp.int32)

    def to_blocks(a):
        return jnp.moveaxis(a.reshape((B, n_blk, Q_BLOCK) + a.shape[2:]), 1, 0)

    def one_block(args):
        ql, qi, wi, start = args
        q_pos = start + jnp.arange(Q_BLOCK, dtype=jnp.int32)
        causal = key_pos[None, :] <= q_pos[:, None]
        rel = jax.nn.relu(jnp.einsum('bqjd,bsd->bqjs', qi, k_idx).astype(jnp.float32))
        score = jnp.einsum('bqjs,bqj->bqs', rel, wi.astype(jnp.float32))
        score = jnp.where(causal[None], score, -jnp.inf)
        _, idx = lax.top_k(score, k_sel)
        valid = idx <= q_pos[None, :, None]
        c_sel = jax.vmap(lambda c, i: c[i])(c_kv, idx)
        logits = jnp.einsum('bqhc,bqkc->bqhk', ql, c_sel).astype(jnp.float32) * ATTN_SCALE
        logits = jnp.where(valid[:, :, None, :], logits, -jnp.inf)
        p = jax.nn.softmax(logits, axis=-1).astype(c_sel.dtype)
        return jnp.einsum('bqhk,bqkc->bqhc', p, c_sel)

    starts = jnp.arange(n_blk, dtype=jnp.int32) * Q_BLOCK
    o = lax.map(one_block, (to_blocks(q_lat), to_blocks(q_idx), to_blocks(w_idx), starts))
    return jnp.moveaxis(o, 0, 1).reshape(B, T, N_HEADS, KV_LATENT)


def multiscale_pool(p):
    B, T = p.shape[0], p.shape[1]
    pf = p.astype(jnp.float32).reshape(B, T, len(POOL_WINDOWS), POOL_GROUP)
    cs = jnp.cumsum(pf, axis=1)
    t1 = jnp.arange(1, T + 1, dtype=jnp.float32)
    outs = []
    for g, w in enumerate(POOL_WINDOWS):
        c = cs[:, :, g]
        lag = jnp.pad(c, ((0, 0), (w, 0), (0, 0)))[:, :T]
        cnt = jnp.minimum(t1, float(w))[None, :, None]
        outs.append((c - lag) / cnt - pf[:, :, g])
    return jnp.stack(outs, axis=2).astype(p.dtype)


def setup_inputs(seed: int = 0) -> dict:
    key = jax.random.key(seed)
    ks = jax.random.split(key, 24)
    f32 = jnp.float32

    def nrm(k, shape, fan_in):
        return jax.random.normal(k, shape, f32) * (fan_in ** -0.5)

    def gain(k, shape):
        return 1.0 + 0.05 * jax.random.normal(k, shape, f32)

    G = len(POOL_WINDOWS)
    return {
        'x': jax.random.normal(ks[0], (BATCH, SEQ, D_MODEL), f32),
        'norm_ffn1': gain(ks[1], (DEPTH, D_MODEL)),
        'ffn1_gate': nrm(ks[2], (DEPTH, D_MODEL, D_FF), D_MODEL),
        'ffn1_up': nrm(ks[3], (DEPTH, D_MODEL, D_FF), D_MODEL),
        'ffn1_down': nrm(ks[4], (DEPTH, D_FF, D_MODEL), D_FF),
        'norm_mix': gain(ks[5], (DEPTH, D_MODEL)),
        'w_in': nrm(ks[6], (DEPTH, D_MODEL, D_IN), D_MODEL),
        'norm_kv': gain(ks[7], (DEPTH, KV_LATENT)),
        'w_uk': nrm(ks[8], (DEPTH, KV_LATENT, N_HEADS, HEAD_DIM), KV_LATENT),
        'w_uv': nrm(ks[9], (DEPTH, KV_LATENT, N_HEADS, HEAD_DIM), KV_LATENT),
        'pool_w': nrm(ks[10], (DEPTH, G, POOL_GROUP, POOL_GROUP), POOL_GROUP),
        'pool_scale': gain(ks[11], (DEPTH, POOL_WIDTH)),
        'w_branch_attn': nrm(ks[12], (DEPTH, N_HEADS * HEAD_DIM, D_MODEL), N_HEADS * HEAD_DIM),
        'w_branch_pool': nrm(ks[13], (DEPTH, POOL_WIDTH, D_MODEL), POOL_WIDTH),
        'w_out': nrm(ks[14], (DEPTH, D_MODEL, D_MODEL), D_MODEL),
        'norm_ffn2': gain(ks[15], (DEPTH, D_MODEL)),
        'ffn2_gate': nrm(ks[16], (DEPTH, D_MODEL, D_FF), D_MODEL),
        'ffn2_up': nrm(ks[17], (DEPTH, D_MODEL, D_FF), D_MODEL),
        'ffn2_down': nrm(ks[18], (DEPTH, D_FF, D_MODEL), D_FF),
        'norm_final': gain(ks[19], (D_MODEL,)),
    }


def reference(x, norm_ffn1, ffn1_gate, ffn1_up, ffn1_down, norm_mix, w_in, norm_kv, w_uk, w_uv,
              pool_w, pool_scale, w_branch_attn, w_branch_pool, w_out, norm_ffn2, ffn2_gate,
              ffn2_up, ffn2_down, norm_final):
    B, T = x.shape[0], x.shape[1]
    cuts = np.cumsum(SPLITS)[:-1].tolist()
    for i in range(DEPTH):
        h = rms_norm(x, norm_ffn1[i])
        x = x + 0.5 * swiglu(h, ffn1_gate[i], ffn1_up[i], ffn1_down[i])

        h = rms_norm(x, norm_mix[i])
        z = h @ w_in[i]
        q, c_kv, q_idx, k_idx, w_idx, pool_in, gate_a, gate_b = jnp.split(z, cuts, axis=-1)

        q = q.reshape(B, T, N_HEADS, HEAD_DIM)
        c_kv = rms_norm(c_kv, norm_kv[i])
        q_lat = jnp.einsum('bthd,chd->bthc', q, w_uk[i])
        q_idx = q_idx.reshape(B, T, IDX_HEADS, IDX_DIM)
        o_lat = dsa_attention(q_lat, c_kv, q_idx, k_idx, w_idx * IDX_SCALE)
        attn = jnp.einsum('bthc,chd->bthd', o_lat, w_uv[i]).reshape(B, T, N_HEADS * HEAD_DIM)

        pooled = multiscale_pool(pool_in)
        mixed = jnp.einsum('btgc,gcd->btgd', pooled, pool_w[i]).reshape(B, T, POOL_WIDTH) * pool_scale[i]

        merged = (jax.nn.sigmoid(gate_a) * (attn @ w_branch_attn[i])
                  + jax.nn.sigmoid(gate_b) * (mixed @ w_branch_pool[i]))
        x = x + merged @ w_out[i]

        h = rms_norm(x, norm_ffn2[i])
        x = x + 0.5 * swiglu(h, ffn2_gate[i], ffn2_up[i], ffn2_down[i])
    return rms_norm(x, norm_final)
```

```cpp
#include <hip/hip_runtime.h>
#include <cstdio>
#include <cstdint>
#include <cmath>
namespace pg8 {
#define PG8_LAS __attribute__((address_space(3)))
typedef unsigned short bf16_t;
typedef short bf16x8 __attribute__((ext_vector_type(8)));
typedef float f32x4 __attribute__((ext_vector_type(4)));
typedef unsigned u32x4 __attribute__((ext_vector_type(4)));
constexpr int BM = 256, BK = 64, HALF = 128, HTB = HALF * BK * 2  , STAGE_BYTES = 8 * HTB, NXCD = 8, WGM = 8;

__host__ __device__ __forceinline__ int lds_byte(int r, int c) { const int st = (r >> 4) * 2 + (c >> 5), rr = r & 15, cc = c & 31, ob = rr * 64 + cc * 2; return st * 1024 + (ob ^ (((ob >> 9) & 1) << 5)); }
__host__ __device__ __forceinline__ void stage_rc(int b, int& R, int& C) { const int st = b / 1024, sb = b % 1024, swz = sb ^ (((sb >> 9) & 1) << 5); R = (st >> 1) * 16 + swz / 64; C = (st & 1) * 32 + (swz % 64) / 2; }
__host__ __device__ __forceinline__ int perm32(int rho) { const int n = rho >> 4, i = rho & 15; return 8 * (i >> 2) + 4 * n + (i & 3); }

struct Unit { int pm, pn; };
struct Gemm { const bf16_t* A; const bf16_t* Bt; int M, N, K; };

struct StaticOrder {
    int nM, nN, nwg, G, c;
    __host__ __device__ void init(int M, int N, int G_, int c_) { nM = M / BM; nN = N / BM; nwg = nM * nN; G = G_; c = c_; }
    __host__ __device__ bool next(int i, Unit& u) const {
        const long L = (long)i * G + c; if (L >= nwg) return false;
        int wgid = (int)L; { const int q = nwg / NXCD, r = nwg % NXCD, xcd = wgid % NXCD, off = wgid / NXCD; wgid = (xcd < r ? xcd * (q + 1) : r * (q + 1) + (xcd - r) * q) + off; }
        const int nig = WGM * nN, gid = wgid / nig, fm = gid * WGM, gsz = (nM - fm) < WGM ? (nM - fm) : WGM;
        u.pm = fm + ((wgid % nig) % gsz); u.pn = (wgid % nig) / gsz; return true;
    }
    __device__ __forceinline__ void a_ready(const Unit&) const {}
    __device__ __forceinline__ void done(const Unit&) const {}
};

__device__ __forceinline__ unsigned cvt_pk_bf16(float lo, float hi) { unsigned r; asm volatile("v_cvt_pk_bf16_f32 %0, %1, %2" : "=v"(r) : "v"(lo), "v"(hi)); return r; }
typedef float f32x2 __attribute__((ext_vector_type(2)));
typedef __bf16 bf16x2_t __attribute__((ext_vector_type(2)));
__device__ __forceinline__ unsigned pk_bf16(float lo, float hi) { f32x2 v = {lo, hi}; bf16x2_t b = __builtin_convertvector(v, bf16x2_t); return __builtin_bit_cast(unsigned, b); }
__device__ __forceinline__ float sigm(float g) { return __builtin_amdgcn_rcpf(1.0f + __builtin_amdgcn_exp2f(-1.4426950408889634f * g)); }
__device__ __forceinline__ float bf_lo(unsigned w) { return __uint_as_float(w << 16); }
__device__ __forceinline__ float bf_hi(unsigned w) { return __uint_as_float(w & 0xffff0000u); }

struct EpiPlainBf16 {
    static constexpr bool PERM = true, AFTER_DRAIN = false;
    bf16_t* O; int ldc;
    __device__ __forceinline__ void operator()(const f32x4 (&acc)[2][2][4][2], const Unit& u, int wr, int wc, int fr, int fq) const {
        const int row0 = u.pm * BM + wr * 64 + fr, col0 = u.pn * BM + wc * 32 + 8 * fq;
#pragma unroll
        for (int ai = 0; ai < 2; ++ai)
#pragma unroll
            for (int m = 0; m < 4; ++m) { bf16_t* rowp = O + (size_t)(row0 + ai * HALF + m * 16) * ldc + col0;
#pragma unroll
                for (int bj = 0; bj < 2; ++bj) { const f32x4 v0 = acc[ai][bj][m][0], v1 = acc[ai][bj][m][1];
                    u32x4 w; w.x = pk_bf16(v0[0], v0[1]); w.y = pk_bf16(v0[2], v0[3]); w.z = pk_bf16(v1[0], v1[1]); w.w = pk_bf16(v1[2], v1[3]);
                    *(u32x4*)(rowp + bj * HALF) = w; } }
    }
};
struct EpiSwiglu {
    static constexpr bool PERM = true, AFTER_DRAIN = false;
    bf16_t* O; int ldc;
    __device__ __forceinline__ void operator()(const f32x4 (&acc)[2][2][4][2], const Unit& u, int wr, int wc, int fr, int fq) const {
        const int row0 = u.pm * BM + wr * 64 + fr, col0 = u.pn * HALF + wc * 32 + 8 * fq;
#pragma unroll
        for (int ai = 0; ai < 2; ++ai)
#pragma unroll
            for (int m = 0; m < 4; ++m) { bf16_t* rowp = O + (size_t)(row0 + ai * HALF + m * 16) * ldc + col0;
                f32x4 h0, h1;
#pragma unroll
                for (int j = 0; j < 4; ++j) { const float g0 = acc[ai][0][m][0][j], g1 = acc[ai][0][m][1][j];
                    h0[j] = g0 * sigm(g0) * acc[ai][1][m][0][j]; h1[j] = g1 * sigm(g1) * acc[ai][1][m][1][j]; }
                u32x4 w; w.x = pk_bf16(h0[0], h0[1]); w.y = pk_bf16(h0[2], h0[3]); w.z = pk_bf16(h1[0], h1[1]); w.w = pk_bf16(h1[2], h1[3]);
                *(u32x4*)rowp = w; }
    }
};
struct EpiResid {
    static constexpr bool PERM = false, AFTER_DRAIN = false;
    const float* base; float* out; int ldc; float scale;
    __device__ __forceinline__ void operator()(const f32x4 (&acc)[2][2][4][2], const Unit& u, int wr, int wc, int fr, int fq) const {
        const int row0 = u.pm * BM + wr * 64 + fr, col0 = u.pn * BM + wc * 32 + 4 * fq;
#pragma unroll
        for (int ai = 0; ai < 2; ++ai)
#pragma unroll
            for (int m = 0; m < 4; ++m) { const size_t off = (size_t)(row0 + ai * HALF + m * 16) * ldc + col0;
#pragma unroll
                for (int bj = 0; bj < 2; ++bj)
#pragma unroll
                    for (int n = 0; n < 2; ++n) { const f32x4 bs = *(const f32x4*)(base + off + bj * HALF + n * 16); *(f32x4*)(out + off + bj * HALF + n * 16) = bs + acc[ai][bj][m][n] * scale; }
                asm volatile("" ::: "memory"); }
    }
};
template <bool ADD> struct EpiGate {
    static constexpr bool PERM = true, AFTER_DRAIN = false;
    bf16_t* O; int ldc; const bf16_t* G; int ldg;
    __device__ __forceinline__ void operator()(const f32x4 (&acc)[2][2][4][2], const Unit& u, int wr, int wc, int fr, int fq) const {
        const int row0 = u.pm * BM + wr * 64 + fr, col0 = u.pn * BM + wc * 32 + 8 * fq;
#pragma unroll
        for (int ai = 0; ai < 2; ++ai)
#pragma unroll
            for (int m = 0; m < 4; ++m) { const size_t r = (size_t)(row0 + ai * HALF + m * 16);
#pragma unroll
                for (int bj = 0; bj < 2; ++bj) { const f32x4 v0 = acc[ai][bj][m][0], v1 = acc[ai][bj][m][1];
                    const u32x4 g = *(const u32x4*)(G + r * ldg + col0 + bj * HALF);
                    float r0 = sigm(bf_lo(g.x)) * v0[0], r1 = sigm(bf_hi(g.x)) * v0[1], r2 = sigm(bf_lo(g.y)) * v0[2], r3 = sigm(bf_hi(g.y)) * v0[3];
                    float r4 = sigm(bf_lo(g.z)) * v1[0], r5 = sigm(bf_hi(g.z)) * v1[1], r6 = sigm(bf_lo(g.w)) * v1[2], r7 = sigm(bf_hi(g.w)) * v1[3];
                    bf16_t* op = O + r * ldc + col0 + bj * HALF;
                    if (ADD) { const u32x4 o = *(const u32x4*)op; r0 += bf_lo(o.x); r1 += bf_hi(o.x); r2 += bf_lo(o.y); r3 += bf_hi(o.y); r4 += bf_lo(o.z); r5 += bf_hi(o.z); r6 += bf_lo(o.w); r7 += bf_hi(o.w); }
                    u32x4 w; w.x = pk_bf16(r0, r1); w.y = pk_bf16(r2, r3); w.z = pk_bf16(r4, r5); w.w = pk_bf16(r6, r7);
                    *(u32x4*)op = w; }
                asm volatile("" ::: "memory"); }
    }
};

template <class Epi, class Sched, bool ALIGN_EPI = false, bool SP2 = false>
__device__ __forceinline__ void gemm_phase(PG8_LAS unsigned char* lds, const Gemm g, const Sched& S, const Epi& E) {
    int tid_o = threadIdx.x; asm volatile("" : "+v"(tid_o));
    const int tid = tid_o, wid = __builtin_amdgcn_readfirstlane(tid >> 6), lane = tid & 63, wr = wid >> 2, wc = wid & 3, fr = lane & 15, fq = lane >> 4;
    const int K = g.K, nt = K / BK;
    unsigned voffA[2], voffB[2];
#pragma unroll
    for (int i = 0; i < 2; ++i) { int R, C; stage_rc(tid * 16 + i * 8192, R, C); const int Rb = Epi::PERM ? ((R & ~31) + perm32(R & 31)) : R;
        voffA[i] = (unsigned)(R * K + C) * 2u; voffB[i] = (unsigned)(Rb * K + C) * 2u; }
    const size_t kstep = (size_t)(BK * 2);
    const size_t hstep = (size_t)HALF * K * 2;
    const size_t tstep = 2 * hstep;
    const unsigned ldsw = (unsigned)wid * 1024u;
    const int aoff = lds_byte(wr * 64 + fr, fq * 8), boff = lds_byte(wc * 32 + fr, fq * 8);
#define PG8_SA(b, h) (((b) * 2 + (h)) * HTB)
#define PG8_SB(b, h) ((4 + (b) * 2 + (h)) * HTB)
#define PG8_STAGE(bufoff, gbase, voff) do { _Pragma("unroll") for (int _i = 0; _i < 2; ++_i) \
        __builtin_amdgcn_global_load_lds((const unsigned*)((const char*)(gbase) + (voff)[_i]), (PG8_LAS unsigned*)(lds + (bufoff) + ldsw + _i * 8192), 16, 0, 0); } while (0)
#define PG8_LDA(dst, b, h) do { _Pragma("unroll") for (int m = 0; m < 4; ++m) _Pragma("unroll") for (int k = 0; k < 2; ++k) dst[m][k] = *(const PG8_LAS bf16x8*)(lds + PG8_SA(b, h) + aoff + m * 2048 + k * 1024); } while (0)
#define PG8_LDB(dst, b, h) do { _Pragma("unroll") for (int n = 0; n < 2; ++n) _Pragma("unroll") for (int k = 0; k < 2; ++k) dst[n][k] = *(const PG8_LAS bf16x8*)(lds + PG8_SB(b, h) + boff + n * 2048 + k * 1024); } while (0)
#define PG8_MMA(ai, bj, At, Bt) do { __builtin_amdgcn_s_setprio(1); _Pragma("unroll") for (int m = 0; m < 4; ++m) _Pragma("unroll") for (int n = 0; n < 2; ++n) _Pragma("unroll") for (int k = 0; k < 2; ++k) \
        acc[ai][bj][m][n] = __builtin_amdgcn_mfma_f32_16x16x32_bf16(Bt[n][k], At[m][k], acc[ai][bj][m][n], 0, 0, 0); __builtin_amdgcn_s_setprio(0); } while (0)
#define PG8_WAIT_V(n) asm volatile("s_waitcnt vmcnt(" #n ")" ::: "memory")
#define PG8_WAIT_L(n) asm volatile("s_waitcnt lgkmcnt(" #n ")" ::: "memory")
#define PG8_BAR __builtin_amdgcn_s_barrier()
#define PG8_SCHED __builtin_amdgcn_sched_barrier(0)
    Unit cur, nxt; int ui = 0;
    if (!S.next(0, cur)) return;
    f32x4 acc[2][2][4][2];
#pragma unroll
    for (int a = 0; a < 2; ++a)
#pragma unroll
        for (int b = 0; b < 2; ++b)
#pragma unroll
            for (int m = 0; m < 4; ++m)
#pragma unroll
                for (int n = 0; n < 2; ++n) acc[a][b][m][n] = (f32x4){0.f, 0.f, 0.f, 0.f};
    bf16x8 At[4][2], B0[2][2], B1[2][2];
    const char* cA = (const char*)g.A + (size_t)cur.pm * tstep; const char* cB = (const char*)g.Bt + (size_t)cur.pn * tstep;
    S.a_ready(cur);
    if constexpr (SP2) {
        PG8_STAGE(PG8_SB(0, 0), cB, voffB); PG8_STAGE(PG8_SB(0, 1), cB + hstep, voffB); PG8_STAGE(PG8_SA(0, 0), cA, voffA); PG8_STAGE(PG8_SA(0, 1), cA + hstep, voffA);
        if (wr == 1) PG8_BAR;
        PG8_WAIT_V(2); PG8_BAR;
        PG8_STAGE(PG8_SB(1, 0), cB + kstep, voffB); PG8_STAGE(PG8_SA(1, 0), cA + kstep, voffA); PG8_STAGE(PG8_SB(1, 1), cB + hstep + kstep, voffB);
        PG8_WAIT_V(6); PG8_BAR;
    } else {
        PG8_STAGE(PG8_SB(0, 0), cB, voffB); PG8_STAGE(PG8_SA(0, 0), cA, voffA); PG8_STAGE(PG8_SB(0, 1), cB + hstep, voffB); PG8_STAGE(PG8_SA(0, 1), cA + hstep, voffA);
        if (wr == 1) PG8_BAR;
        PG8_WAIT_V(4); PG8_BAR;
        PG8_STAGE(PG8_SB(1, 0), cB + kstep, voffB); PG8_STAGE(PG8_SA(1, 0), cA + kstep, voffA); PG8_STAGE(PG8_SB(1, 1), cB + hstep + kstep, voffB);
        PG8_WAIT_V(6); PG8_BAR;
    }
    for (;;) {
        const bool has_next = S.next(ui + 1, nxt);
        const char* nA = has_next ? (const char*)g.A + (size_t)nxt.pm * tstep : cA; const char* nB = has_next ? (const char*)g.Bt + (size_t)nxt.pn * tstep : cB;
        for (int t = 0; t < nt; t += 2) {
            const bool last = (t == nt - 2);
            const char* a1 = cA + (size_t)(t + 1) * kstep;
            const char* a2 = last ? nA : cA + (size_t)(t + 2) * kstep; const char* b2 = last ? nB : cB + (size_t)(t + 2) * kstep;
            const char* a3 = a2 + kstep; const char* b3 = b2 + kstep;
            if (last && has_next) S.a_ready(nxt);
            if constexpr (SP2) {
            PG8_LDB(B0, 0, 0); PG8_LDB(B1, 0, 1); PG8_SCHED; PG8_LDA(At, 0, 0); PG8_STAGE(PG8_SA(1, 1), a1 + hstep, voffA);
            PG8_WAIT_V(8); PG8_WAIT_L(0); PG8_BAR; PG8_MMA(0, 0, At, B0); PG8_MMA(0, 1, At, B1); PG8_BAR; PG8_SCHED;
            PG8_LDA(At, 0, 1); PG8_STAGE(PG8_SB(0, 0), b2, voffB); PG8_STAGE(PG8_SB(0, 1), b2 + hstep, voffB); PG8_STAGE(PG8_SA(0, 0), a2, voffA);
            PG8_WAIT_V(8); PG8_WAIT_L(0); PG8_BAR; PG8_MMA(1, 0, At, B0); PG8_MMA(1, 1, At, B1); PG8_BAR; PG8_SCHED;
            PG8_LDB(B0, 1, 0); PG8_LDB(B1, 1, 1); PG8_SCHED; PG8_LDA(At, 1, 0); PG8_STAGE(PG8_SA(0, 1), a2 + hstep, voffA);
            PG8_WAIT_V(8); PG8_WAIT_L(0); PG8_BAR; PG8_MMA(0, 0, At, B0); PG8_MMA(0, 1, At, B1); PG8_BAR; PG8_SCHED;
            PG8_LDA(At, 1, 1); PG8_STAGE(PG8_SB(1, 0), b3, voffB); PG8_STAGE(PG8_SB(1, 1), b3 + hstep, voffB); PG8_STAGE(PG8_SA(1, 0), a3, voffA);
            PG8_WAIT_V(8); PG8_WAIT_L(0); PG8_BAR; PG8_MMA(1, 0, At, B0); PG8_MMA(1, 1, At, B1); PG8_BAR; PG8_SCHED;
            } else {
            PG8_LDB(B0, 0, 0); PG8_SCHED; PG8_LDA(At, 0, 0); PG8_STAGE(PG8_SA(1, 1), a1 + hstep, voffA);
            PG8_WAIT_L(8); PG8_BAR; PG8_WAIT_L(0); PG8_MMA(0, 0, At, B0); PG8_BAR; PG8_SCHED;
            PG8_LDB(B1, 0, 1); PG8_STAGE(PG8_SB(0, 0), b2, voffB);
            PG8_BAR; PG8_WAIT_L(0); PG8_MMA(0, 1, At, B1); PG8_BAR;
            PG8_LDA(At, 0, 1); PG8_STAGE(PG8_SA(0, 0), a2, voffA);
            PG8_BAR; PG8_WAIT_L(0); PG8_MMA(1, 0, At, B0); PG8_BAR; PG8_SCHED;
            PG8_STAGE(PG8_SB(0, 1), b2 + hstep, voffB);
            PG8_WAIT_V(6); PG8_BAR; PG8_MMA(1, 1, At, B1); PG8_BAR;
            PG8_LDB(B0, 1, 0); PG8_SCHED; PG8_LDA(At, 1, 0); PG8_STAGE(PG8_SA(0, 1), a2 + hstep, voffA);
            PG8_WAIT_L(8); PG8_BAR; PG8_WAIT_L(0); PG8_MMA(0, 0, At, B0); PG8_BAR; PG8_SCHED;
            PG8_LDB(B1, 1, 1); PG8_STAGE(PG8_SB(1, 0), b3, voffB);
            PG8_BAR; PG8_WAIT_L(0); PG8_MMA(0, 1, At, B1); PG8_BAR;
            PG8_LDA(At, 1, 1); PG8_STAGE(PG8_SA(1, 0), a3, voffA);
            PG8_BAR; PG8_WAIT_L(0); PG8_MMA(1, 0, At, B0); PG8_BAR; PG8_SCHED;
            PG8_STAGE(PG8_SB(1, 1), b3 + hstep, voffB);
            PG8_WAIT_V(6); PG8_BAR; PG8_MMA(1, 1, At, B1); PG8_BAR;
            }
        }
        if constexpr (ALIGN_EPI) { if (wr == 0) PG8_BAR; }
        if constexpr (!Epi::AFTER_DRAIN) { E(acc, cur, wr, wc, fr, fq); S.done(cur); }
        if (!has_next) break;
#pragma unroll
        for (int a = 0; a < 2; ++a)
#pragma unroll
            for (int b = 0; b < 2; ++b)
#pragma unroll
                for (int m = 0; m < 4; ++m)
#pragma unroll
                    for (int n = 0; n < 2; ++n) acc[a][b][m][n] = (f32x4){0.f, 0.f, 0.f, 0.f};
        cur = nxt; cA = nA; cB = nB; ++ui;
        if constexpr (ALIGN_EPI) { if (wr == 1) PG8_BAR; }
    }
    PG8_WAIT_V(0);
    if constexpr (!ALIGN_EPI) { if (wr == 0) PG8_BAR; }
    PG8_BAR;
    if constexpr (Epi::AFTER_DRAIN) { E.fused(acc, cur, wr, wc, fr, fq, lds, wid, lane); S.done(cur); }
#undef PG8_SA
#undef PG8_SB
#undef PG8_STAGE
#undef PG8_LDA
#undef PG8_LDB
#undef PG8_MMA
#undef PG8_WAIT_V
#undef PG8_WAIT_L
#undef PG8_BAR
#undef PG8_SCHED
}
}
#define GAS __attribute__((address_space(1)))
#define LAS __attribute__((address_space(3)))
typedef unsigned short bf16;
typedef unsigned v4u __attribute__((ext_vector_type(4)));
typedef float f32x4 __attribute__((ext_vector_type(4)));
typedef short bf16x8 __attribute__((ext_vector_type(8)));
typedef GAS unsigned gu32;
typedef GAS unsigned long long gu64;
#define RLX_AGENT __ATOMIC_RELAXED, __HIP_MEMORY_SCOPE_AGENT
#define LDS_WAIT() asm volatile("s_waitcnt lgkmcnt(0)" ::: "memory")
#define VM_WAIT() asm volatile("s_waitcnt vmcnt(0)" ::: "memory")
__device__ __forceinline__ unsigned long long rt() { return __builtin_amdgcn_s_memrealtime(); }
__device__ __forceinline__ unsigned f2bf(float f) { unsigned u = __builtin_bit_cast(unsigned, f); return (u + 0x7fffu + ((u >> 16) & 1u)) >> 16; }
__device__ __forceinline__ unsigned pk2(float lo, float hi) { return f2bf(lo) | (f2bf(hi) << 16); }

#define XB_TMO      128
#define XB_XCNT(j)  (256  + 64 * (j))
#define XB_XSUB(j)  (1280 + 64 * (j))
#define XB_XGEN(j)  (2304 + 64 * (j))
#define XB_TOP      3328
#define XB_TOPGEN   3392
#define XCD_BAR_WORDS 3456
#define XB_SPIN_CAP (1u << 18)

__device__ __forceinline__ unsigned xb_ld(unsigned* p)              { return __hip_atomic_load(p, __ATOMIC_RELAXED, __HIP_MEMORY_SCOPE_AGENT); }
__device__ __forceinline__ unsigned xb_add(unsigned* p, unsigned v) { return __hip_atomic_fetch_add(p, v, __ATOMIC_RELAXED, __HIP_MEMORY_SCOPE_AGENT); }
__device__ __forceinline__ unsigned xb_xcc_id() { return (unsigned)__builtin_amdgcn_s_getreg((3 << 11) | 20) & 0xFu; }
#define XB_SPIN(cond, bar) do { unsigned _sp = 0; while (cond) { __builtin_amdgcn_s_sleep(1); \
    if ((++_sp & 255u) == 0u) { if (xb_ld(&(bar)[XB_TMO])) break; if (_sp > XB_SPIN_CAP) { atomicAdd(&(bar)[XB_TMO], 1u); break; } } } } while (0)

struct XcdBarrier {
    unsigned* bar; unsigned x;
    volatile LAS unsigned* st;
};

__device__ __forceinline__ XcdBarrier xcd_barrier_post(unsigned* bar, volatile LAS unsigned* st) {
    XcdBarrier b; b.bar = bar; b.x = xb_xcc_id(); b.st = st;
    if (threadIdx.x == 0) (void)xb_add(&bar[XB_XCNT(b.x)], 1u);
    return b;
}
__device__ __forceinline__ void xcd_barrier_complete(unsigned* bar, unsigned x, unsigned& nloc, unsigned& nx) {
    const unsigned G = gridDim.x * gridDim.y * gridDim.z;
    unsigned sum, cnt, mine, sp = 0u;
    for (;;) {
        sum = 0u; cnt = 0u; mine = 0u;
#pragma unroll
        for (unsigned j = 0; j < 16; ++j) { const unsigned c = xb_ld(&bar[XB_XCNT(j)]); sum += c; cnt += (c > 0u) ? 1u : 0u; mine = (j == x) ? c : mine; }
        if (sum == G) break;
        __builtin_amdgcn_s_sleep(1);
        if ((++sp & 255u) == 0u) { if (xb_ld(&bar[XB_TMO])) break; if (sp > XB_SPIN_CAP) { atomicAdd(&bar[XB_TMO], 1u); break; } }
    }
    nloc = mine > 0u ? mine : 1u; nx = cnt > 0u ? cnt : 1u;
}

__device__ __forceinline__ void xcd_barrier(const XcdBarrier& b) {
    asm volatile("s_waitcnt vmcnt(0)" ::: "memory");
    __syncthreads();
    if (threadIdx.x == 0) {
        unsigned* bar = b.bar;
        __builtin_amdgcn_s_waitcnt(0);
        unsigned nloc = b.st[0], nx = b.st[1];
        if (nloc == 0u) { xcd_barrier_complete(bar, b.x, nloc, nx); b.st[0] = nloc; b.st[1] = nx; }
        const unsigned old = xb_add(&bar[XB_XSUB(b.x)], 1u);
        const unsigned gen = old / nloc;
        if (old + 1u == (gen + 1u) * nloc) {
            __builtin_amdgcn_fence(__ATOMIC_RELEASE, "agent");
            asm volatile("s_waitcnt vmcnt(0)" ::: "memory");
            const unsigned og = xb_add(&bar[XB_TOP], 1u);
            const unsigned tg = og / nx;
            if (og + 1u == (tg + 1u) * nx) xb_add(&bar[XB_TOPGEN], 1u);
            else XB_SPIN(xb_ld(&bar[XB_TOPGEN]) == tg, bar);
            __builtin_amdgcn_fence(__ATOMIC_ACQUIRE, "agent");
            xb_add(&bar[XB_XGEN(b.x)], 1u);
            asm volatile("s_waitcnt vmcnt(0)" ::: "memory");
        } else {
            XB_SPIN(xb_ld(&bar[XB_XGEN(b.x)]) == gen, bar);
            __builtin_amdgcn_fence(__ATOMIC_ACQUIRE, "agent");
            asm volatile("s_waitcnt vmcnt(0)" ::: "memory");
        }
    }
    __syncthreads();
}

constexpr int NWAVES = 8;
constexpr int BATCH = 32, T = 2048, D = 1024, FF = 2816, NL = 2;
constexpr int M = BATCH * T;
constexpr int DIN = 3784;
constexpr int ZN = 4352;
constexpr int Z_QL = 0, Z_QI = 1024, Z_PI = 1536, Z_GA = 2048, Z_GB = 3072, Z_CKV = 4096, Z_KI = 4224, Z_WI = 4288;
constexpr int S_Q = 0, S_CKV = 512, S_QI = 640, S_KI = 1152, S_WI = 1216, S_PI = 1224, S_GA = 1736, S_GB = 2760;
constexpr float EPS = 1e-6f;
constexpr float IDX_SCALE = 0.044194173824159216f;
constexpr float QSCALE = 0.125f * 1.4426950408889634f;

constexpr size_t MiB = 1u << 20;
constexpr size_t WS_CTL = 0, CTL_ZERO_BYTES = 1 * MiB;
constexpr size_t WS_W = 1 * MiB, LW = 46 * MiB + MiB / 2;
constexpr size_t O_WGU1 = 0, O_WD1 = 11 * MiB, O_WIN = 16 * MiB + MiB / 2, O_WA = 25 * MiB, O_WP = 27 * MiB, O_WO = 28 * MiB, O_WGU2 = 30 * MiB, O_WD2 = 41 * MiB;
constexpr size_t WS_XN = 96 * MiB;
constexpr size_t WS_Z = 224 * MiB;
constexpr size_t WS_OL = 768 * MiB;
constexpr size_t WS_PO = 896 * MiB;
constexpr size_t WS_CK = 960 * MiB;
constexpr size_t WS_MASK = 976 * MiB;
constexpr size_t WS_END = 992 * MiB;
static_assert(WS_W + NL * LW <= WS_XN && WS_XN + (size_t)M * D * 2 <= WS_Z && WS_Z + (size_t)M * ZN * 2 <= WS_OL && (size_t)M * FF * 2 <= (size_t)M * ZN * 2, "d_ws map");
static_assert(O_WD2 + (size_t)D * FF * 2 <= LW && O_WIN + (size_t)ZN * D * 2 <= O_WA, "weight map");
constexpr int CW_TMO = 0, CW_CODE = 1, CW_BAR = 4096;

constexpr int RING_OFF = 0, RING_BYTES = 131072;
constexpr int LDSCTL_OFF = RING_BYTES, MISC_OFF = LDSCTL_OFF + 320;
constexpr int LDS_BYTES = 147456;

struct Args { const float* in[20]; float* out; unsigned char* ws; };
typedef const Args __attribute__((address_space(4)))* cargs_t;
struct Frame {
    LAS unsigned char* lds;
    volatile LAS unsigned* MISC;
    gu32* ctl;
    int tid, lane, wave;
    int vcu, G;
};

typedef unsigned u32x4 __attribute__((ext_vector_type(4)));
typedef unsigned u32x2 __attribute__((ext_vector_type(2)));
typedef float f32x16 __attribute__((ext_vector_type(16)));
typedef short s16x4 __attribute__((ext_vector_type(4)));
using pg8::pk_bf16; using pg8::bf_lo; using pg8::bf_hi;

__device__ __forceinline__ float wave_sum(float v) {
#pragma unroll
    for (int o = 1; o < 64; o <<= 1) v += __shfl_xor(v, o);
    return v;
}

__device__ __forceinline__ void tr_item(const float* W, int ldw, int c0, int k0, bf16* WT, int Kd, int drow0, LAS float* scr, int lane) {
#pragma unroll 8
    for (int i = 0; i < 32; ++i) { const int kk = 2 * i + (lane >> 5); scr[kk * 33 + (lane & 31)] = W[(size_t)(k0 + kk) * ldw + c0 + (lane & 31)]; }
    LDS_WAIT(); asm volatile("" ::: "memory");
    const int c = lane & 7;
#pragma unroll
    for (int j = 0; j < 4; ++j) { const int n = (lane >> 3) + 8 * j; const LAS float* s = scr + (8 * c) * 33 + n;
        v4u o; o.x = pk2(s[0 * 33], s[1 * 33]); o.y = pk2(s[2 * 33], s[3 * 33]); o.z = pk2(s[4 * 33], s[5 * 33]); o.w = pk2(s[6 * 33], s[7 * 33]);
        *(GAS v4u*)(WT + (size_t)(drow0 + n) * Kd + k0 + 8 * c) = o; }
    LDS_WAIT(); asm volatile("" ::: "memory");
}
constexpr int I_GU = 16 * 88, I_DN = 44 * 32, I_WO = 16 * 32, I_WIN = 16 * 103, I_ZERO = 1, I_QL = 1024, I_WA = 2048, I_WP = 1024;
constexpr int I_LAYER = 6 * I_GU + I_WO + I_WIN + I_ZERO + I_QL + I_WA + I_WP;
static_assert(I_GU == I_DN, "item counts");

__device__ __forceinline__ void prologue_item(cargs_t ka, int it, LAS float* scr, int lane) {
    const float* const __attribute__((address_space(4)))* in = ka->in; unsigned char* ws = ka->ws;
    const int l = it / I_LAYER; int r = it - l * I_LAYER;
    unsigned char* wl = ws + WS_W + (size_t)l * LW;
    if (r < I_WA) {
        const int hh = r >> 8, cb = (r >> 4) & 15, ib = r & 15, n = 64 * ib + lane;
        const float* wuv = in[9] + (size_t)l * 128 * 8 * 64; const float* wba = in[12] + (size_t)l * 512 * 1024;
        float a[8];
#pragma unroll
        for (int j = 0; j < 8; ++j) a[j] = 0.f;
        for (int d = 0; d < 64; ++d) { const float wv = wba[(size_t)(hh * 64 + d) * 1024 + n];
#pragma unroll
            for (int j = 0; j < 8; ++j) a[j] += wuv[((8 * cb + j) * 8 + hh) * 64 + d] * wv; }
        v4u o; o.x = pk2(a[0], a[1]); o.y = pk2(a[2], a[3]); o.z = pk2(a[4], a[5]); o.w = pk2(a[6], a[7]);
        *(GAS v4u*)((bf16*)(wl + O_WA) + (size_t)n * 1024 + hh * 128 + 8 * cb) = o; return; }
    r -= I_WA;
    if (r < I_WP) {
        const int g = r >> 8, cb = (r >> 4) & 15, ib = r & 15, n = 64 * ib + lane;
        const float* pw = in[10] + (size_t)l * 4 * 128 * 128; const float* ps = in[11] + (size_t)l * 512; const float* wbp = in[13] + (size_t)l * 512 * 1024;
        float a[8];
#pragma unroll
        for (int j = 0; j < 8; ++j) a[j] = 0.f;
        for (int d = 0; d < 128; ++d) { const float wv = wbp[(size_t)(g * 128 + d) * 1024 + n] * ps[g * 128 + d];
#pragma unroll
            for (int j = 0; j < 8; ++j) a[j] += pw[(size_t)(g * 128 + 8 * cb + j) * 128 + d] * wv; }
        v4u o; o.x = pk2(a[0], a[1]); o.y = pk2(a[2], a[3]); o.z = pk2(a[4], a[5]); o.w = pk2(a[6], a[7]);
        *(GAS v4u*)((bf16*)(wl + O_WP) + (size_t)n * 512 + g * 128 + 8 * cb) = o; return; }
    r -= I_WP;
    if (r < I_QL) {
        const int n = r, hh = n >> 7, c = n & 127;
        const float* win = in[6] + (size_t)l * D * DIN; const f32x4* wuk = (const f32x4*)(in[8] + (size_t)l * 128 * 8 * 64 + (size_t)(c * 8 + hh) * 64);
        bf16* dst = (bf16*)(wl + O_WIN) + (size_t)n * D;
        for (int i = 0; i < 16; ++i) { const int k = 64 * i + lane; const f32x4* wr = (const f32x4*)(win + (size_t)k * DIN + hh * 64); float a = 0.f;
#pragma unroll 4
            for (int d4 = 0; d4 < 16; ++d4) { const f32x4 x = wr[d4], y = wuk[d4]; a += (x.x * y.x + x.y * y.y) + (x.z * y.z + x.w * y.w); }
            dst[k] = (bf16)f2bf(a * QSCALE); }
        return; }
    r -= I_QL;
    if (r < I_GU) { const int kb = r / 88, nb = r % 88, n0 = 32 * nb; tr_item(in[2] + (size_t)l * D * FF, FF, n0, 64 * kb, (bf16*)(wl + O_WGU1), D, 256 * (n0 >> 7) + (n0 & 127), scr, lane); return; }
    r -= I_GU;
    if (r < I_GU) { const int kb = r / 88, nb = r % 88, n0 = 32 * nb; tr_item(in[3] + (size_t)l * D * FF, FF, n0, 64 * kb, (bf16*)(wl + O_WGU1), D, 256 * (n0 >> 7) + 128 + (n0 & 127), scr, lane); return; }
    r -= I_GU;
    if (r < I_DN) { const int kb = r / 32, nb = r % 32; tr_item(in[4] + (size_t)l * FF * D, D, 32 * nb, 64 * kb, (bf16*)(wl + O_WD1), FF, 32 * nb, scr, lane); return; }
    r -= I_DN;
    if (r < I_GU) { const int kb = r / 88, nb = r % 88, n0 = 32 * nb; tr_item(in[16] + (size_t)l * D * FF, FF, n0, 64 * kb, (bf16*)(wl + O_WGU2), D, 256 * (n0 >> 7) + (n0 & 127), scr, lane); return; }
    r -= I_GU;
    if (r < I_GU) { const int kb = r / 88, nb = r % 88, n0 = 32 * nb; tr_item(in[17] + (size_t)l * D * FF, FF, n0, 64 * kb, (bf16*)(wl + O_WGU2), D, 256 * (n0 >> 7) + 128 + (n0 & 127), scr, lane); return; }
    r -= I_GU;
    if (r < I_DN) { const int kb = r / 32, nb = r % 32; tr_item(in[18] + (size_t)l * FF * D, D, 32 * nb, 64 * kb, (bf16*)(wl + O_WD2), FF, 32 * nb, scr, lane); return; }
    r -= I_DN;
    if (r < I_WO) { const int kb = r / 32, nb = r % 32; tr_item(in[14] + (size_t)l * D * D, D, 32 * nb, 64 * kb, (bf16*)(wl + O_WO), D, 32 * nb, scr, lane); return; }
    r -= I_WO;
    if (r < I_WIN) {
        const int kb = r / 103, v = 32 * (r % 103); int c0, d0;
        if (v < 512) { c0 = S_QI + v; d0 = Z_QI + v; }
        else if (v < 1024) { c0 = S_PI + (v - 512); d0 = Z_PI + (v - 512); }
        else if (v < 2048) { c0 = S_GA + (v - 1024); d0 = Z_GA + (v - 1024); }
        else if (v < 3072) { c0 = S_GB + (v - 2048); d0 = Z_GB + (v - 2048); }
        else if (v < 3200) { c0 = S_CKV + (v - 3072); d0 = Z_CKV + (v - 3072); }
        else { c0 = S_KI + (v - 3200); d0 = Z_KI + (v - 3200); }
        tr_item(in[6] + (size_t)l * D * DIN, DIN, c0, 64 * kb, (bf16*)(wl + O_WIN), D, d0, scr, lane); return; }
    r -= I_WIN;
    {
        v4u z; z.x = 0u; z.y = 0u; z.z = 0u; z.w = 0u; GAS v4u* p = (GAS v4u*)((bf16*)(wl + O_WIN) + (size_t)4320 * D);
        for (int i = lane; i < 32 * D / 8; i += 64) p[i] = z; }
}

__device__ __forceinline__ void rms_phase(const float* src, const float* g, bf16* dst, int gw, int NGW, int lane) {
    f32x4 gv[4];
#pragma unroll
    for (int j = 0; j < 4; ++j) gv[j] = ((const f32x4*)g)[64 * j + lane];
    for (int m = gw; m < M; m += NGW) {
        const GAS f32x4* xr = (const GAS f32x4*)(src + (size_t)m * D) + lane;
        f32x4 v[4]; float s = 0.f;
#pragma unroll
        for (int j = 0; j < 4; ++j) { v[j] = xr[64 * j]; s += (v[j].x * v[j].x + v[j].y * v[j].y) + (v[j].z * v[j].z + v[j].w * v[j].w); }
        const float rstd = 1.f / sqrtf(wave_sum(s) * (1.f / D) + EPS);
        GAS u32x2* o8 = (GAS u32x2*)(dst + (size_t)m * D) + lane;
#pragma unroll
        for (int j = 0; j < 4; ++j) { u32x2 w; w.x = pk_bf16(v[j].x * rstd * gv[j].x, v[j].y * rstd * gv[j].y); w.y = pk_bf16(v[j].z * rstd * gv[j].z, v[j].w * rstd * gv[j].w); o8[64 * j] = w; }
    }
}
__device__ __forceinline__ void final_norm_phase(float* x, const float* g, int gw, int NGW, int lane, bool poison) {
    f32x4 gv[4];
#pragma unroll
    for (int j = 0; j < 4; ++j) gv[j] = ((const f32x4*)g)[64 * j + lane];
    const float qnan = __builtin_nanf("");
    for (int m = gw; m < M; m += NGW) {
        GAS f32x4* xr = (GAS f32x4*)(x + (size_t)m * D) + lane;
        f32x4 v[4]; float s = 0.f;
#pragma unroll
        for (int j = 0; j < 4; ++j) { v[j] = xr[64 * j]; s += (v[j].x * v[j].x + v[j].y * v[j].y) + (v[j].z * v[j].z + v[j].w * v[j].w); }
        float rstd = 1.f / sqrtf(wave_sum(s) * (1.f / D) + EPS);
        if (poison) rstd = qnan;
#pragma unroll
        for (int j = 0; j < 4; ++j) xr[64 * j] = v[j] * rstd * gv[j];
    }
}
__device__ __forceinline__ void prep_phase(const bf16* Z, const float* gkv, bf16* CK, bf16* PO, int gw, int NGW, int lane) {
    {
        const int sub = lane >> 4, ch = lane & 15;
        float gk[8];
#pragma unroll
        for (int e = 0; e < 8; ++e) gk[e] = gkv[8 * ch + e];
        for (int r4 = gw; r4 < M / 4; r4 += NGW) {
            const size_t m = (size_t)r4 * 4 + sub;
            const u32x4 w = *(const GAS u32x4*)(Z + m * ZN + Z_CKV + 8 * ch);
            float x[8] = {bf_lo(w.x), bf_hi(w.x), bf_lo(w.y), bf_hi(w.y), bf_lo(w.z), bf_hi(w.z), bf_lo(w.w), bf_hi(w.w)};
            float s = 0.f;
#pragma unroll
            for (int e = 0; e < 8; ++e) s += x[e] * x[e];
            s += __shfl_xor(s, 1); s += __shfl_xor(s, 2); s += __shfl_xor(s, 4); s += __shfl_xor(s, 8);
            const float rstd = 1.f / sqrtf(s * (1.f / 128.f) + EPS);
            u32x4 o; o.x = pk_bf16(x[0] * rstd * gk[0], x[1] * rstd * gk[1]); o.y = pk_bf16(x[2] * rstd * gk[2], x[3] * rstd * gk[3]);
            o.z = pk_bf16(x[4] * rstd * gk[4], x[5] * rstd * gk[5]); o.w = pk_bf16(x[6] * rstd * gk[6], x[7] * rstd * gk[7]);
            *(GAS u32x4*)(CK + m * 128 + 8 * ch) = o;
        }
    }
    {
        const int wdw = 2 << (lane >> 4);
        for (int m = gw; m < M; m += NGW) {
            const int t = m & (T - 1); const int cnt = (t + 1) < wdw ? (t + 1) : wdw;
            const bf16* p = Z + (size_t)m * ZN + Z_PI + 8 * lane;
            float a[8], self[8];
#pragma unroll
            for (int e = 0; e < 8; ++e) { a[e] = 0.f; self[e] = 0.f; }
#pragma unroll
            for (int i = 0; i < 16; ++i) {
                if (i < cnt) {
                    const u32x4 w = *(const GAS u32x4*)(p - (size_t)i * ZN);
                    const float x[8] = {bf_lo(w.x), bf_hi(w.x), bf_lo(w.y), bf_hi(w.y), bf_lo(w.z), bf_hi(w.z), bf_lo(w.w), bf_hi(w.w)};
#pragma unroll
                    for (int e = 0; e < 8; ++e) { a[e] += x[e]; if (i == 0) self[e] = x[e]; }
                }
            }
            const float inv = 1.f / (float)cnt;
            u32x4 o; o.x = pk_bf16(a[0] * inv - self[0], a[1] * inv - self[1]); o.y = pk_bf16(a[2] * inv - self[2], a[3] * inv - self[3]);
            o.z = pk_bf16(a[4] * inv - self[4], a[5] * inv - self[5]); o.w = pk_bf16(a[6] * inv - self[6], a[7] * inv - self[7]);
            *(GAS u32x4*)(PO + (size_t)m * 512 + 8 * lane) = o;
        }
    }
}

__device__ __forceinline__ bool mix_unit(int i, int vcu, int G, int& b, int& qb) {
    if (G == 256) { if (i >= 8) return false; b = vcu >> 3; const int r = vcu & 7; qb = (i & 1) ? 16 * (i >> 1) + 15 - r : 16 * (i >> 1) + r; return true; }
    const int u = vcu + i * G; if (u >= BATCH * 64) return false; b = u >> 6; qb = u & 63; return true;
}
__device__ __forceinline__ unsigned fkey(float s) { const unsigned u = __float_as_uint(s); return (u & 0x80000000u) ? ~u : (u | 0x80000000u); }

__device__ __forceinline__ void select_unit(const bf16* Z, unsigned* MASK, int b, int qb, int wid, int lane_in) {
    int lane = lane_in; asm volatile("" : "+v"(lane));
    const int col = lane & 31, hh = lane >> 5;
    const size_t mb = (size_t)b * T + 32 * qb + 4 * wid;
    const int tql_r = 2 * (col >> 4) + ((col >> 2) & 1), j_r = 4 * ((col >> 3) & 1) + (col & 3);
    bf16x8 qa[4];
#pragma unroll
    for (int s = 0; s < 4; ++s) qa[s] = *(const GAS bf16x8*)(Z + (mb + tql_r) * ZN + Z_QI + j_r * 64 + 16 * s + 8 * hh);
    float wA[8], wB[8];
    { const u32x4 a = *(const GAS u32x4*)(Z + (mb + hh) * ZN + Z_WI), c = *(const GAS u32x4*)(Z + (mb + 2 + hh) * ZN + Z_WI);
      wA[0] = bf_lo(a.x) * IDX_SCALE; wA[1] = bf_hi(a.x) * IDX_SCALE; wA[2] = bf_lo(a.y) * IDX_SCALE; wA[3] = bf_hi(a.y) * IDX_SCALE;
      wA[4] = bf_lo(a.z) * IDX_SCALE; wA[5] = bf_hi(a.z) * IDX_SCALE; wA[6] = bf_lo(a.w) * IDX_SCALE; wA[7] = bf_hi(a.w) * IDX_SCALE;
      wB[0] = bf_lo(c.x) * IDX_SCALE; wB[1] = bf_hi(c.x) * IDX_SCALE; wB[2] = bf_lo(c.y) * IDX_SCALE; wB[3] = bf_hi(c.y) * IDX_SCALE;
      wB[4] = bf_lo(c.z) * IDX_SCALE; wB[5] = bf_hi(c.z) * IDX_SCALE; wB[6] = bf_lo(c.w) * IDX_SCALE; wB[7] = bf_hi(c.w) * IDX_SCALE; }
    const int dA = 32 * qb + 4 * wid + hh - col, dB = dA + 2;
    unsigned kA[64], kB[64];
    const bf16* kp = Z + ((size_t)b * T + col) * ZN + Z_KI + 8 * hh;
#pragma unroll
    for (int kt = 0; kt < 64; ++kt) {
        kA[kt] = 0u; kB[kt] = 0u;
        if (kt <= qb) {
            asm volatile("" : "+v"(kp));
            f32x16 acc;
#pragma unroll
            for (int i = 0; i < 16; ++i) acc[i] = 0.f;
#pragma unroll
            for (int s = 0; s < 4; ++s) { const bf16x8 kb = *(const GAS bf16x8*)(kp + 16 * s); acc = __builtin_amdgcn_mfma_f32_32x32x16_bf16(qa[s], kb, acc, 0, 0, 0); }
            kp += (size_t)32 * ZN;
            float sa = 0.f, sb = 0.f;
#pragma unroll
            for (int j = 0; j < 8; ++j) { sa = fmaf(fmaxf(acc[j], 0.f), wA[j], sa); sb = fmaf(fmaxf(acc[8 + j], 0.f), wB[j], sb); }
            kA[kt] = (32 * kt <= dA) ? fkey(sa) : 0u; kB[kt] = (32 * kt <= dB) ? fkey(sb) : 0u;
        }
        __builtin_amdgcn_sched_barrier(0);
    }
    unsigned thrA = 1u, thrB = 1u;
    if (qb >= 8) {
        unsigned pa = 0u, pb = 0u; bool dA = false, dB = false;
#pragma unroll 1
        for (int bit = 31; bit >= 0; --bit) {
            const unsigned cA = pa | (1u << bit), cB = pb | (1u << bit);
            unsigned nA = 0u, nB = 0u;
#pragma unroll
            for (int c8 = 0; c8 < 8; ++c8) {
                if (8 * c8 <= qb) {
#pragma unroll
                    for (int k = 0; k < 8; ++k) { nA += (kA[8 * c8 + k] >= cA) ? 1u : 0u; nB += (kB[8 * c8 + k] >= cB) ? 1u : 0u; }
                }
            }
#pragma unroll
            for (int o = 1; o < 32; o <<= 1) { nA += __shfl_xor(nA, o); nB += __shfl_xor(nB, o); }
            if (!dA) { if (nA >= 256u) pa = cA; dA = (nA == 256u); }
            if (!dB) { if (nB >= 256u) pb = cB; dB = (nB == 256u); }
            if (__all(dA && dB)) break;
        }
        thrA = pa > 1u ? pa : 1u; thrB = pb > 1u ? pb : 1u;
    }
    unsigned w0 = 0u, w1 = 0u, w2 = 0u, w3 = 0u;
    int lane2 = lane; asm volatile("" : "+v"(lane2));
#pragma unroll
    for (int kt = 0; kt < 64; ++kt) {
        const unsigned long long bA = __ballot(kA[kt] >= thrA), bB = __ballot(kB[kt] >= thrB);
        const bool mine = (lane2 == kt);
        w0 = mine ? (unsigned)bA : w0; w1 = mine ? (unsigned)(bA >> 32) : w1; w2 = mine ? (unsigned)bB : w2; w3 = mine ? (unsigned)(bB >> 32) : w3;
    }
    GAS unsigned* mo = (GAS unsigned*)MASK + mb * 64 + lane;
    mo[0] = w0; mo[64] = w1; mo[128] = w2; mo[192] = w3;
}

__device__ __forceinline__ unsigned off_b(unsigned row, unsigned ch) { return 256u * row + 16u * (ch ^ (((row & 3u) << 2) | ((row >> 2) & 3u))); }
__device__ __forceinline__ s16x4 vtr(const LAS unsigned char* p) { typedef short v4i16_t __attribute__((ext_vector_type(4))); return __builtin_bit_cast(s16x4, __builtin_amdgcn_ds_read_tr16_b64_v4i16((LAS v4i16_t*)p)); }
__device__ __forceinline__ void attn_unit(LAS unsigned char* kbuf, const bf16* Z, const bf16* CK, const unsigned* MASK, bf16* OL, int b, int qb, int wid, int lane, int tid) {
    const int r32 = lane & 31, hh = lane >> 5, tql = r32 >> 3, head = r32 & 7;
    const size_t m = (size_t)b * T + 32 * qb + 4 * wid + tql;
    bf16x8 qf[8];
#pragma unroll
    for (int s = 0; s < 8; ++s) qf[s] = *(const GAS bf16x8*)(Z + m * ZN + Z_QL + head * 128 + 16 * s + 8 * hh);
    const GAS unsigned* mrow = (const GAS unsigned*)MASK + m * 64;
    f32x16 o[4];
#pragma unroll
    for (int dt = 0; dt < 4; ++dt)
#pragma unroll
        for (int i = 0; i < 16; ++i) o[dt][i] = 0.f;
    float mrun = -1e30f, lrun = 0.f;
    const int nt = qb + 1;
    const bf16* ksrc = CK + ((size_t)b * T + (tid >> 4)) * 128 + 8 * (tid & 15);
    const unsigned kdst = off_b((unsigned)(tid >> 4), (unsigned)(tid & 15));
    const unsigned q4 = (lane & 15) >> 2, p4 = lane & 3, blk = (lane >> 4) & 1;
    { const u32x4 g0 = *(const GAS u32x4*)ksrc; *(LAS u32x4*)(kbuf + kdst) = g0; }
    unsigned mw = mrow[0];
    __syncthreads();
    for (int kt = 0; kt < nt; ++kt) {
        const LAS unsigned char* kb = kbuf + (kt & 1) * 8192;
        u32x4 gn; gn.x = 0u; gn.y = 0u; gn.z = 0u; gn.w = 0u; unsigned mwn = 0u;
        const bool more = (kt + 1 < nt);
        if (more) { gn = *(const GAS u32x4*)(ksrc + (size_t)(kt + 1) * 32 * 128); mwn = mrow[kt + 1]; }
        f32x16 st;
#pragma unroll
        for (int i = 0; i < 16; ++i) st[i] = 0.f;
#pragma unroll
        for (int s = 0; s < 8; ++s) { const bf16x8 kf = *(const LAS bf16x8*)(kb + off_b((unsigned)r32, (unsigned)(2 * s + hh))); st = __builtin_amdgcn_mfma_f32_32x32x16_bf16(kf, qf[s], st, 0, 0, 0); }
        const unsigned wsh = mw >> (4 * hh);
        float mx = -INFINITY;
#pragma unroll
        for (int i = 0; i < 16; ++i) { const int pos = (i & 3) + 8 * (i >> 2); st[i] = ((wsh >> pos) & 1u) ? st[i] : -INFINITY; mx = fmaxf(mx, st[i]); }
        mx = fmaxf(mx, __shfl_xor(mx, 32));
        const float mnew = fmaxf(mrun, mx);
        const float alpha = __builtin_amdgcn_exp2f(mrun - mnew);
        mrun = mnew;
        float ps = 0.f;
#pragma unroll
        for (int i = 0; i < 16; ++i) { st[i] = __builtin_amdgcn_exp2f(st[i] - mnew); ps += st[i]; }
        lrun = lrun * alpha + ps;
        if (__any(alpha != 1.0f)) {
#pragma unroll
            for (int dt = 0; dt < 4; ++dt)
#pragma unroll
                for (int i = 0; i < 16; ++i) o[dt][i] *= alpha;
        }
        bf16x8 pf[2];
#pragma unroll
        for (int s = 0; s < 2; ++s) { u32x4 pw; pw.x = pk_bf16(st[8 * s + 0], st[8 * s + 1]); pw.y = pk_bf16(st[8 * s + 2], st[8 * s + 3]); pw.z = pk_bf16(st[8 * s + 4], st[8 * s + 5]); pw.w = pk_bf16(st[8 * s + 6], st[8 * s + 7]); pf[s] = __builtin_bit_cast(bf16x8, pw); }
#pragma unroll
        for (int dt = 0; dt < 4; ++dt)
#pragma unroll
            for (int s = 0; s < 2; ++s) {
                const s16x4 lo = vtr(kb + off_b(16u * s + 4u * hh + q4, 4u * dt + 2u * blk + (p4 >> 1)) + 8u * (p4 & 1u));
                const s16x4 hi = vtr(kb + off_b(16u * s + 8u + 4u * hh + q4, 4u * dt + 2u * blk + (p4 >> 1)) + 8u * (p4 & 1u));
                const bf16x8 vt = __builtin_shufflevector(lo, hi, 0, 1, 2, 3, 4, 5, 6, 7);
                o[dt] = __builtin_amdgcn_mfma_f32_32x32x16_bf16(vt, pf[s], o[dt], 0, 0, 0);
            }
        if (more) *(LAS u32x4*)(kbuf + ((kt + 1) & 1) * 8192 + kdst) = gn;
        mw = mwn;
        __syncthreads();
    }
    lrun += __shfl_xor(lrun, 32);
    const float inv = 1.f / lrun;
    bf16* orow = OL + m * 1024 + head * 128 + 4 * hh;
#pragma unroll
    for (int dt = 0; dt < 4; ++dt)
#pragma unroll
        for (int g = 0; g < 4; ++g) { u32x2 w; w.x = pk_bf16(o[dt][4 * g] * inv, o[dt][4 * g + 1] * inv); w.y = pk_bf16(o[dt][4 * g + 2] * inv, o[dt][4 * g + 3] * inv);
            *(GAS u32x2*)(orow + 32 * dt + 8 * g) = w; }
}

__device__ __forceinline__ cargs_t kargs() { cargs_t p = (cargs_t)__builtin_amdgcn_kernarg_segment_ptr(); asm volatile("" : "+s"(p)); return p; }
__device__ __forceinline__ int opq(int v) { asm volatile("" : "+v"(v)); return v; }
__global__ void __launch_bounds__(NWAVES * 64, 2) fwd(Args args_unused) {
    extern __shared__ __attribute__((aligned(16))) unsigned char lds[];
    Frame F;
    F.lds = (LAS unsigned char*)lds;
    F.MISC = (volatile LAS unsigned*)(F.lds + MISC_OFF);
    F.tid = threadIdx.x; F.lane = F.tid & 63; F.wave = __builtin_amdgcn_readfirstlane(F.tid >> 6);
    F.G = gridDim.x; { const int bx = blockIdx.x; F.vcu = (F.G % 8 == 0) ? (bx % 8) * (F.G / 8) + bx / 8 : bx; }
    F.ctl = (gu32*)(kargs()->ws + WS_CTL);
    for (int u = F.tid; u < (LDS_BYTES - LDSCTL_OFF) / 4; u += NWAVES * 64) ((LAS unsigned*)(F.lds + LDSCTL_OFF))[u] = 0u;
    __syncthreads();
    XcdBarrier bar = xcd_barrier_post((unsigned*)(F.ctl + CW_BAR), F.MISC + 8);
#define GRID_BAR() xcd_barrier(bar)
    const int gw = F.vcu * NWAVES + F.wave, NGW = F.G * NWAVES;
#define WSP(off) (kargs()->ws + (off))

    {
        LAS float* scr = (LAS float*)(F.lds + RING_OFF + F.wave * 16384);
        const cargs_t a = kargs(); const int lane = opq(F.lane);
        for (int it = gw; it < NL * I_LAYER; it += NGW) prologue_item(a, it, scr, lane);
        rms_phase(a->in[0], a->in[1], (bf16*)(a->ws + WS_XN), gw, NGW, lane);
        GRID_BAR();
    }
#define GEMM_PHASE(EPI_T, A_, B_, N_, K_, E_) do { const pg8::Gemm g_{(const pg8::bf16_t*)(A_), (const pg8::bf16_t*)(B_), M, (N_), (K_)}; pg8::StaticOrder S_; S_.init(M, (N_), F.G, (int)blockIdx.x); \
        pg8::gemm_phase<EPI_T, pg8::StaticOrder, true, true>(F.lds + RING_OFF, g_, S_, (E_)); } while (0)

    for (int fi = 0; fi < 2 * NL; ++fi) {
        const int l = fi >> 1; const bool second = (fi & 1) != 0;
        const size_t wlo = WS_W + (size_t)l * LW;
        if (fi > 0) { const cargs_t a = kargs(); rms_phase(a->out, (second ? a->in[15] : a->in[1]) + (size_t)l * D, (bf16*)(a->ws + WS_XN), gw, NGW, opq(F.lane)); GRID_BAR(); }
        { const cargs_t a = kargs(); const pg8::EpiSwiglu E{(pg8::bf16_t*)(a->ws + WS_Z), FF}; GEMM_PHASE(pg8::EpiSwiglu, a->ws + WS_XN, a->ws + wlo + (second ? O_WGU2 : O_WGU1), 2 * FF, D, E); GRID_BAR(); }
        { const cargs_t a = kargs(); const pg8::EpiResid E{fi == 0 ? a->in[0] : a->out, a->out, D, 0.5f}; GEMM_PHASE(pg8::EpiResid, a->ws + WS_Z, a->ws + wlo + (second ? O_WD2 : O_WD1), D, FF, E); GRID_BAR(); }
        if (!second) {
            { const cargs_t a = kargs(); rms_phase(a->out, a->in[5] + (size_t)l * D, (bf16*)(a->ws + WS_XN), gw, NGW, opq(F.lane)); GRID_BAR(); }
            { const cargs_t a = kargs(); const pg8::EpiPlainBf16 E{(pg8::bf16_t*)(a->ws + WS_Z), ZN}; GEMM_PHASE(pg8::EpiPlainBf16, a->ws + WS_XN, a->ws + wlo + O_WIN, ZN, D, E); GRID_BAR(); }
            { const cargs_t a = kargs(); const int lane = opq(F.lane);
              prep_phase((const bf16*)(a->ws + WS_Z), a->in[7] + (size_t)l * 128, (bf16*)(a->ws + WS_CK), (bf16*)(a->ws + WS_PO), gw, NGW, lane);
              int b, qb; for (int i = 0; mix_unit(i, F.vcu, F.G, b, qb); ++i) select_unit((const bf16*)(a->ws + WS_Z), (unsigned*)(a->ws + WS_MASK), b, qb, F.wave, lane);
              GRID_BAR(); }
            { const cargs_t a = kargs(); const int tid = opq(F.tid);
              int b, qb; for (int i = 0; mix_unit(i, F.vcu, F.G, b, qb); ++i) attn_unit(F.lds + RING_OFF, (const bf16*)(a->ws + WS_Z), (const bf16*)(a->ws + WS_CK), (const unsigned*)(a->ws + WS_MASK), (bf16*)(a->ws + WS_OL), b, qb, F.wave, tid & 63, tid);
              GRID_BAR(); }
            { const cargs_t a = kargs(); const pg8::EpiGate<false> E{(pg8::bf16_t*)(a->ws + WS_XN), D, (const pg8::bf16_t*)(a->ws + WS_Z) + Z_GA, ZN}; GEMM_PHASE(pg8::EpiGate<false>, a->ws + WS_OL, a->ws + wlo + O_WA, D, D, E); GRID_BAR(); }
            { const cargs_t a = kargs(); const pg8::EpiGate<true> E{(pg8::bf16_t*)(a->ws + WS_XN), D, (const pg8::bf16_t*)(a->ws + WS_Z) + Z_GB, ZN}; GEMM_PHASE(pg8::EpiGate<true>, a->ws + WS_PO, a->ws + wlo + O_WP, D, 512, E); GRID_BAR(); }
            { const cargs_t a = kargs(); const pg8::EpiResid E{a->out, a->out, D, 1.0f}; GEMM_PHASE(pg8::EpiResid, a->ws + WS_XN, a->ws + wlo + O_WO, D, D, E); GRID_BAR(); }
        }
    }
    {
        const cargs_t a = kargs();
        const bool poison = __hip_atomic_load((gu32*)(F.ctl + CW_BAR + XB_TMO), RLX_AGENT) != 0u;
        final_norm_phase(a->out, a->in[19], gw, NGW, opq(F.lane), poison);
    }
}

extern "C" void kernel_launch(void* const* d_in, const int* in_sizes, int n_in, void* d_out, int out_size, void* d_ws, size_t ws_size, hipStream_t stream) {
    static int grid = 0;
    if (grid == 0) {
        if (n_in != 20 || in_sizes[0] != M * D || out_size != M * D || ws_size < WS_END) { fprintf(stderr, "kernel_launch: unexpected shapes (n_in %d, in0 %d, out %d, ws %zu); nothing launched\n", n_in, n_in > 0 ? in_sizes[0] : -1, out_size, ws_size); grid = -1; return; }
        int dev = 0, cus = 0, per_cu = 0;
        if (hipGetDevice(&dev) != hipSuccess || hipDeviceGetAttribute(&cus, hipDeviceAttributeMultiprocessorCount, dev) != hipSuccess) { fprintf(stderr, "kernel_launch: device query failed\n"); grid = -1; return; }
        if (hipFuncSetAttribute((const void*)fwd, hipFuncAttributeMaxDynamicSharedMemorySize, LDS_BYTES) != hipSuccess) { fprintf(stderr, "kernel_launch: hipFuncSetAttribute failed\n"); grid = -1; return; }
        if (hipOccupancyMaxActiveBlocksPerMultiprocessor(&per_cu, (const void*)fwd, NWAVES * 64, LDS_BYTES) != hipSuccess || per_cu < 1)
            fprintf(stderr, "kernel_launch: note: occupancy query reports %d workgroups per CU\n", per_cu);
        (void)hipGetLastError();
        grid = cus;
    }
    if (grid < 0) return;
    if (hipMemsetAsync((char*)d_ws + WS_CTL, 0, CTL_ZERO_BYTES, stream) != hipSuccess) { fprintf(stderr, "kernel_launch: hipMemsetAsync failed\n"); return; }
    Args a{};
    for (int i = 0; i < 20; ++i) a.in[i] = (const float*)d_in[i];
    a.out = (float*)d_out; a.ws = (unsigned char*)d_ws;
    hipLaunchKernelGGL(fwd, dim3(grid), dim3(NWAVES * 64), LDS_BYTES, stream, a);
    const hipError_t le = hipPeekAtLastError();
    if (le != hipSuccess) fprintf(stderr, "kernel_launch: launch failed: %s\n", hipGetErrorName(le));
}
```

```cpp
#ifndef PROBE_DUP
#define PROBE_DUP 0
#endif
#include <hip/hip_runtime.h>
#include <cstdio>
#include <cstdint>
#include <cmath>
namespace pg8 {
#define PG8_LAS __attribute__((address_space(3)))
typedef unsigned short bf16_t;
typedef short bf16x8 __attribute__((ext_vector_type(8)));
typedef float f32x4 __attribute__((ext_vector_type(4)));
typedef unsigned u32x4 __attribute__((ext_vector_type(4)));
constexpr int BM = 256, BK = 64, HALF = 128, HTB = HALF * BK * 2  , STAGE_BYTES = 8 * HTB, NXCD = 8, WGM = 8;

__host__ __device__ __forceinline__ int lds_byte(int r, int c) { const int st = (r >> 4) * 2 + (c >> 5), rr = r & 15, cc = c & 31, ob = rr * 64 + cc * 2; return st * 1024 + (ob ^ (((ob >> 9) & 1) << 5)); }
__host__ __device__ __forceinline__ void stage_rc(int b, int& R, int& C) { const int st = b / 1024, sb = b % 1024, swz = sb ^ (((sb >> 9) & 1) << 5); R = (st >> 1) * 16 + swz / 64; C = (st & 1) * 32 + (swz % 64) / 2; }
__host__ __device__ __forceinline__ int perm32(int rho) { const int n = rho >> 4, i = rho & 15; return 8 * (i >> 2) + 4 * n + (i & 3); }

struct Unit { int pm, pn; };
struct Gemm { const bf16_t* A; const bf16_t* Bt; int M, N, K; };

struct StaticOrder {
    int nM, nN, nwg, G, c;
    __host__ __device__ void init(int M, int N, int G_, int c_) { nM = M / BM; nN = N / BM; nwg = nM * nN; G = G_; c = c_; }
    __host__ __device__ bool next(int i, Unit& u) const {
        const long L = (long)i * G + c; if (L >= nwg) return false;
        int wgid = (int)L; { const int q = nwg / NXCD, r = nwg % NXCD, xcd = wgid % NXCD, off = wgid / NXCD; wgid = (xcd < r ? xcd * (q + 1) : r * (q + 1) + (xcd - r) * q) + off; }
        const int nig = WGM * nN, gid = wgid / nig, fm = gid * WGM, gsz = (nM - fm) < WGM ? (nM - fm) : WGM;
        u.pm = fm + ((wgid % nig) % gsz); u.pn = (wgid % nig) / gsz; return true;
    }
    __device__ __forceinline__ void a_ready(const Unit&) const {}
    __device__ __forceinline__ void done(const Unit&) const {}
};

__device__ __forceinline__ unsigned cvt_pk_bf16(float lo, float hi) { unsigned r; asm volatile("v_cvt_pk_bf16_f32 %0, %1, %2" : "=v"(r) : "v"(lo), "v"(hi)); return r; }
typedef float f32x2 __attribute__((ext_vector_type(2)));
typedef __bf16 bf16x2_t __attribute__((ext_vector_type(2)));
__device__ __forceinline__ unsigned pk_bf16(float lo, float hi) { f32x2 v = {lo, hi}; bf16x2_t b = __builtin_convertvector(v, bf16x2_t); return __builtin_bit_cast(unsigned, b); }
__device__ __forceinline__ float sigm(float g) { return __builtin_amdgcn_rcpf(1.0f + __builtin_amdgcn_exp2f(-1.4426950408889634f * g)); }
__device__ __forceinline__ float bf_lo(unsigned w) { return __uint_as_float(w << 16); }
__device__ __forceinline__ float bf_hi(unsigned w) { return __uint_as_float(w & 0xffff0000u); }

struct EpiPlainBf16 {
    static constexpr bool PERM = true, AFTER_DRAIN = false;
    bf16_t* O1; int ld1; bf16_t* O2; int ld2; int nsplit;
    __device__ __forceinline__ void operator()(const f32x4 (&acc)[2][2][4][2], const Unit& u, int wr, int wc, int fr, int fq) const {
        const bool first = u.pn < nsplit; bf16_t* O = first ? O1 : O2; const int ldc = first ? ld1 : ld2;
        const int row0 = u.pm * BM + wr * 64 + fr, col0 = (first ? u.pn : u.pn - nsplit) * BM + wc * 32 + 8 * fq;
#pragma unroll
        for (int ai = 0; ai < 2; ++ai)
#pragma unroll
            for (int m = 0; m < 4; ++m) { bf16_t* rowp = O + (size_t)(row0 + ai * HALF + m * 16) * ldc + col0;
#pragma unroll
                for (int bj = 0; bj < 2; ++bj) { const f32x4 v0 = acc[ai][bj][m][0], v1 = acc[ai][bj][m][1];
                    u32x4 w; w.x = pk_bf16(v0[0], v0[1]); w.y = pk_bf16(v0[2], v0[3]); w.z = pk_bf16(v1[0], v1[1]); w.w = pk_bf16(v1[2], v1[3]);
                    *(u32x4*)(rowp + bj * HALF) = w; } }
    }
};
struct EpiSwiglu {
    static constexpr bool PERM = true, AFTER_DRAIN = false;
    bf16_t* O; int ldc;
    __device__ __forceinline__ void operator()(const f32x4 (&acc)[2][2][4][2], const Unit& u, int wr, int wc, int fr, int fq) const {
        const int row0 = u.pm * BM + wr * 64 + fr, col0 = u.pn * HALF + wc * 32 + 8 * fq;
#pragma unroll
        for (int ai = 0; ai < 2; ++ai)
#pragma unroll
            for (int m = 0; m < 4; ++m) { bf16_t* rowp = O + (size_t)(row0 + ai * HALF + m * 16) * ldc + col0;
                f32x4 h0, h1;
#pragma unroll
                for (int j = 0; j < 4; ++j) { const float g0 = acc[ai][0][m][0][j], g1 = acc[ai][0][m][1][j];
                    h0[j] = g0 * sigm(g0) * acc[ai][1][m][0][j]; h1[j] = g1 * sigm(g1) * acc[ai][1][m][1][j]; }
                u32x4 w; w.x = pk_bf16(h0[0], h0[1]); w.y = pk_bf16(h0[2], h0[3]); w.z = pk_bf16(h1[0], h1[1]); w.w = pk_bf16(h1[2], h1[3]);
                *(u32x4*)rowp = w; }
    }
};
template <int HALFSTEP> struct EpiResid {
    static constexpr bool PERM = false, AFTER_DRAIN = false;
    bf16_t* X; int ldc;
    __device__ __forceinline__ void operator()(const f32x4 (&acc)[2][2][4][2], const Unit& u, int wr, int wc, int fr, int fq) const {
        const int row0 = u.pm * BM + wr * 64 + fr, col0 = u.pn * BM + wc * 32 + 4 * fq;
        typedef unsigned u32x2_t __attribute__((ext_vector_type(2)));
#pragma unroll
        for (int ai = 0; ai < 2; ++ai)
#pragma unroll
            for (int m = 0; m < 4; ++m) { bf16_t* rowp = X + (size_t)(row0 + ai * HALF + m * 16) * ldc + col0;
#pragma unroll
                for (int bj = 0; bj < 2; ++bj)
#pragma unroll
                    for (int n = 0; n < 2; ++n) { const u32x2_t b = *(const u32x2_t*)(rowp + bj * HALF + n * 16); const f32x4 a = acc[ai][bj][m][n] * (HALFSTEP ? 0.5f : 1.0f);
                        u32x2_t w; w.x = pk_bf16(bf_lo(b.x) + a[0], bf_hi(b.x) + a[1]); w.y = pk_bf16(bf_lo(b.y) + a[2], bf_hi(b.y) + a[3]);
                        *(u32x2_t*)(rowp + bj * HALF + n * 16) = w; }
                if (m & 1) __builtin_amdgcn_sched_barrier(0); }
    }
};
template <bool ADD> struct EpiGate {
    static constexpr bool PERM = true, AFTER_DRAIN = false;
    bf16_t* O; int ldc; const bf16_t* G; int ldg;
    __device__ __forceinline__ void operator()(const f32x4 (&acc)[2][2][4][2], const Unit& u, int wr, int wc, int fr, int fq) const {
        const int row0 = u.pm * BM + wr * 64 + fr, col0 = u.pn * BM + wc * 32 + 8 * fq;
#pragma unroll
        for (int ai = 0; ai < 2; ++ai)
#pragma unroll
            for (int m = 0; m < 4; ++m) { const size_t r = (size_t)(row0 + ai * HALF + m * 16);
#pragma unroll
                for (int bj = 0; bj < 2; ++bj) { const f32x4 v0 = acc[ai][bj][m][0], v1 = acc[ai][bj][m][1];
                    const u32x4 g = *(const u32x4*)(G + r * ldg + col0 + bj * HALF);
                    float r0 = sigm(bf_lo(g.x)) * v0[0], r1 = sigm(bf_hi(g.x)) * v0[1], r2 = sigm(bf_lo(g.y)) * v0[2], r3 = sigm(bf_hi(g.y)) * v0[3];
                    float r4 = sigm(bf_lo(g.z)) * v1[0], r5 = sigm(bf_hi(g.z)) * v1[1], r6 = sigm(bf_lo(g.w)) * v1[2], r7 = sigm(bf_hi(g.w)) * v1[3];
                    bf16_t* op = O + r * ldc + col0 + bj * HALF;
                    if (ADD) { const u32x4 o = *(const u32x4*)op; r0 += bf_lo(o.x); r1 += bf_hi(o.x); r2 += bf_lo(o.y); r3 += bf_hi(o.y); r4 += bf_lo(o.z); r5 += bf_hi(o.z); r6 += bf_lo(o.w); r7 += bf_hi(o.w); }
                    u32x4 w; w.x = pk_bf16(r0, r1); w.y = pk_bf16(r2, r3); w.z = pk_bf16(r4, r5); w.w = pk_bf16(r6, r7);
                    *(u32x4*)op = w; }
                __builtin_amdgcn_sched_barrier(0); }
    }
};

template <class Epi, class Sched, bool ALIGN_EPI = false, bool SP2 = false>
__device__ __forceinline__ void gemm_phase(PG8_LAS unsigned char* lds, const Gemm g, const Sched S, const Epi E, const int wave_id) {
    unsigned z_o = 0u; asm volatile("" : "+v"(z_o)); int tid_o = wave_id * 64 + (int)__builtin_amdgcn_mbcnt_hi(~0u, __builtin_amdgcn_mbcnt_lo(~0u, z_o)); asm volatile("" : "+v"(tid_o));
    const int tid = tid_o, wid = __builtin_amdgcn_readfirstlane(tid >> 6), lane = tid & 63, wr = wid >> 2, wc = wid & 3, fr = lane & 15, fq = lane >> 4;
    const int K = g.K, nt = K / BK;
    unsigned voffA[2], voffB[2];
#pragma unroll
    for (int i = 0; i < 2; ++i) { int R, C; stage_rc(tid * 16 + i * 8192, R, C); const int Rb = Epi::PERM ? ((R & ~31) + perm32(R & 31)) : R;
        voffA[i] = (unsigned)(R * K + C) * 2u; voffB[i] = (unsigned)(Rb * K + C) * 2u; }
    const size_t kstep = (size_t)(BK * 2);
    const size_t hstep = (size_t)HALF * K * 2;
    const size_t tstep = 2 * hstep;
    const unsigned ldsw = (unsigned)wid * 1024u;
    const int aoff = lds_byte(wr * 64 + fr, fq * 8), boff = lds_byte(wc * 32 + fr, fq * 8);
#define PG8_SA(b, h) (((b) * 2 + (h)) * HTB)
#define PG8_SB(b, h) ((4 + (b) * 2 + (h)) * HTB)
#define PG8_STAGE(bufoff, gbase, voff) do { _Pragma("unroll") for (int _i = 0; _i < 2; ++_i) \
        __builtin_amdgcn_global_load_lds((const unsigned*)((const char*)(gbase) + (voff)[_i]), (PG8_LAS unsigned*)(lds + (bufoff) + ldsw + _i * 8192), 16, 0, 0); } while (0)
#define PG8_LDA(dst, b, h) do { _Pragma("unroll") for (int m = 0; m < 4; ++m) _Pragma("unroll") for (int k = 0; k < 2; ++k) dst[m][k] = *(const PG8_LAS bf16x8*)(lds + PG8_SA(b, h) + aoff + m * 2048 + k * 1024); } while (0)
#define PG8_LDB(dst, b, h) do { _Pragma("unroll") for (int n = 0; n < 2; ++n) _Pragma("unroll") for (int k = 0; k < 2; ++k) dst[n][k] = *(const PG8_LAS bf16x8*)(lds + PG8_SB(b, h) + boff + n * 2048 + k * 1024); } while (0)
#define PG8_MMA(ai, bj, At, Bt) do { __builtin_amdgcn_s_setprio(1); _Pragma("unroll") for (int m = 0; m < 4; ++m) _Pragma("unroll") for (int n = 0; n < 2; ++n) _Pragma("unroll") for (int k = 0; k < 2; ++k) \
        acc[ai][bj][m][n] = __builtin_amdgcn_mfma_f32_16x16x32_bf16(Bt[n][k], At[m][k], acc[ai][bj][m][n], 0, 0, 0); __builtin_amdgcn_s_setprio(0); } while (0)
#define PG8_WAIT_V(n) asm volatile("s_waitcnt vmcnt(" #n ")" ::: "memory")
#define PG8_WAIT_L(n) asm volatile("s_waitcnt lgkmcnt(" #n ")" ::: "memory")
#define PG8_BAR __builtin_amdgcn_s_barrier()
#define PG8_SCHED __builtin_amdgcn_sched_barrier(0)
    Unit cur, nxt; int ui = 0;
    if (!S.next(0, cur)) return;
    f32x4 acc[2][2][4][2];
#pragma unroll
    for (int a = 0; a < 2; ++a)
#pragma unroll
        for (int b = 0; b < 2; ++b)
#pragma unroll
            for (int m = 0; m < 4; ++m)
#pragma unroll
                for (int n = 0; n < 2; ++n) acc[a][b][m][n] = (f32x4){0.f, 0.f, 0.f, 0.f};
    bf16x8 At[4][2], B0[2][2], B1[2][2];
    const char* cA = (const char*)g.A + (size_t)cur.pm * tstep; const char* cB = (const char*)g.Bt + (size_t)cur.pn * tstep;
    S.a_ready(cur);
    if constexpr (SP2) {
        PG8_STAGE(PG8_SB(0, 0), cB, voffB); PG8_STAGE(PG8_SB(0, 1), cB + hstep, voffB); PG8_STAGE(PG8_SA(0, 0), cA, voffA); PG8_STAGE(PG8_SA(0, 1), cA + hstep, voffA);
        if (wr == 1) PG8_BAR;
        PG8_WAIT_V(2); PG8_BAR;
        PG8_STAGE(PG8_SB(1, 0), cB + kstep, voffB); PG8_STAGE(PG8_SA(1, 0), cA + kstep, voffA); PG8_STAGE(PG8_SB(1, 1), cB + hstep + kstep, voffB);
        PG8_WAIT_V(6); PG8_BAR;
    } else {
        PG8_STAGE(PG8_SB(0, 0), cB, voffB); PG8_STAGE(PG8_SA(0, 0), cA, voffA); PG8_STAGE(PG8_SB(0, 1), cB + hstep, voffB); PG8_STAGE(PG8_SA(0, 1), cA + hstep, voffA);
        if (wr == 1) PG8_BAR;
        PG8_WAIT_V(4); PG8_BAR;
        PG8_STAGE(PG8_SB(1, 0), cB + kstep, voffB); PG8_STAGE(PG8_SA(1, 0), cA + kstep, voffA); PG8_STAGE(PG8_SB(1, 1), cB + hstep + kstep, voffB);
        PG8_WAIT_V(6); PG8_BAR;
    }
    for (;;) {
        const bool has_next = S.next(ui + 1, nxt);
        const char* nA = has_next ? (const char*)g.A + (size_t)nxt.pm * tstep : cA; const char* nB = has_next ? (const char*)g.Bt + (size_t)nxt.pn * tstep : cB;
        for (int t = 0; t < nt; t += 2) {
            const bool last = (t == nt - 2);
            const char* a1 = cA + (size_t)(t + 1) * kstep;
            const char* a2 = last ? nA : cA + (size_t)(t + 2) * kstep; const char* b2 = last ? nB : cB + (size_t)(t + 2) * kstep;
            const char* a3 = a2 + kstep; const char* b3 = b2 + kstep;
            if (last && has_next) S.a_ready(nxt);
            if constexpr (SP2) {
            PG8_LDB(B0, 0, 0); PG8_LDB(B1, 0, 1); PG8_SCHED; PG8_LDA(At, 0, 0); PG8_STAGE(PG8_SA(1, 1), a1 + hstep, voffA);
            PG8_WAIT_V(8); PG8_WAIT_L(0); PG8_BAR; PG8_MMA(0, 0, At, B0); PG8_MMA(0, 1, At, B1); PG8_BAR; PG8_SCHED;
            PG8_LDA(At, 0, 1); PG8_STAGE(PG8_SB(0, 0), b2, voffB); PG8_STAGE(PG8_SB(0, 1), b2 + hstep, voffB); PG8_STAGE(PG8_SA(0, 0), a2, voffA);
            PG8_WAIT_V(8); PG8_WAIT_L(0); PG8_BAR; PG8_MMA(1, 0, At, B0); PG8_MMA(1, 1, At, B1); PG8_BAR; PG8_SCHED;
            PG8_LDB(B0, 1, 0); PG8_LDB(B1, 1, 1); PG8_SCHED; PG8_LDA(At, 1, 0); PG8_STAGE(PG8_SA(0, 1), a2 + hstep, voffA);
            PG8_WAIT_V(8); PG8_WAIT_L(0); PG8_BAR; PG8_MMA(0, 0, At, B0); PG8_MMA(0, 1, At, B1); PG8_BAR; PG8_SCHED;
            PG8_LDA(At, 1, 1); PG8_STAGE(PG8_SB(1, 0), b3, voffB); PG8_STAGE(PG8_SB(1, 1), b3 + hstep, voffB); PG8_STAGE(PG8_SA(1, 0), a3, voffA);
            PG8_WAIT_V(8); PG8_WAIT_L(0); PG8_BAR; PG8_MMA(1, 0, At, B0); PG8_MMA(1, 1, At, B1); PG8_BAR; PG8_SCHED;
            } else {
            PG8_LDB(B0, 0, 0); PG8_SCHED; PG8_LDA(At, 0, 0); PG8_STAGE(PG8_SA(1, 1), a1 + hstep, voffA);
            PG8_WAIT_L(8); PG8_BAR; PG8_WAIT_L(0); PG8_MMA(0, 0, At, B0); PG8_BAR; PG8_SCHED;
            PG8_LDB(B1, 0, 1); PG8_STAGE(PG8_SB(0, 0), b2, voffB);
            PG8_BAR; PG8_WAIT_L(0); PG8_MMA(0, 1, At, B1); PG8_BAR;
            PG8_LDA(At, 0, 1); PG8_STAGE(PG8_SA(0, 0), a2, voffA);
            PG8_BAR; PG8_WAIT_L(0); PG8_MMA(1, 0, At, B0); PG8_BAR; PG8_SCHED;
            PG8_STAGE(PG8_SB(0, 1), b2 + hstep, voffB);
            PG8_WAIT_V(6); PG8_BAR; PG8_MMA(1, 1, At, B1); PG8_BAR;
            PG8_LDB(B0, 1, 0); PG8_SCHED; PG8_LDA(At, 1, 0); PG8_STAGE(PG8_SA(0, 1), a2 + hstep, voffA);
            PG8_WAIT_L(8); PG8_BAR; PG8_WAIT_L(0); PG8_MMA(0, 0, At, B0); PG8_BAR; PG8_SCHED;
            PG8_LDB(B1, 1, 1); PG8_STAGE(PG8_SB(1, 0), b3, voffB);
            PG8_BAR; PG8_WAIT_L(0); PG8_MMA(0, 1, At, B1); PG8_BAR;
            PG8_LDA(At, 1, 1); PG8_STAGE(PG8_SA(1, 0), a3, voffA);
            PG8_BAR; PG8_WAIT_L(0); PG8_MMA(1, 0, At, B0); PG8_BAR; PG8_SCHED;
            PG8_STAGE(PG8_SB(1, 1), b3 + hstep, voffB);
            PG8_WAIT_V(6); PG8_BAR; PG8_MMA(1, 1, At, B1); PG8_BAR;
            }
        }
        if constexpr (ALIGN_EPI) { if (wr == 0) PG8_BAR; }
        if constexpr (!Epi::AFTER_DRAIN) { E(acc, cur, wr, wc, fr, fq); S.done(cur); }
        if (!has_next) break;
#pragma unroll
        for (int a = 0; a < 2; ++a)
#pragma unroll
            for (int b = 0; b < 2; ++b)
#pragma unroll
                for (int m = 0; m < 4; ++m)
#pragma unroll
                    for (int n = 0; n < 2; ++n) acc[a][b][m][n] = (f32x4){0.f, 0.f, 0.f, 0.f};
        cur = nxt; cA = nA; cB = nB; ++ui;
        if constexpr (ALIGN_EPI) { if (wr == 1) PG8_BAR; }
    }
    PG8_WAIT_V(0);
    if constexpr (!ALIGN_EPI) { if (wr == 0) PG8_BAR; }
    PG8_BAR;
    if constexpr (Epi::AFTER_DRAIN) { E.fused(acc, cur, wr, wc, fr, fq, lds, wid, lane); S.done(cur); }
#undef PG8_SA
#undef PG8_SB
#undef PG8_STAGE
#undef PG8_LDA
#undef PG8_LDB
#undef PG8_MMA
#undef PG8_WAIT_V
#undef PG8_WAIT_L
#undef PG8_BAR
#undef PG8_SCHED
}
}
#define GAS __attribute__((address_space(1)))
#define LAS __attribute__((address_space(3)))
typedef unsigned short bf16;
typedef unsigned v4u __attribute__((ext_vector_type(4)));
typedef float f32x4 __attribute__((ext_vector_type(4)));
typedef short bf16x8 __attribute__((ext_vector_type(8)));
typedef GAS unsigned gu32;
typedef GAS unsigned long long gu64;
#define RLX_AGENT __ATOMIC_RELAXED, __HIP_MEMORY_SCOPE_AGENT
#define LDS_WAIT() asm volatile("s_waitcnt lgkmcnt(0)" ::: "memory")
#define VM_WAIT() asm volatile("s_waitcnt vmcnt(0)" ::: "memory")
__device__ __forceinline__ unsigned long long rt() { return __builtin_amdgcn_s_memrealtime(); }
__device__ __forceinline__ unsigned f2bf(float f) { unsigned u = __builtin_bit_cast(unsigned, f); return (u + 0x7fffu + ((u >> 16) & 1u)) >> 16; }
__device__ __forceinline__ unsigned pk2(float lo, float hi) { return f2bf(lo) | (f2bf(hi) << 16); }

#define XB_TMO      128
#define XB_XCNT(j)  (256  + 64 * (j))
#define XB_XSUB(j)  (1280 + 64 * (j))
#define XB_XGEN(j)  (2304 + 64 * (j))
#define XB_TOP      3328
#define XB_TOPGEN   3392
#define XCD_BAR_WORDS 3456
#define XB_SPIN_CAP (1u << 18)

__device__ __forceinline__ unsigned xb_ld(unsigned* p)              { return __hip_atomic_load(p, __ATOMIC_RELAXED, __HIP_MEMORY_SCOPE_AGENT); }
__device__ __forceinline__ unsigned xb_add(unsigned* p, unsigned v) { return __hip_atomic_fetch_add(p, v, __ATOMIC_RELAXED, __HIP_MEMORY_SCOPE_AGENT); }
__device__ __forceinline__ unsigned xb_xcc_id() { return (unsigned)__builtin_amdgcn_s_getreg((3 << 11) | 20) & 0xFu; }
#define XB_SPIN(cond, bar) do { unsigned _sp = 0; while (cond) { __builtin_amdgcn_s_sleep(1); \
    if ((++_sp & 255u) == 0u) { if (xb_ld(&(bar)[XB_TMO])) break; if (_sp > XB_SPIN_CAP) { atomicAdd(&(bar)[XB_TMO], 1u); break; } } } } while (0)

struct XcdBarrier {
    unsigned wv;
    unsigned* bar; unsigned x;
    volatile LAS unsigned* st;
};

__device__ __forceinline__ bool xb_thread0(unsigned wv) { unsigned z = 0u; asm volatile("" : "+v"(z)); return wv == 0u && __builtin_amdgcn_mbcnt_hi(~0u, __builtin_amdgcn_mbcnt_lo(~0u, z)) == 0u; }
__device__ __forceinline__ XcdBarrier xcd_barrier_post(unsigned* bar, volatile LAS unsigned* st, unsigned wv) {
    XcdBarrier b; b.wv = wv; b.bar = bar; b.x = (unsigned)__builtin_amdgcn_readfirstlane((int)xb_xcc_id());     b.st = st;
    if (xb_thread0(wv)) (void)xb_add(&bar[XB_XCNT(b.x)], 1u);
    return b;
}
__device__ __forceinline__ void xcd_barrier_complete(unsigned* bar, unsigned x, unsigned& nloc, unsigned& nx) {
    const unsigned G = gridDim.x * gridDim.y * gridDim.z;
    unsigned sum, cnt, mine, sp = 0u;
    for (;;) {
        sum = 0u; cnt = 0u; mine = 0u;
#pragma unroll
        for (unsigned j = 0; j < 16; ++j) { const unsigned c = xb_ld(&bar[XB_XCNT(j)]); sum += c; cnt += (c > 0u) ? 1u : 0u; mine = (j == x) ? c : mine; }
        if (sum == G) break;
        __builtin_amdgcn_s_sleep(1);
        if ((++sp & 255u) == 0u) { if (xb_ld(&bar[XB_TMO])) break; if (sp > XB_SPIN_CAP) { atomicAdd(&bar[XB_TMO], 1u); break; } }
    }
    nloc = mine > 0u ? mine : 1u; nx = cnt > 0u ? cnt : 1u;
}

__device__ __forceinline__ void xcd_barrier(const XcdBarrier& b) {
    asm volatile("s_waitcnt vmcnt(0)" ::: "memory");
    __syncthreads();
    if (xb_thread0(b.wv)) {
        unsigned* bar = b.bar;
        __builtin_amdgcn_s_waitcnt(0);
        unsigned nloc = b.st[0], nx = b.st[1];
        if (nloc == 0u) { xcd_barrier_complete(bar, b.x, nloc, nx); b.st[0] = nloc; b.st[1] = nx; }
        const unsigned old = xb_add(&bar[XB_XSUB(b.x)], 1u);
        const unsigned gen = old / nloc;
        if (old + 1u == (gen + 1u) * nloc) {
            __builtin_amdgcn_fence(__ATOMIC_RELEASE, "agent");
            asm volatile("s_waitcnt vmcnt(0)" ::: "memory");
            const unsigned og = xb_add(&bar[XB_TOP], 1u);
            const unsigned tg = og / nx;
            if (og + 1u == (tg + 1u) * nx) xb_add(&bar[XB_TOPGEN], 1u);
            else XB_SPIN(xb_ld(&bar[XB_TOPGEN]) == tg, bar);
            __builtin_amdgcn_fence(__ATOMIC_ACQUIRE, "agent");
            xb_add(&bar[XB_XGEN(b.x)], 1u);
            asm volatile("s_waitcnt vmcnt(0)" ::: "memory");
        } else {
            XB_SPIN(xb_ld(&bar[XB_XGEN(b.x)]) == gen, bar);
            __builtin_amdgcn_fence(__ATOMIC_ACQUIRE, "agent");
            asm volatile("s_waitcnt vmcnt(0)" ::: "memory");
        }
    }
    __syncthreads();
}

constexpr int NWAVES = 8;
constexpr int BATCH = 32, T = 2048, D = 1024, FF = 2816, NL = 2;
constexpr int M = BATCH * T;
constexpr int DIN = 3784;
constexpr int ZN = 4352;
constexpr int ZA = 2304, ZGN = 2048;
constexpr int Z_QL = 0, Z_QI = 1024, Z_PI = 1536, Z_CKV = 2048, Z_KI = 2176, Z_WI = 2240;
constexpr int R_GA = 2304, R_GB = 3328;
constexpr int S_Q = 0, S_CKV = 512, S_QI = 640, S_KI = 1152, S_WI = 1216, S_PI = 1224, S_GA = 1736, S_GB = 2760;
constexpr float EPS = 1e-6f;
constexpr float IDX_SCALE = 0.044194173824159216f;
constexpr float QSCALE = 0.125f * 1.4426950408889634f;

constexpr size_t MiB = 1u << 20;
constexpr size_t WS_CTL = 0, CTL_ZERO_BYTES = 1 * MiB;
constexpr size_t WS_W = 1 * MiB, LW = 46 * MiB + MiB / 2;
constexpr size_t O_WGU1 = 0, O_WD1 = 11 * MiB, O_WIN = 16 * MiB + MiB / 2, O_WA = 25 * MiB, O_WP = 27 * MiB, O_WO = 28 * MiB, O_WGU2 = 30 * MiB, O_WD2 = 41 * MiB;
constexpr size_t WS_XR = 96 * MiB;
constexpr size_t WS_ZA = 224 * MiB;
constexpr size_t WS_ZG = 512 * MiB;
constexpr size_t WS_OL = 768 * MiB;
constexpr size_t WS_XN = WS_OL;
constexpr size_t WS_PO = 896 * MiB;
constexpr size_t WS_CK = 960 * MiB;
constexpr size_t WS_MASK = 976 * MiB;
constexpr size_t WS_END = 992 * MiB;
static_assert(WS_W + NL * LW <= WS_XR && WS_XR + (size_t)M * D * 2 <= WS_ZA && WS_ZA + (size_t)M * ZA * 2 <= WS_ZG && WS_ZG + (size_t)M * ZGN * 2 <= WS_OL && WS_ZA + (size_t)M * FF * 2 <= WS_OL, "d_ws map");
static_assert(O_WD2 + (size_t)D * FF * 2 <= LW && O_WIN + (size_t)ZN * D * 2 <= O_WA, "weight map");
constexpr int CW_TMO = 0, CW_CODE = 1, CW_BAR = 4096;

constexpr int RING_OFF = 0, RING_BYTES = 131072;
constexpr int LDSCTL_OFF = RING_BYTES, MISC_OFF = LDSCTL_OFF + 320;
constexpr int LDS_BYTES = 147456;

struct Args { const float* in[20]; float* out; unsigned char* ws; };
typedef const Args __attribute__((address_space(4)))* cargs_t;
struct Frame {
    LAS unsigned char* lds;
    volatile LAS unsigned* MISC;
    gu32* ctl;
    int wave;
    int vcu, G;
};

typedef unsigned u32x4 __attribute__((ext_vector_type(4)));
typedef unsigned u32x2 __attribute__((ext_vector_type(2)));
typedef float f32x16 __attribute__((ext_vector_type(16)));
typedef short s16x4 __attribute__((ext_vector_type(4)));
using pg8::pk_bf16; using pg8::bf_lo; using pg8::bf_hi;

__device__ __forceinline__ float shx(float v, int m, int lane) { return __int_as_float(__builtin_amdgcn_ds_bpermute((lane ^ m) << 2, __float_as_int(v))); }
__device__ __forceinline__ float wave_sum(float v, int lane) {
#pragma unroll
    for (int o = 1; o < 64; o <<= 1) v += shx(v, o, lane);
    return v;
}
__device__ __forceinline__ int sopq(int v) { asm volatile("" : "+s"(v)); return v; }

__device__ __forceinline__ void tr_item(const float* W, int ldw, int c0, int k0, bf16* WT, int Kd, int drow0, LAS float* scr, int lane) {
#pragma unroll 8
    for (int i = 0; i < 32; ++i) { const int kk = 2 * i + (lane >> 5); scr[kk * 33 + (lane & 31)] = W[(size_t)(k0 + kk) * ldw + c0 + (lane & 31)]; }
    LDS_WAIT(); asm volatile("" ::: "memory");
    const int c = lane & 7;
#pragma unroll
    for (int j = 0; j < 4; ++j) { const int n = (lane >> 3) + 8 * j; const LAS float* s = scr + (8 * c) * 33 + n;
        v4u o; o.x = pk2(s[0 * 33], s[1 * 33]); o.y = pk2(s[2 * 33], s[3 * 33]); o.z = pk2(s[4 * 33], s[5 * 33]); o.w = pk2(s[6 * 33], s[7 * 33]);
        *(GAS v4u*)(WT + (size_t)(drow0 + n) * Kd + k0 + 8 * c) = o; }
    LDS_WAIT(); asm volatile("" ::: "memory");
}
constexpr int I_GU = 16 * 88, I_DN = 44 * 32, I_WO = 16 * 32, I_WIN = 16 * 103, I_ZERO = 1, I_QL = 1024, I_WA = 2048, I_WP = 1024;
constexpr int I_LAYER = 6 * I_GU + I_WO + I_WIN + I_ZERO + I_QL + I_WA + I_WP;
static_assert(I_GU == I_DN, "item counts");

__device__ __forceinline__ void prologue_item(cargs_t ka, int it, LAS float* scr, int lane) {
    const float* const __attribute__((address_space(4)))* in = ka->in; unsigned char* ws = ka->ws;
    const int l = it / I_LAYER; int r = it - l * I_LAYER;
    unsigned char* wl = ws + WS_W + (size_t)l * LW;
    if (r < I_WA) {
        const int hh = r >> 8, cb = (r >> 4) & 15, ib = r & 15, n = 64 * ib + lane;
        const float* wuv = in[9] + (size_t)l * 128 * 8 * 64; const float* wba = in[12] + (size_t)l * 512 * 1024;
        float a[8];
#pragma unroll
        for (int j = 0; j < 8; ++j) a[j] = 0.f;
        for (int d = 0; d < 64; ++d) { const float wv = wba[(size_t)(hh * 64 + d) * 1024 + n];
#pragma unroll
            for (int j = 0; j < 8; ++j) a[j] += wuv[((8 * cb + j) * 8 + hh) * 64 + d] * wv; }
        v4u o; o.x = pk2(a[0], a[1]); o.y = pk2(a[2], a[3]); o.z = pk2(a[4], a[5]); o.w = pk2(a[6], a[7]);
        *(GAS v4u*)((bf16*)(wl + O_WA) + (size_t)n * 1024 + hh * 128 + 8 * cb) = o; return; }
    r -= I_WA;
    if (r < I_WP) {
        const int g = r >> 8, cb = (r >> 4) & 15, ib = r & 15, n = 64 * ib + lane;
        const float* pw = in[10] + (size_t)l * 4 * 128 * 128; const float* ps = in[11] + (size_t)l * 512; const float* wbp = in[13] + (size_t)l * 512 * 1024;
        float a[8];
#pragma unroll
        for (int j = 0; j < 8; ++j) a[j] = 0.f;
        for (int d = 0; d < 128; ++d) { const float wv = wbp[(size_t)(g * 128 + d) * 1024 + n] * ps[g * 128 + d];
#pragma unroll
            for (int j = 0; j < 8; ++j) a[j] += pw[(size_t)(g * 128 + 8 * cb + j) * 128 + d] * wv; }
        v4u o; o.x = pk2(a[0], a[1]); o.y = pk2(a[2], a[3]); o.z = pk2(a[4], a[5]); o.w = pk2(a[6], a[7]);
        *(GAS v4u*)((bf16*)(wl + O_WP) + (size_t)n * 512 + g * 128 + 8 * cb) = o; return; }
    r -= I_WP;
    if (r < I_QL) {
        const int n = r, hh = n >> 7, c = n & 127;
        const float* win = in[6] + (size_t)l * D * DIN; const f32x4* wuk = (const f32x4*)(in[8] + (size_t)l * 128 * 8 * 64 + (size_t)(c * 8 + hh) * 64);
        bf16* dst = (bf16*)(wl + O_WIN) + (size_t)n * D;
        for (int i = 0; i < 16; ++i) { const int k = 64 * i + lane; const f32x4* wr = (const f32x4*)(win + (size_t)k * DIN + hh * 64); float a = 0.f;
#pragma unroll 4
            for (int d4 = 0; d4 < 16; ++d4) { const f32x4 x = wr[d4], y = wuk[d4]; a += (x.x * y.x + x.y * y.y) + (x.z * y.z + x.w * y.w); }
            dst[k] = (bf16)f2bf(a * QSCALE); }
        return; }
    r -= I_QL;
    if (r < I_GU) { const int kb = r / 88, nb = r % 88, n0 = 32 * nb; tr_item(in[2] + (size_t)l * D * FF, FF, n0, 64 * kb, (bf16*)(wl + O_WGU1), D, 256 * (n0 >> 7) + (n0 & 127), scr, lane); return; }
    r -= I_GU;
    if (r < I_GU) { const int kb = r / 88, nb = r % 88, n0 = 32 * nb; tr_item(in[3] + (size_t)l * D * FF, FF, n0, 64 * kb, (bf16*)(wl + O_WGU1), D, 256 * (n0 >> 7) + 128 + (n0 & 127), scr, lane); return; }
    r -= I_GU;
    if (r < I_DN) { const int kb = r / 32, nb = r % 32; tr_item(in[4] + (size_t)l * FF * D, D, 32 * nb, 64 * kb, (bf16*)(wl + O_WD1), FF, 32 * nb, scr, lane); return; }
    r -= I_DN;
    if (r < I_GU) { const int kb = r / 88, nb = r % 88, n0 = 32 * nb; tr_item(in[16] + (size_t)l * D * FF, FF, n0, 64 * kb, (bf16*)(wl + O_WGU2), D, 256 * (n0 >> 7) + (n0 & 127), scr, lane); return; }
    r -= I_GU;
    if (r < I_GU) { const int kb = r / 88, nb = r % 88, n0 = 32 * nb; tr_item(in[17] + (size_t)l * D * FF, FF, n0, 64 * kb, (bf16*)(wl + O_WGU2), D, 256 * (n0 >> 7) + 128 + (n0 & 127), scr, lane); return; }
    r -= I_GU;
    if (r < I_DN) { const int kb = r / 32, nb = r % 32; tr_item(in[18] + (size_t)l * FF * D, D, 32 * nb, 64 * kb, (bf16*)(wl + O_WD2), FF, 32 * nb, scr, lane); return; }
    r -= I_DN;
    if (r < I_WO) { const int kb = r / 32, nb = r % 32; tr_item(in[14] + (size_t)l * D * D, D, 32 * nb, 64 * kb, (bf16*)(wl + O_WO), D, 32 * nb, scr, lane); return; }
    r -= I_WO;
    if (r < I_WIN) {
        const int kb = r / 103, v = 32 * (r % 103); int c0, d0;
        if (v < 512) { c0 = S_QI + v; d0 = Z_QI + v; }
        else if (v < 1024) { c0 = S_PI + (v - 512); d0 = Z_PI + (v - 512); }
        else if (v < 2048) { c0 = S_GA + (v - 1024); d0 = R_GA + (v - 1024); }
        else if (v < 3072) { c0 = S_GB + (v - 2048); d0 = R_GB + (v - 2048); }
        else if (v < 3200) { c0 = S_CKV + (v - 3072); d0 = Z_CKV + (v - 3072); }
        else { c0 = S_KI + (v - 3200); d0 = Z_KI + (v - 3200); }
        tr_item(in[6] + (size_t)l * D * DIN, DIN, c0, 64 * kb, (bf16*)(wl + O_WIN), D, d0, scr, lane); return; }
    r -= I_WIN;
    {
        v4u z; z.x = 0u; z.y = 0u; z.z = 0u; z.w = 0u; GAS v4u* p = (GAS v4u*)((bf16*)(wl + O_WIN) + (size_t)(Z_KI + 96) * D);
        for (int i = lane; i < 32 * D / 8; i += 64) p[i] = z; }
}

__device__ __forceinline__ void rms_phase(const bf16* src, const float* g, bf16* dst, int gw, int NGW, int lane) {
    f32x4 gv[4];
#pragma unroll
    for (int j = 0; j < 4; ++j) gv[j] = ((const f32x4*)g)[64 * j + lane];
    for (int m = gw; m < M; m += NGW) {
        const GAS u32x2* xr = (const GAS u32x2*)(src + (size_t)m * D) + lane;
        f32x4 v[4]; float s = 0.f;
#pragma unroll
        for (int j = 0; j < 4; ++j) { const u32x2 w = xr[64 * j]; v[j].x = bf_lo(w.x); v[j].y = bf_hi(w.x); v[j].z = bf_lo(w.y); v[j].w = bf_hi(w.y); s += (v[j].x * v[j].x + v[j].y * v[j].y) + (v[j].z * v[j].z + v[j].w * v[j].w); }
        const float rstd = 1.f / sqrtf(wave_sum(s, lane) * (1.f / D) + EPS);
        GAS u32x2* o8 = (GAS u32x2*)(dst + (size_t)m * D) + lane;
#pragma unroll
        for (int j = 0; j < 4; ++j) { u32x2 w; w.x = pk_bf16(v[j].x * rstd * gv[j].x, v[j].y * rstd * gv[j].y); w.y = pk_bf16(v[j].z * rstd * gv[j].z, v[j].w * rstd * gv[j].w); o8[64 * j] = w; }
    }
}
__device__ __forceinline__ void rms_phase_in(const float* src, const float* g, bf16* xr_out, bf16* dst, int gw, int NGW, int lane) {
    f32x4 gv[4];
#pragma unroll
    for (int j = 0; j < 4; ++j) gv[j] = ((const f32x4*)g)[64 * j + lane];
    for (int m = gw; m < M; m += NGW) {
        const GAS f32x4* xr = (const GAS f32x4*)(src + (size_t)m * D) + lane;
        f32x4 v[4]; float s = 0.f;
#pragma unroll
        for (int j = 0; j < 4; ++j) { v[j] = xr[64 * j]; s += (v[j].x * v[j].x + v[j].y * v[j].y) + (v[j].z * v[j].z + v[j].w * v[j].w); }
        const float rstd = 1.f / sqrtf(wave_sum(s, lane) * (1.f / D) + EPS);
        GAS u32x2* o8 = (GAS u32x2*)(dst + (size_t)m * D) + lane; GAS u32x2* x8 = (GAS u32x2*)(xr_out + (size_t)m * D) + lane;
#pragma unroll
        for (int j = 0; j < 4; ++j) { u32x2 w; w.x = pk_bf16(v[j].x * rstd * gv[j].x, v[j].y * rstd * gv[j].y); w.y = pk_bf16(v[j].z * rstd * gv[j].z, v[j].w * rstd * gv[j].w); o8[64 * j] = w;
            u32x2 q; q.x = pk_bf16(v[j].x, v[j].y); q.y = pk_bf16(v[j].z, v[j].w); x8[64 * j] = q; }
    }
}
__device__ __forceinline__ void final_norm_phase(const bf16* src, float* out, const float* g, int gw, int NGW, int lane, bool poison) {
    f32x4 gv[4];
#pragma unroll
    for (int j = 0; j < 4; ++j) gv[j] = ((const f32x4*)g)[64 * j + lane];
    const float qnan = __builtin_nanf("");
    for (int m = gw; m < M; m += NGW) {
        const GAS u32x2* xr = (const GAS u32x2*)(src + (size_t)m * D) + lane;
        f32x4 v[4]; float s = 0.f;
#pragma unroll
        for (int j = 0; j < 4; ++j) { const u32x2 w = xr[64 * j]; v[j].x = bf_lo(w.x); v[j].y = bf_hi(w.x); v[j].z = bf_lo(w.y); v[j].w = bf_hi(w.y); s += (v[j].x * v[j].x + v[j].y * v[j].y) + (v[j].z * v[j].z + v[j].w * v[j].w); }
        float rstd = 1.f / sqrtf(wave_sum(s, lane) * (1.f / D) + EPS);
        if (poison) rstd = qnan;
        GAS f32x4* o = (GAS f32x4*)(out + (size_t)m * D) + lane;
#pragma unroll
        for (int j = 0; j < 4; ++j) o[64 * j] = v[j] * rstd * gv[j];
    }
}
__device__ __forceinline__ void prep_phase(const bf16* Z, const float* gkv, bf16* CK, bf16* PO, int gw, int NGW, int lane) {
    {
        const int sub = lane >> 4, ch = lane & 15;
        float gk[8];
#pragma unroll
        for (int e = 0; e < 8; ++e) gk[e] = gkv[8 * ch + e];
        for (int r4 = gw; r4 < M / 4; r4 += NGW) {
            const size_t m = (size_t)r4 * 4 + sub;
            const u32x4 w = *(const GAS u32x4*)(Z + m * ZA + Z_CKV + 8 * ch);
            float x[8] = {bf_lo(w.x), bf_hi(w.x), bf_lo(w.y), bf_hi(w.y), bf_lo(w.z), bf_hi(w.z), bf_lo(w.w), bf_hi(w.w)};
            float s = 0.f;
#pragma unroll
            for (int e = 0; e < 8; ++e) s += x[e] * x[e];
            s += shx(s, 1, lane); s += shx(s, 2, lane); s += shx(s, 4, lane); s += shx(s, 8, lane);
            const float rstd = 1.f / sqrtf(s * (1.f / 128.f) + EPS);
            u32x4 o; o.x = pk_bf16(x[0] * rstd * gk[0], x[1] * rstd * gk[1]); o.y = pk_bf16(x[2] * rstd * gk[2], x[3] * rstd * gk[3]);
            o.z = pk_bf16(x[4] * rstd * gk[4], x[5] * rstd * gk[5]); o.w = pk_bf16(x[6] * rstd * gk[6], x[7] * rstd * gk[7]);
            *(GAS u32x4*)(CK + m * 128 + 8 * ch) = o;
        }
    }
    {
        const int wdw = 2 << (lane >> 4);
        for (int mm = gw * 32; mm < M; mm += NGW * 32)
        for (int m = mm; m < mm + 32; ++m) {
            const int t = m & (T - 1); const int cnt = (t + 1) < wdw ? (t + 1) : wdw;
            const bf16* p = Z + (size_t)m * ZA + Z_PI + 8 * lane;
            float a[8], self[8];
#pragma unroll
            for (int e = 0; e < 8; ++e) { a[e] = 0.f; self[e] = 0.f; }
#pragma unroll
            for (int i = 0; i < 16; ++i) {
                if (i < cnt) {
                    const u32x4 w = *(const GAS u32x4*)(p - (size_t)i * ZA);
                    const float x[8] = {bf_lo(w.x), bf_hi(w.x), bf_lo(w.y), bf_hi(w.y), bf_lo(w.z), bf_hi(w.z), bf_lo(w.w), bf_hi(w.w)};
#pragma unroll
                    for (int e = 0; e < 8; ++e) { a[e] += x[e]; if (i == 0) self[e] = x[e]; }
                }
            }
            const float inv = 1.f / (float)cnt;
            u32x4 o; o.x = pk_bf16(a[0] * inv - self[0], a[1] * inv - self[1]); o.y = pk_bf16(a[2] * inv - self[2], a[3] * inv - self[3]);
            o.z = pk_bf16(a[4] * inv - self[4], a[5] * inv - self[5]); o.w = pk_bf16(a[6] * inv - self[6], a[7] * inv - self[7]);
            *(GAS u32x4*)(PO + (size_t)m * 512 + 8 * lane) = o;
        }
    }
}

__device__ __forceinline__ bool mix_unit(int i, int vcu, int G, int& b, int& qb) {
    const int U = vcu + i * G; if (U >= BATCH * 64) return false;
    const int ii = U >> 8, r = U & 7; b = (U & 255) >> 3; qb = (ii & 1) ? 16 * (ii >> 1) + 15 - r : 16 * (ii >> 1) + r; return true;
}
__device__ __forceinline__ unsigned fkey(float s) { const unsigned u = __float_as_uint(s); return (u & 0x80000000u) ? ~u : (u | 0x80000000u); }
__device__ __forceinline__ float funkey(unsigned k) { return __uint_as_float((k & 0x80000000u) ? (k & 0x7fffffffu) : ~k); }
__device__ __forceinline__ unsigned half_sum(unsigned v, int hh) {
    v += (unsigned)__builtin_amdgcn_update_dpp(0, (int)v, 0xB1, 0xF, 0xF, false);
    v += (unsigned)__builtin_amdgcn_update_dpp(0, (int)v, 0x4E, 0xF, 0xF, false);
    v += (unsigned)__builtin_amdgcn_update_dpp(0, (int)v, 0x141, 0xF, 0xF, false);
    v += (unsigned)__builtin_amdgcn_update_dpp(0, (int)v, 0x140, 0xF, 0xF, false);
    const unsigned a = __builtin_amdgcn_readlane(v, 0) + __builtin_amdgcn_readlane(v, 16), b = __builtin_amdgcn_readlane(v, 32) + __builtin_amdgcn_readlane(v, 48);
    return hh ? b : a;
}
__device__ __forceinline__ float rl_f(float v, int l) { return __uint_as_float((unsigned)__builtin_amdgcn_readlane((int)__float_as_uint(v), l)); }
__device__ __forceinline__ float half_max(float v, int hh) {
    v = fmaxf(v, __builtin_amdgcn_update_dpp(v, v, 0xB1, 0xF, 0xF, false)); v = fmaxf(v, __builtin_amdgcn_update_dpp(v, v, 0x4E, 0xF, 0xF, false));
    v = fmaxf(v, __builtin_amdgcn_update_dpp(v, v, 0x141, 0xF, 0xF, false)); v = fmaxf(v, __builtin_amdgcn_update_dpp(v, v, 0x140, 0xF, 0xF, false));
    const float a = fmaxf(rl_f(v, 0), rl_f(v, 16)), b = fmaxf(rl_f(v, 32), rl_f(v, 48));
    return hh ? b : a;
}
__device__ __forceinline__ float half_min(float v, int hh) {
    v = fminf(v, __builtin_amdgcn_update_dpp(v, v, 0xB1, 0xF, 0xF, false)); v = fminf(v, __builtin_amdgcn_update_dpp(v, v, 0x4E, 0xF, 0xF, false));
    v = fminf(v, __builtin_amdgcn_update_dpp(v, v, 0x141, 0xF, 0xF, false)); v = fminf(v, __builtin_amdgcn_update_dpp(v, v, 0x140, 0xF, 0xF, false));
    const float a = fminf(rl_f(v, 0), rl_f(v, 16)), b = fminf(rl_f(v, 32), rl_f(v, 48));
    return hh ? b : a;
}
__device__ __forceinline__ float sel_cand(float lo, float hi, float glo, float ghi) {
    float c = lo + (hi - lo) * (glo / (glo - ghi));
    if (!(c > lo && c < hi)) c = funkey((fkey(lo) >> 1) + (fkey(hi) >> 1) + (fkey(lo) & fkey(hi) & 1u));
    return c;
}

__device__ __forceinline__ void select_unit(const bf16* Z, unsigned* MASK, int b, int qb, int wid, int lane_in) {
    int lane = lane_in; asm volatile("" : "+v"(lane));
    const int col = lane & 31, hh = lane >> 5;
    const size_t mb = (size_t)b * T + 32 * qb + 4 * wid;
    const int tql_r = 2 * (col >> 4) + ((col >> 2) & 1), j_r = 4 * ((col >> 3) & 1) + (col & 3);
    bf16x8 qa[4];
#pragma unroll
    for (int s = 0; s < 4; ++s) qa[s] = *(const GAS bf16x8*)(Z + (mb + tql_r) * ZA + Z_QI + j_r * 64 + 16 * s + 8 * hh);
    float wA[8], wB[8];
    { const u32x4 a = *(const GAS u32x4*)(Z + (mb + hh) * ZA + Z_WI), c = *(const GAS u32x4*)(Z + (mb + 2 + hh) * ZA + Z_WI);
      wA[0] = bf_lo(a.x) * IDX_SCALE; wA[1] = bf_hi(a.x) * IDX_SCALE; wA[2] = bf_lo(a.y) * IDX_SCALE; wA[3] = bf_hi(a.y) * IDX_SCALE;
      wA[4] = bf_lo(a.z) * IDX_SCALE; wA[5] = bf_hi(a.z) * IDX_SCALE; wA[6] = bf_lo(a.w) * IDX_SCALE; wA[7] = bf_hi(a.w) * IDX_SCALE;
      wB[0] = bf_lo(c.x) * IDX_SCALE; wB[1] = bf_hi(c.x) * IDX_SCALE; wB[2] = bf_lo(c.y) * IDX_SCALE; wB[3] = bf_hi(c.y) * IDX_SCALE;
      wB[4] = bf_lo(c.z) * IDX_SCALE; wB[5] = bf_hi(c.z) * IDX_SCALE; wB[6] = bf_lo(c.w) * IDX_SCALE; wB[7] = bf_hi(c.w) * IDX_SCALE; }
    const int dA = 32 * qb + 4 * wid + hh - col, dB = dA + 2;
    float sA[64], sB[64];
    const bf16* kp = Z + ((size_t)b * T + col) * ZA + Z_KI + 8 * hh;
    bf16x8 kn[4];
#pragma unroll
    for (int s = 0; s < 4; ++s) kn[s] = *(const GAS bf16x8*)(kp + 16 * s);
#pragma unroll
    for (int kt = 0; kt < 64; ++kt) {
        sA[kt] = -INFINITY; sB[kt] = -INFINITY;
        if (kt <= qb) {
            bf16x8 kc[4];
#pragma unroll
            for (int s = 0; s < 4; ++s) kc[s] = kn[s];
            if (kt + 1 <= qb) {
                kp += (size_t)32 * ZA; asm volatile("" : "+v"(kp));
#pragma unroll
                for (int s = 0; s < 4; ++s) kn[s] = *(const GAS bf16x8*)(kp + 16 * s);
            }
            f32x16 acc;
#pragma unroll
            for (int i = 0; i < 16; ++i) acc[i] = 0.f;
#pragma unroll
            for (int s = 0; s < 4; ++s) acc = __builtin_amdgcn_mfma_f32_32x32x16_bf16(qa[s], kc[s], acc, 0, 0, 0);
            float sa = 0.f, sb = 0.f;
#pragma unroll
            for (int j = 0; j < 8; ++j) { sa = fmaf(fmaxf(acc[j], 0.f), wA[j], sa); sb = fmaf(fmaxf(acc[8 + j], 0.f), wB[j], sb); }
            sA[kt] = (32 * kt <= dA) ? sa : -INFINITY; sB[kt] = (32 * kt <= dB) ? sb : -INFINITY;
        }
        __builtin_amdgcn_sched_barrier(0);
    }
    float thrA = -3.0e38f, thrB = -3.0e38f;
    if (qb >= 8) {
        float mnA = sA[0], mnB = sB[0], mxA = sA[0], mxB = sB[0];
#pragma unroll
        for (int k = 1; k < 8; ++k) { mnA = fminf(mnA, sA[k]); mnB = fminf(mnB, sB[k]); }
#pragma unroll
        for (int c8 = 0; c8 < 8; ++c8) {
            if (8 * c8 <= qb) {
#pragma unroll
                for (int k = 0; k < 8; ++k) { mxA = fmaxf(mxA, sA[8 * c8 + k]); mxB = fmaxf(mxB, sB[8 * c8 + k]); }
            }
        }
        float loA = half_min(mnA, hh), loB = half_min(mnB, hh);
        float hiA = funkey(fkey(half_max(mxA, hh)) + 1u), hiB = funkey(fkey(half_max(mxB, hh)) + 1u);
        const float nv = (float)(32 * qb + 16);
        float gloA = nv - 256.5f, ghiA = -256.5f, gloB = gloA, ghiB = ghiA;
        int sdA = 0, sdB = 0;
        unsigned nloA = 0x40000000u, nhiA = 0u, nloB = 0x40000000u, nhiB = 0u;
        int stA = 0, stB = 0;
        bool dnA = false, dnB = false;
#pragma unroll 1
        for (int it = 0; it < 96; ++it) {
            const float cA = sel_cand(loA, hiA, gloA, ghiA), cB = sel_cand(loB, hiB, gloB, ghiB);
            unsigned nA = 0u, nB = 0u;
#pragma unroll
            for (int c8 = 0; c8 < 8; ++c8) {
                if (8 * c8 <= qb) {
#pragma unroll
                    for (int k = 0; k < 8; ++k) { nA += (sA[8 * c8 + k] >= cA) ? 1u : 0u; nB += (sB[8 * c8 + k] >= cB) ? 1u : 0u; }
                }
            }
            nA = half_sum(nA, hh); nB = half_sum(nB, hh);
            if (!dnA) {
                const float g = (float)nA - 256.5f; const unsigned w0_ = nloA - nhiA;
                if (nA == 256u) { loA = cA; dnA = true; }
                else if (nA > 256u) { loA = cA; nloA = nA; gloA = g; if (sdA > 0) ghiA *= 0.5f; sdA = 1; }
                else { hiA = cA; nhiA = nA; ghiA = g; if (sdA < 0) gloA *= 0.5f; sdA = -1; }
                stA = (nloA - nhiA == w0_) ? stA + 1 : 0;
                if (!dnA && fkey(hiA) - fkey(loA) <= 1u) dnA = true;
            }
            if (!dnB) {
                const float g = (float)nB - 256.5f; const unsigned w0_ = nloB - nhiB;
                if (nB == 256u) { loB = cB; dnB = true; }
                else if (nB > 256u) { loB = cB; nloB = nB; gloB = g; if (sdB > 0) ghiB *= 0.5f; sdB = 1; }
                else { hiB = cB; nhiB = nB; ghiB = g; if (sdB < 0) gloB *= 0.5f; sdB = -1; }
                stB = (nloB - nhiB == w0_) ? stB + 1 : 0;
                if (!dnB && fkey(hiB) - fkey(loB) <= 1u) dnB = true;
            }
            if (__all(dnA && dnB)) break;
            if (__any((!dnA && stA >= 2) || (!dnB && stB >= 2))) {
                float mnA_ = INFINITY, mxA_ = -INFINITY, mnB_ = INFINITY, mxB_ = -INFINITY;
#pragma unroll
                for (int c8 = 0; c8 < 8; ++c8) {
                    if (8 * c8 <= qb) {
#pragma unroll
                        for (int k = 0; k < 8; ++k) {
                            const float a = sA[8 * c8 + k], b2 = sB[8 * c8 + k];
                            const bool ia = (a >= loA) && (a < hiA), ib = (b2 >= loB) && (b2 < hiB);
                            mnA_ = ia ? fminf(mnA_, a) : mnA_; mxA_ = ia ? fmaxf(mxA_, a) : mxA_;
                            mnB_ = ib ? fminf(mnB_, b2) : mnB_; mxB_ = ib ? fmaxf(mxB_, b2) : mxB_;
                        }
                    }
                }
                mnA_ = half_min(mnA_, hh); mxA_ = half_max(mxA_, hh); mnB_ = half_min(mnB_, hh); mxB_ = half_max(mxB_, hh);
                if (!dnA && stA >= 2) { if (mnA_ == mxA_) { loA = mnA_; dnA = true; } else { loA = mnA_; hiA = funkey(fkey(mxA_) + 1u); stA = 0; } }
                if (!dnB && stB >= 2) { if (mnB_ == mxB_) { loB = mnB_; dnB = true; } else { loB = mnB_; hiB = funkey(fkey(mxB_) + 1u); stB = 0; } }
                if (__all(dnA && dnB)) break;
            }
        }
        thrA = loA; thrB = loB;
    }
    unsigned w0 = 0u, w1 = 0u, w2 = 0u, w3 = 0u;
    int lane2 = lane; asm volatile("" : "+v"(lane2));
#pragma unroll
    for (int kt = 0; kt < 64; ++kt) {
        const unsigned long long bA = __ballot(sA[kt] >= thrA), bB = __ballot(sB[kt] >= thrB);
        const bool mine = (lane2 == kt);
        w0 = mine ? (unsigned)bA : w0; w1 = mine ? (unsigned)(bA >> 32) : w1; w2 = mine ? (unsigned)bB : w2; w3 = mine ? (unsigned)(bB >> 32) : w3;
    }
    GAS unsigned* mo = (GAS unsigned*)MASK + mb * 64 + lane;
    mo[0] = w0; mo[64] = w1; mo[128] = w2; mo[192] = w3;
}

__device__ __forceinline__ unsigned off_b(unsigned row, unsigned ch) { return 256u * row + 16u * (ch ^ (((row & 3u) << 2) | ((row >> 2) & 3u))); }
__device__ __forceinline__ s16x4 vtr(const LAS unsigned char* p) { typedef short v4i16_t __attribute__((ext_vector_type(4))); return __builtin_bit_cast(s16x4, __builtin_amdgcn_ds_read_tr16_b64_v4i16((LAS v4i16_t*)p)); }
__device__ __forceinline__ void attn_unit(LAS unsigned char* kbuf, const bf16* Z, const bf16* CK, const unsigned* MASK, bf16* OL, const float* gkv, int b, int qb, int wid, int lane_in) {
    int lane = lane_in; asm volatile("" : "+v"(lane));
    const int r32 = lane & 31, hh = lane >> 5, tql = r32 >> 3, head = r32 & 7;
    const size_t m = (size_t)b * T + 32 * qb + 4 * wid + tql;
    bf16x8 qf[8];
#pragma unroll
    for (int s = 0; s < 8; ++s) qf[s] = *(const GAS bf16x8*)(Z + m * ZA + Z_QL + head * 128 + 16 * s + 8 * hh);
    const GAS unsigned* mrow = (const GAS unsigned*)MASK + m * 64;
    float mref;
    { float gm = fmaxf(fabsf(gkv[lane]), fabsf(gkv[lane + 64]));
#pragma unroll
      for (int o = 1; o < 64; o <<= 1) gm = fmaxf(gm, shx(gm, o, lane));
      float qn = 0.f;
#pragma unroll
      for (int s = 0; s < 8; ++s)
#pragma unroll
          for (int e = 0; e < 8; ++e) { const float x = __uint_as_float(((unsigned)(unsigned short)qf[s][e]) << 16); qn += x * x; }
      qn += shx(qn, 32, lane);
      mref = fminf(sqrtf(qn) * gm * (1.02f * 11.313708499f), 60.f); }
    f32x16 zero16;
#pragma unroll
    for (int i = 0; i < 16; ++i) zero16[i] = 0.f;
    f32x16 o[4];
#pragma unroll
    for (int dt = 0; dt < 4; ++dt)
#pragma unroll
        for (int i = 0; i < 16; ++i) o[dt][i] = 0.f;
    float lrun = 0.f;
    const int ns = (qb + 8) >> 3;
    const int lr = lane >> 4;
    const bf16* gsrc0 = CK + ((size_t)b * T + 32 * wid + lr) * 128;
    LAS unsigned char* ldst0 = kbuf + (32 * wid) * 256;
#define ATT_DMA_STAGE(st_) do { _Pragma("unroll") for (int i_ = 0; i_ < 8; ++i_) { const int ch_ = (lane & 15) ^ ((lr << 2) | (i_ & 3)); \
        __builtin_amdgcn_global_load_lds((const unsigned*)(gsrc0 + (size_t)(st_) * 256 * 128 + i_ * 4 * 128 + 8 * ch_), (LAS unsigned*)(ldst0 + ((st_) & 1) * 65536 + i_ * 1024), 16, 0, 0); } } while (0)
    const unsigned q4 = (lane & 15) >> 2, p4 = lane & 3, blk = (lane >> 4) & 1;
    const unsigned fh = (unsigned)r32 & 3u, fl = ((unsigned)r32 >> 2) & 3u;
    const unsigned kl0 = 256u * (unsigned)r32 + 16u * (((unsigned)hh ^ fl) & 3u), kl1 = 256u * (unsigned)r32 + 16u * (((2u + (unsigned)hh) ^ fl) & 3u);
#define ATT_KA(s_) ((((s_) & 1) ? kl1 : kl0) + 64u * ((unsigned)((s_) >> 1) ^ fh))
    const unsigned vb = 256u * (4u * hh + q4) + 8u * (p4 & 1u), cl = 2u * blk + (p4 >> 1);
    const unsigned vlo0 = vb + 16u * ((cl ^ (unsigned)hh) & 3u), vlo1 = vb + 2048u + 16u * ((cl ^ (2u + (unsigned)hh)) & 3u);
    asm volatile("s_waitcnt lgkmcnt(0)" ::: "memory"); __builtin_amdgcn_s_barrier(); asm volatile("" ::: "memory");
    u32x4 mw0 = *(const GAS u32x4*)(mrow), mw1 = *(const GAS u32x4*)(mrow + 4);
    ATT_DMA_STAGE(0);
    for (int st = 0; st < ns; ++st) {
        asm volatile("s_waitcnt vmcnt(0) lgkmcnt(0)" ::: "memory"); __builtin_amdgcn_s_barrier(); asm volatile("" ::: "memory");
        if (st + 1 < ns) ATT_DMA_STAGE(st + 1);
        const LAS unsigned char* sb = kbuf + (st & 1) * 65536;
#define ATT_QK(S_, k_) do { bf16x8 kf_[2]; \
        _Pragma("unroll") for (int s_ = 0; s_ < 8; s_ += 2) { kf_[0] = *(const LAS bf16x8*)(sb + (k_) * 8192 + ATT_KA(s_)); kf_[1] = *(const LAS bf16x8*)(sb + (k_) * 8192 + ATT_KA(s_ + 1)); \
            S_ = __builtin_amdgcn_mfma_f32_32x32x16_bf16(kf_[0], qf[s_], s_ == 0 ? zero16 : S_, 0, 0, 0); S_ = __builtin_amdgcn_mfma_f32_32x32x16_bf16(kf_[1], qf[s_ + 1], S_, 0, 0, 0); } } while (0)
        f32x16 S;
        ATT_QK(S, 0);
#pragma unroll
        for (int k = 0; k < 8; ++k) {
            const LAS unsigned char* kb = sb + k * 8192;
            const unsigned wsh = (k < 4 ? mw0[k & 3] : mw1[k & 3]) >> (4 * hh);
            float ps = 0.f;
#pragma unroll
            for (int i = 0; i < 16; ++i) { const int pos = (i & 3) + 8 * (i >> 2);
                const unsigned sel = (unsigned)(((int)(wsh << (31 - pos))) >> 31);
                S[i] = __uint_as_float(__float_as_uint(__builtin_amdgcn_exp2f(S[i] - mref)) & sel); ps += S[i]; }
            lrun += ps;
            bf16x8 pf[2];
#pragma unroll
            for (int s = 0; s < 2; ++s) { u32x4 pw; pw.x = pk_bf16(S[8 * s + 0], S[8 * s + 1]); pw.y = pk_bf16(S[8 * s + 2], S[8 * s + 3]); pw.z = pk_bf16(S[8 * s + 4], S[8 * s + 5]); pw.w = pk_bf16(S[8 * s + 6], S[8 * s + 7]); pf[s] = __builtin_bit_cast(bf16x8, pw); }
            if (k < 7) ATT_QK(S, k + 1);
#pragma unroll
            for (int dt = 0; dt < 4; ++dt)
#pragma unroll
                for (int s = 0; s < 2; ++s) {
                    const s16x4 lo = vtr(kb + 4096 * s + vlo0 + 64u * ((unsigned)dt ^ q4));
                    const s16x4 hi = vtr(kb + 4096 * s + vlo1 + 64u * ((unsigned)dt ^ q4));
                    const bf16x8 vt = __builtin_shufflevector(lo, hi, 0, 1, 2, 3, 4, 5, 6, 7);
                    o[dt] = __builtin_amdgcn_mfma_f32_32x32x16_bf16(vt, pf[s], o[dt], 0, 0, 0);
                }
            if (k == 3) mw0 = *(const GAS u32x4*)(mrow + 8 * (st + 1));
            if (k == 7) mw1 = *(const GAS u32x4*)(mrow + 8 * (st + 1) + 4);
            __builtin_amdgcn_sched_barrier(0);
        }
#undef ATT_QK
#undef ATT_KA
    }
#undef ATT_DMA_STAGE
    lrun += shx(lrun, 32, lane);
    const float inv = 1.f / lrun;
    bf16* orow = OL + m * 1024 + head * 128 + 4 * hh;
#pragma unroll
    for (int dt = 0; dt < 4; ++dt)
#pragma unroll
        for (int g = 0; g < 4; ++g) { u32x2 w; w.x = pk_bf16(o[dt][4 * g] * inv, o[dt][4 * g + 1] * inv); w.y = pk_bf16(o[dt][4 * g + 2] * inv, o[dt][4 * g + 3] * inv);
            *(GAS u32x2*)(orow + 32 * dt + 8 * g) = w; }
}

__device__ __forceinline__ cargs_t kargs() { cargs_t p = (cargs_t)__builtin_amdgcn_kernarg_segment_ptr(); asm volatile("" : "+s"(p)); return p; }
__device__ __forceinline__ int lane_id() { unsigned z = 0u; asm volatile("" : "+v"(z)); int v = (int)__builtin_amdgcn_mbcnt_hi(~0u, __builtin_amdgcn_mbcnt_lo(~0u, z)); asm volatile("" : "+v"(v)); return v; }
__global__ void __launch_bounds__(NWAVES * 64, 2) fwd(Args args_unused) {
    extern __shared__ __attribute__((aligned(16))) unsigned char lds[];
    Frame F;
    F.lds = (LAS unsigned char*)lds;
    F.MISC = (volatile LAS unsigned*)(F.lds + MISC_OFF);
    F.wave = __builtin_amdgcn_readfirstlane((int)threadIdx.x >> 6);
    F.G = gridDim.x; { const int bx = blockIdx.x; F.vcu = (F.G % 8 == 0) ? (bx % 8) * (F.G / 8) + bx / 8 : bx; }
    F.ctl = (gu32*)(kargs()->ws + WS_CTL);
    for (int u = threadIdx.x; u < (LDS_BYTES - LDSCTL_OFF) / 4; u += NWAVES * 64) ((LAS unsigned*)(F.lds + LDSCTL_OFF))[u] = 0u;
    __syncthreads();
    XcdBarrier bar = xcd_barrier_post((unsigned*)(F.ctl + CW_BAR), F.MISC + 8, (unsigned)F.wave);
#define GRID_BAR() xcd_barrier(bar)
    const int gw = F.vcu * NWAVES + F.wave, NGW = F.G * NWAVES;
#define WSP(off) (kargs()->ws + (off))

    {
        LAS float* scr = (LAS float*)(F.lds + RING_OFF + F.wave * 16384);
        const cargs_t a = kargs(); const int lane = lane_id();
        for (int rep_ = 0; rep_ < (PROBE_DUP == 1 ? 2 : 1); ++rep_) {
        for (int it = sopq(gw); it < NL * I_LAYER; it += NGW) prologue_item(a, it, scr, lane);
        rms_phase_in(a->in[0], a->in[1], (bf16*)(a->ws + WS_XR), (bf16*)(a->ws + WS_XN), sopq(gw), NGW, lane);
        GRID_BAR(); }
    }
#define GEMM_PHASE(EPI_T, A_, B_, N_, K_, E_) do { const pg8::Gemm g_{(const pg8::bf16_t*)(A_), (const pg8::bf16_t*)(B_), M, (N_), (K_)}; pg8::StaticOrder S_; S_.init(M, (N_), F.G, (int)blockIdx.x); \
        pg8::gemm_phase<EPI_T, pg8::StaticOrder, true, true>(F.lds + RING_OFF, g_, S_, (E_), F.wave); } while (0)

    for (int fi = 0; fi < 2 * NL; ++fi) {
        const int l = fi >> 1; const bool second = (fi & 1) != 0;
        const size_t wlo = WS_W + (size_t)l * LW;
        if (fi > 0) for (int rep_ = 0; rep_ < (PROBE_DUP == 1 ? 2 : 1); ++rep_) { const cargs_t a = kargs(); rms_phase((const bf16*)(a->ws + WS_XR), (second ? a->in[15] : a->in[1]) + (size_t)l * D, (bf16*)(a->ws + WS_XN), sopq(gw), NGW, lane_id()); GRID_BAR(); }
        for (int rep_ = 0; rep_ < (PROBE_DUP == 5 ? 2 : 1); ++rep_) { const cargs_t a = kargs(); const pg8::EpiSwiglu E{(pg8::bf16_t*)(a->ws + WS_ZA), FF}; GEMM_PHASE(pg8::EpiSwiglu, a->ws + WS_XN, a->ws + wlo + (second ? O_WGU2 : O_WGU1), 2 * FF, D, E); GRID_BAR(); }
        { const cargs_t a = kargs(); const pg8::EpiResid<1> E{(pg8::bf16_t*)(a->ws + WS_XR), D}; GEMM_PHASE(pg8::EpiResid<1>, a->ws + WS_ZA, a->ws + wlo + (second ? O_WD2 : O_WD1), D, FF, E); GRID_BAR(); }
        if (!second) {
            for (int rep_ = 0; rep_ < (PROBE_DUP == 1 ? 2 : 1); ++rep_) { const cargs_t a = kargs(); rms_phase((const bf16*)(a->ws + WS_XR), a->in[5] + (size_t)l * D, (bf16*)(a->ws + WS_XN), sopq(gw), NGW, lane_id()); GRID_BAR(); }
            for (int rep_ = 0; rep_ < (PROBE_DUP == 6 ? 2 : 1); ++rep_) { const cargs_t a = kargs(); const pg8::EpiPlainBf16 E{(pg8::bf16_t*)(a->ws + WS_ZA), ZA, (pg8::bf16_t*)(a->ws + WS_ZG), ZGN, ZA / 256}; GEMM_PHASE(pg8::EpiPlainBf16, a->ws + WS_XN, a->ws + wlo + O_WIN, ZN, D, E); GRID_BAR(); }
            { const cargs_t a = kargs(); const int lane = lane_id();
              for (int rep_ = 0; rep_ < (PROBE_DUP == 2 ? 2 : 1); ++rep_)
              prep_phase((const bf16*)(a->ws + WS_ZA), a->in[7] + (size_t)l * 128, (bf16*)(a->ws + WS_CK), (bf16*)(a->ws + WS_PO), sopq(gw), NGW, lane);
              for (int rep_ = 0; rep_ < (PROBE_DUP == 4 ? 2 : 1); ++rep_) {
              int b, qb; for (int i = 0; mix_unit(i, F.vcu, F.G, b, qb); ++i) select_unit((const bf16*)(a->ws + WS_ZA), (unsigned*)(a->ws + WS_MASK), b, qb, F.wave, lane); }
              GRID_BAR(); }
            for (int rep_ = 0; rep_ < (PROBE_DUP == 3 ? 2 : 1); ++rep_) { const cargs_t a = kargs(); const int tid = F.wave * 64 + lane_id();
              int b, qb; for (int i = 0; mix_unit(i, F.vcu, F.G, b, qb); ++i) attn_unit(F.lds + RING_OFF, (const bf16*)(a->ws + WS_ZA), (const bf16*)(a->ws + WS_CK), (const unsigned*)(a->ws + WS_MASK), (bf16*)(a->ws + WS_OL), a->in[7] + (size_t)l * 128, b, qb, F.wave, tid & 63);
              asm volatile("s_waitcnt vmcnt(0) lgkmcnt(0)" ::: "memory"); __syncthreads();
              GRID_BAR(); }
            { const cargs_t a = kargs(); const pg8::EpiGate<false> E{(pg8::bf16_t*)(a->ws + WS_ZA), D, (const pg8::bf16_t*)(a->ws + WS_ZG), ZGN}; GEMM_PHASE(pg8::EpiGate<false>, a->ws + WS_OL, a->ws + wlo + O_WA, D, D, E); GRID_BAR(); }
            { const cargs_t a = kargs(); const pg8::EpiGate<true> E{(pg8::bf16_t*)(a->ws + WS_ZA), D, (const pg8::bf16_t*)(a->ws + WS_ZG) + 1024, ZGN}; GEMM_PHASE(pg8::EpiGate<true>, a->ws + WS_PO, a->ws + wlo + O_WP, D, 512, E); GRID_BAR(); }
            { const cargs_t a = kargs(); const pg8::EpiResid<0> E{(pg8::bf16_t*)(a->ws + WS_XR), D}; GEMM_PHASE(pg8::EpiResid<0>, a->ws + WS_ZA, a->ws + wlo + O_WO, D, D, E); GRID_BAR(); }
        }
    }
    {
        const cargs_t a = kargs();
        const bool poison = __hip_atomic_load((gu32*)(F.ctl + CW_BAR + XB_TMO), RLX_AGENT) != 0u;
        final_norm_phase((const bf16*)(a->ws + WS_XR), a->out, a->in[19], sopq(gw), NGW, lane_id(), poison);
    }
}

extern "C" void kernel_launch(void* const* d_in, const int* in_sizes, int n_in, void* d_out, int out_size, void* d_ws, size_t ws_size, hipStream_t stream) {
    static int grid = 0;
    if (grid == 0) {
        if (n_in != 20 || in_sizes[0] != M * D || out_size != M * D || ws_size < WS_END) { fprintf(stderr, "kernel_launch: unexpected shapes (n_in %d, in0 %d, out %d, ws %zu); nothing launched\n", n_in, n_in > 0 ? in_sizes[0] : -1, out_size, ws_size); grid = -1; return; }
        int dev = 0, cus = 0, per_cu = 0;
        if (hipGetDevice(&dev) != hipSuccess || hipDeviceGetAttribute(&cus, hipDeviceAttributeMultiprocessorCount, dev) != hipSuccess) { fprintf(stderr, "kernel_launch: device query failed\n"); grid = -1; return; }
        if (hipFuncSetAttribute((const void*)fwd, hipFuncAttributeMaxDynamicSharedMemorySize, LDS_BYTES) != hipSuccess) { fprintf(stderr, "kernel_launch: hipFuncSetAttribute failed\n"); grid = -1; return; }
        if (hipOccupancyMaxActiveBlocksPerMultiprocessor(&per_cu, (const void*)fwd, NWAVES * 64, LDS_BYTES) != hipSuccess || per_cu < 1)
            fprintf(stderr, "kernel_launch: note: occupancy query reports %d workgroups per CU\n", per_cu);
        (void)hipGetLastError();
        grid = cus;
    }
    if (grid < 0) return;
    if (hipMemsetAsync((char*)d_ws + WS_CTL, 0, CTL_ZERO_BYTES, stream) != hipSuccess) { fprintf(stderr, "kernel_launch: hipMemsetAsync failed\n"); return; }
    Args a{};
    for (int i = 0; i < 20; ++i) a.in[i] = (const float*)d_in[i];
    a.out = (float*)d_out; a.ws = (unsigned char*)d_ws;
    hipLaunchKernelGGL(fwd, dim3(grid), dim3(NWAVES * 64), LDS_BYTES, stream, a);
    const hipError_t le = hipPeekAtLastError();
    if (le != hipSuccess) fprintf(stderr, "kernel_launch: launch failed: %s\n", hipGetErrorName(le));
}
```

```cpp
#ifndef PROBE_DUP
#define PROBE_DUP 0
#endif
#ifndef DIAG_SEL
#define DIAG_SEL 0
#endif
#include <hip/hip_runtime.h>
#include <cstdio>
#include <cstdint>
#include <cmath>
namespace pg8 {
#define PG8_LAS __attribute__((address_space(3)))
typedef unsigned short bf16_t;
typedef short bf16x8 __attribute__((ext_vector_type(8)));
typedef float f32x4 __attribute__((ext_vector_type(4)));
typedef unsigned u32x4 __attribute__((ext_vector_type(4)));
constexpr int BM = 256, BK = 64, HALF = 128, HTB = HALF * BK * 2  , STAGE_BYTES = 8 * HTB, NXCD = 8, WGM = 8;

__host__ __device__ __forceinline__ int lds_byte(int r, int c) { const int st = (r >> 4) * 2 + (c >> 5), rr = r & 15, cc = c & 31, ob = rr * 64 + cc * 2; return st * 1024 + (ob ^ (((ob >> 9) & 1) << 5)); }
__host__ __device__ __forceinline__ void stage_rc(int b, int& R, int& C) { const int st = b / 1024, sb = b % 1024, swz = sb ^ (((sb >> 9) & 1) << 5); R = (st >> 1) * 16 + swz / 64; C = (st & 1) * 32 + (swz % 64) / 2; }
__host__ __device__ __forceinline__ int perm32(int rho) { const int n = rho >> 4, i = rho & 15; return 8 * (i >> 2) + 4 * n + (i & 3); }

struct Unit { int pm, pn; };
struct Gemm { const bf16_t* A; const bf16_t* Bt; int M, N, K; };

struct StaticOrder {
    int nM, nN, nwg, G, c;
    __host__ __device__ void init(int M, int N, int G_, int c_) { nM = M / BM; nN = N / BM; nwg = nM * nN; G = G_; c = c_; }
    __host__ __device__ bool next(int i, Unit& u) const {
        const long L = (long)i * G + c; if (L >= nwg) return false;
        int wgid = (int)L; { const int q = nwg / NXCD, r = nwg % NXCD, xcd = wgid % NXCD, off = wgid / NXCD; wgid = (xcd < r ? xcd * (q + 1) : r * (q + 1) + (xcd - r) * q) + off; }
        const int nig = WGM * nN, gid = wgid / nig, fm = gid * WGM, gsz = (nM - fm) < WGM ? (nM - fm) : WGM;
        u.pm = fm + ((wgid % nig) % gsz); u.pn = (wgid % nig) / gsz; return true;
    }
    __device__ __forceinline__ void a_ready(const Unit&) const {}
    __device__ __forceinline__ void done(const Unit&) const {}
};

__device__ __forceinline__ unsigned cvt_pk_bf16(float lo, float hi) { unsigned r; asm volatile("v_cvt_pk_bf16_f32 %0, %1, %2" : "=v"(r) : "v"(lo), "v"(hi)); return r; }
typedef float f32x2 __attribute__((ext_vector_type(2)));
typedef __bf16 bf16x2_t __attribute__((ext_vector_type(2)));
__device__ __forceinline__ unsigned pk_bf16(float lo, float hi) { f32x2 v = {lo, hi}; bf16x2_t b = __builtin_convertvector(v, bf16x2_t); return __builtin_bit_cast(unsigned, b); }
__device__ __forceinline__ float sigm(float g) { return __builtin_amdgcn_rcpf(1.0f + __builtin_amdgcn_exp2f(-1.4426950408889634f * g)); }
__device__ __forceinline__ float bf_lo(unsigned w) { return __uint_as_float(w << 16); }
__device__ __forceinline__ float bf_hi(unsigned w) { return __uint_as_float(w & 0xffff0000u); }

struct EpiPlainBf16 {
    static constexpr bool PERM = true, AFTER_DRAIN = false;
    bf16_t* O1; int ld1; bf16_t* O2; int ld2; int nsplit;
    __device__ __forceinline__ void operator()(const f32x4 (&acc)[2][2][4][2], const Unit& u, int wr, int wc, int fr, int fq) const {
        const bool first = u.pn < nsplit; bf16_t* O = first ? O1 : O2; const int ldc = first ? ld1 : ld2;
        const int row0 = u.pm * BM + wr * 64 + fr, col0 = (first ? u.pn : u.pn - nsplit) * BM + wc * 32 + 8 * fq;
#pragma unroll
        for (int ai = 0; ai < 2; ++ai)
#pragma unroll
            for (int m = 0; m < 4; ++m) { bf16_t* rowp = O + (size_t)(row0 + ai * HALF + m * 16) * ldc + col0;
#pragma unroll
                for (int bj = 0; bj < 2; ++bj) { const f32x4 v0 = acc[ai][bj][m][0], v1 = acc[ai][bj][m][1];
                    u32x4 w; w.x = pk_bf16(v0[0], v0[1]); w.y = pk_bf16(v0[2], v0[3]); w.z = pk_bf16(v1[0], v1[1]); w.w = pk_bf16(v1[2], v1[3]);
                    *(u32x4*)(rowp + bj * HALF) = w; } }
    }
};
struct EpiSwiglu {
    static constexpr bool PERM = true, AFTER_DRAIN = false;
    bf16_t* O; int ldc;
    __device__ __forceinline__ void operator()(const f32x4 (&acc)[2][2][4][2], const Unit& u, int wr, int wc, int fr, int fq) const {
        const int row0 = u.pm * BM + wr * 64 + fr, col0 = u.pn * HALF + wc * 32 + 8 * fq;
#pragma unroll
        for (int ai = 0; ai < 2; ++ai)
#pragma unroll
            for (int m = 0; m < 4; ++m) { bf16_t* rowp = O + (size_t)(row0 + ai * HALF + m * 16) * ldc + col0;
                f32x4 h0, h1;
#pragma unroll
                for (int j = 0; j < 4; ++j) { const float g0 = acc[ai][0][m][0][j], g1 = acc[ai][0][m][1][j];
                    h0[j] = g0 * sigm(g0) * acc[ai][1][m][0][j]; h1[j] = g1 * sigm(g1) * acc[ai][1][m][1][j]; }
                u32x4 w; w.x = pk_bf16(h0[0], h0[1]); w.y = pk_bf16(h0[2], h0[3]); w.z = pk_bf16(h1[0], h1[1]); w.w = pk_bf16(h1[2], h1[3]);
                *(u32x4*)rowp = w; }
    }
};
template <int HALFSTEP> struct EpiResid {
    static constexpr bool PERM = false, AFTER_DRAIN = false;
    bf16_t* X; int ldc;
    __device__ __forceinline__ void operator()(const f32x4 (&acc)[2][2][4][2], const Unit& u, int wr, int wc, int fr, int fq) const {
        const int row0 = u.pm * BM + wr * 64 + fr, col0 = u.pn * BM + wc * 32 + 4 * fq;
        typedef unsigned u32x2_t __attribute__((ext_vector_type(2)));
#pragma unroll
        for (int ai = 0; ai < 2; ++ai)
#pragma unroll
            for (int m = 0; m < 4; ++m) { bf16_t* rowp = X + (size_t)(row0 + ai * HALF + m * 16) * ldc + col0;
#pragma unroll
                for (int bj = 0; bj < 2; ++bj)
#pragma unroll
                    for (int n = 0; n < 2; ++n) { const u32x2_t b = *(const u32x2_t*)(rowp + bj * HALF + n * 16); const f32x4 a = acc[ai][bj][m][n] * (HALFSTEP ? 0.5f : 1.0f);
                        u32x2_t w; w.x = pk_bf16(bf_lo(b.x) + a[0], bf_hi(b.x) + a[1]); w.y = pk_bf16(bf_lo(b.y) + a[2], bf_hi(b.y) + a[3]);
                        *(u32x2_t*)(rowp + bj * HALF + n * 16) = w; }
                if (m & 1) __builtin_amdgcn_sched_barrier(0); }
    }
};
template <bool ADD> struct EpiGate {
    static constexpr bool PERM = true, AFTER_DRAIN = false;
    bf16_t* O; int ldc; const bf16_t* G; int ldg;
    __device__ __forceinline__ void operator()(const f32x4 (&acc)[2][2][4][2], const Unit& u, int wr, int wc, int fr, int fq) const {
        const int row0 = u.pm * BM + wr * 64 + fr, col0 = u.pn * BM + wc * 32 + 8 * fq;
#pragma unroll
        for (int ai = 0; ai < 2; ++ai)
#pragma unroll
            for (int m = 0; m < 4; ++m) { const size_t r = (size_t)(row0 + ai * HALF + m * 16);
#pragma unroll
                for (int bj = 0; bj < 2; ++bj) { const f32x4 v0 = acc[ai][bj][m][0], v1 = acc[ai][bj][m][1];
                    const u32x4 g = *(const u32x4*)(G + r * ldg + col0 + bj * HALF);
                    float r0 = sigm(bf_lo(g.x)) * v0[0], r1 = sigm(bf_hi(g.x)) * v0[1], r2 = sigm(bf_lo(g.y)) * v0[2], r3 = sigm(bf_hi(g.y)) * v0[3];
                    float r4 = sigm(bf_lo(g.z)) * v1[0], r5 = sigm(bf_hi(g.z)) * v1[1], r6 = sigm(bf_lo(g.w)) * v1[2], r7 = sigm(bf_hi(g.w)) * v1[3];
                    bf16_t* op = O + r * ldc + col0 + bj * HALF;
                    if (ADD) { const u32x4 o = *(const u32x4*)op; r0 += bf_lo(o.x); r1 += bf_hi(o.x); r2 += bf_lo(o.y); r3 += bf_hi(o.y); r4 += bf_lo(o.z); r5 += bf_hi(o.z); r6 += bf_lo(o.w); r7 += bf_hi(o.w); }
                    u32x4 w; w.x = pk_bf16(r0, r1); w.y = pk_bf16(r2, r3); w.z = pk_bf16(r4, r5); w.w = pk_bf16(r6, r7);
                    *(u32x4*)op = w; }
                __builtin_amdgcn_sched_barrier(0); }
    }
};

template <class Epi, class Sched, bool ALIGN_EPI = false, bool SP2 = false>
__device__ __forceinline__ void gemm_phase(PG8_LAS unsigned char* lds, const Gemm g, const Sched S, const Epi E, const int wave_id) {
    unsigned z_o = 0u; asm volatile("" : "+v"(z_o)); int tid_o = wave_id * 64 + (int)__builtin_amdgcn_mbcnt_hi(~0u, __builtin_amdgcn_mbcnt_lo(~0u, z_o)); asm volatile("" : "+v"(tid_o));
    const int tid = tid_o, wid = __builtin_amdgcn_readfirstlane(tid >> 6), lane = tid & 63, wr = wid >> 2, wc = wid & 3, fr = lane & 15, fq = lane >> 4;
    const int K = g.K, nt = K / BK;
    unsigned voffA[2], voffB[2];
#pragma unroll
    for (int i = 0; i < 2; ++i) { int R, C; stage_rc(tid * 16 + i * 8192, R, C); const int Rb = Epi::PERM ? ((R & ~31) + perm32(R & 31)) : R;
        voffA[i] = (unsigned)(R * K + C) * 2u; voffB[i] = (unsigned)(Rb * K + C) * 2u; }
    const size_t kstep = (size_t)(BK * 2);
    const size_t hstep = (size_t)HALF * K * 2;
    const size_t tstep = 2 * hstep;
    const unsigned ldsw = (unsigned)wid * 1024u;
    const int aoff = lds_byte(wr * 64 + fr, fq * 8), boff = lds_byte(wc * 32 + fr, fq * 8);
#define PG8_SA(b, h) (((b) * 2 + (h)) * HTB)
#define PG8_SB(b, h) ((4 + (b) * 2 + (h)) * HTB)
#define PG8_STAGE(bufoff, gbase, voff) do { _Pragma("unroll") for (int _i = 0; _i < 2; ++_i) \
        __builtin_amdgcn_global_load_lds((const unsigned*)((const char*)(gbase) + (voff)[_i]), (PG8_LAS unsigned*)(lds + (bufoff) + ldsw + _i * 8192), 16, 0, 0); } while (0)
#define PG8_LDA(dst, b, h) do { _Pragma("unroll") for (int m = 0; m < 4; ++m) _Pragma("unroll") for (int k = 0; k < 2; ++k) dst[m][k] = *(const PG8_LAS bf16x8*)(lds + PG8_SA(b, h) + aoff + m * 2048 + k * 1024); } while (0)
#define PG8_LDB(dst, b, h) do { _Pragma("unroll") for (int n = 0; n < 2; ++n) _Pragma("unroll") for (int k = 0; k < 2; ++k) dst[n][k] = *(const PG8_LAS bf16x8*)(lds + PG8_SB(b, h) + boff + n * 2048 + k * 1024); } while (0)
#define PG8_MMA(ai, bj, At, Bt) do { __builtin_amdgcn_s_setprio(1); _Pragma("unroll") for (int m = 0; m < 4; ++m) _Pragma("unroll") for (int n = 0; n < 2; ++n) _Pragma("unroll") for (int k = 0; k < 2; ++k) \
        acc[ai][bj][m][n] = __builtin_amdgcn_mfma_f32_16x16x32_bf16(Bt[n][k], At[m][k], acc[ai][bj][m][n], 0, 0, 0); __builtin_amdgcn_s_setprio(0); } while (0)
#define PG8_WAIT_V(n) asm volatile("s_waitcnt vmcnt(" #n ")" ::: "memory")
#define PG8_WAIT_L(n) asm volatile("s_waitcnt lgkmcnt(" #n ")" ::: "memory")
#define PG8_BAR __builtin_amdgcn_s_barrier()
#define PG8_SCHED __builtin_amdgcn_sched_barrier(0)
    Unit cur, nxt; int ui = 0;
    if (!S.next(0, cur)) return;
    f32x4 acc[2][2][4][2];
#pragma unroll
    for (int a = 0; a < 2; ++a)
#pragma unroll
        for (int b = 0; b < 2; ++b)
#pragma unroll
            for (int m = 0; m < 4; ++m)
#pragma unroll
                for (int n = 0; n < 2; ++n) acc[a][b][m][n] = (f32x4){0.f, 0.f, 0.f, 0.f};
    bf16x8 At[4][2], B0[2][2], B1[2][2];
    const char* cA = (const char*)g.A + (size_t)cur.pm * tstep; const char* cB = (const char*)g.Bt + (size_t)cur.pn * tstep;
    S.a_ready(cur);
    if constexpr (SP2) {
        PG8_STAGE(PG8_SB(0, 0), cB, voffB); PG8_STAGE(PG8_SB(0, 1), cB + hstep, voffB); PG8_STAGE(PG8_SA(0, 0), cA, voffA); PG8_STAGE(PG8_SA(0, 1), cA + hstep, voffA);
        if (wr == 1) PG8_BAR;
        PG8_WAIT_V(2); PG8_BAR;
        PG8_STAGE(PG8_SB(1, 0), cB + kstep, voffB); PG8_STAGE(PG8_SA(1, 0), cA + kstep, voffA); PG8_STAGE(PG8_SB(1, 1), cB + hstep + kstep, voffB);
        PG8_WAIT_V(6); PG8_BAR;
    } else {
        PG8_STAGE(PG8_SB(0, 0), cB, voffB); PG8_STAGE(PG8_SA(0, 0), cA, voffA); PG8_STAGE(PG8_SB(0, 1), cB + hstep, voffB); PG8_STAGE(PG8_SA(0, 1), cA + hstep, voffA);
        if (wr == 1) PG8_BAR;
        PG8_WAIT_V(4); PG8_BAR;
        PG8_STAGE(PG8_SB(1, 0), cB + kstep, voffB); PG8_STAGE(PG8_SA(1, 0), cA + kstep, voffA); PG8_STAGE(PG8_SB(1, 1), cB + hstep + kstep, voffB);
        PG8_WAIT_V(6); PG8_BAR;
    }
    for (;;) {
        const bool has_next = S.next(ui + 1, nxt);
        const char* nA = has_next ? (const char*)g.A + (size_t)nxt.pm * tstep : cA; const char* nB = has_next ? (const char*)g.Bt + (size_t)nxt.pn * tstep : cB;
        for (int t = 0; t < nt; t += 2) {
            const bool last = (t == nt - 2);
            const char* a1 = cA + (size_t)(t + 1) * kstep;
            const char* a2 = last ? nA : cA + (size_t)(t + 2) * kstep; const char* b2 = last ? nB : cB + (size_t)(t + 2) * kstep;
            const char* a3 = a2 + kstep; const char* b3 = b2 + kstep;
            if (last && has_next) S.a_ready(nxt);
            if constexpr (SP2) {
            PG8_LDB(B0, 0, 0); PG8_LDB(B1, 0, 1); PG8_SCHED; PG8_LDA(At, 0, 0); PG8_STAGE(PG8_SA(1, 1), a1 + hstep, voffA);
            PG8_WAIT_V(8); PG8_WAIT_L(0); PG8_BAR; PG8_MMA(0, 0, At, B0); PG8_MMA(0, 1, At, B1); PG8_BAR; PG8_SCHED;
            PG8_LDA(At, 0, 1); PG8_STAGE(PG8_SB(0, 0), b2, voffB); PG8_STAGE(PG8_SB(0, 1), b2 + hstep, voffB); PG8_STAGE(PG8_SA(0, 0), a2, voffA);
            PG8_WAIT_V(8); PG8_WAIT_L(0); PG8_BAR; PG8_MMA(1, 0, At, B0); PG8_MMA(1, 1, At, B1); PG8_BAR; PG8_SCHED;
            PG8_LDB(B0, 1, 0); PG8_LDB(B1, 1, 1); PG8_SCHED; PG8_LDA(At, 1, 0); PG8_STAGE(PG8_SA(0, 1), a2 + hstep, voffA);
            PG8_WAIT_V(8); PG8_WAIT_L(0); PG8_BAR; PG8_MMA(0, 0, At, B0); PG8_MMA(0, 1, At, B1); PG8_BAR; PG8_SCHED;
            PG8_LDA(At, 1, 1); PG8_STAGE(PG8_SB(1, 0), b3, voffB); PG8_STAGE(PG8_SB(1, 1), b3 + hstep, voffB); PG8_STAGE(PG8_SA(1, 0), a3, voffA);
            PG8_WAIT_V(8); PG8_WAIT_L(0); PG8_BAR; PG8_MMA(1, 0, At, B0); PG8_MMA(1, 1, At, B1); PG8_BAR; PG8_SCHED;
            } else {
            PG8_LDB(B0, 0, 0); PG8_SCHED; PG8_LDA(At, 0, 0); PG8_STAGE(PG8_SA(1, 1), a1 + hstep, voffA);
            PG8_WAIT_L(8); PG8_BAR; PG8_WAIT_L(0); PG8_MMA(0, 0, At, B0); PG8_BAR; PG8_SCHED;
            PG8_LDB(B1, 0, 1); PG8_STAGE(PG8_SB(0, 0), b2, voffB);
            PG8_BAR; PG8_WAIT_L(0); PG8_MMA(0, 1, At, B1); PG8_BAR;
            PG8_LDA(At, 0, 1); PG8_STAGE(PG8_SA(0, 0), a2, voffA);
            PG8_BAR; PG8_WAIT_L(0); PG8_MMA(1, 0, At, B0); PG8_BAR; PG8_SCHED;
            PG8_STAGE(PG8_SB(0, 1), b2 + hstep, voffB);
            PG8_WAIT_V(6); PG8_BAR; PG8_MMA(1, 1, At, B1); PG8_BAR;
            PG8_LDB(B0, 1, 0); PG8_SCHED; PG8_LDA(At, 1, 0); PG8_STAGE(PG8_SA(0, 1), a2 + hstep, voffA);
            PG8_WAIT_L(8); PG8_BAR; PG8_WAIT_L(0); PG8_MMA(0, 0, At, B0); PG8_BAR; PG8_SCHED;
            PG8_LDB(B1, 1, 1); PG8_STAGE(PG8_SB(1, 0), b3, voffB);
            PG8_BAR; PG8_WAIT_L(0); PG8_MMA(0, 1, At, B1); PG8_BAR;
            PG8_LDA(At, 1, 1); PG8_STAGE(PG8_SA(1, 0), a3, voffA);
            PG8_BAR; PG8_WAIT_L(0); PG8_MMA(1, 0, At, B0); PG8_BAR; PG8_SCHED;
            PG8_STAGE(PG8_SB(1, 1), b3 + hstep, voffB);
            PG8_WAIT_V(6); PG8_BAR; PG8_MMA(1, 1, At, B1); PG8_BAR;
            }
        }
        if constexpr (ALIGN_EPI) { if (wr == 0) PG8_BAR; }
        if constexpr (!Epi::AFTER_DRAIN) { E(acc, cur, wr, wc, fr, fq); S.done(cur); }
        if (!has_next) break;
#pragma unroll
        for (int a = 0; a < 2; ++a)
#pragma unroll
            for (int b = 0; b < 2; ++b)
#pragma unroll
                for (int m = 0; m < 4; ++m)
#pragma unroll
                    for (int n = 0; n < 2; ++n) acc[a][b][m][n] = (f32x4){0.f, 0.f, 0.f, 0.f};
        cur = nxt; cA = nA; cB = nB; ++ui;
        if constexpr (ALIGN_EPI) { if (wr == 1) PG8_BAR; }
    }
    PG8_WAIT_V(0);
    if constexpr (!ALIGN_EPI) { if (wr == 0) PG8_BAR; }
    PG8_BAR;
    if constexpr (Epi::AFTER_DRAIN) { E.fused(acc, cur, wr, wc, fr, fq, lds, wid, lane); S.done(cur); }
#undef PG8_SA
#undef PG8_SB
#undef PG8_STAGE
#undef PG8_LDA
#undef PG8_LDB
#undef PG8_MMA
#undef PG8_WAIT_V
#undef PG8_WAIT_L
#undef PG8_BAR
#undef PG8_SCHED
}
}
#define GAS __attribute__((address_space(1)))
#define LAS __attribute__((address_space(3)))
typedef unsigned short bf16;
typedef unsigned v4u __attribute__((ext_vector_type(4)));
typedef float f32x4 __attribute__((ext_vector_type(4)));
typedef short bf16x8 __attribute__((ext_vector_type(8)));
typedef GAS unsigned gu32;
typedef GAS unsigned long long gu64;
#define RLX_AGENT __ATOMIC_RELAXED, __HIP_MEMORY_SCOPE_AGENT
#define LDS_WAIT() asm volatile("s_waitcnt lgkmcnt(0)" ::: "memory")
#define VM_WAIT() asm volatile("s_waitcnt vmcnt(0)" ::: "memory")
__device__ __forceinline__ unsigned long long rt() { return __builtin_amdgcn_s_memrealtime(); }
__device__ __forceinline__ unsigned f2bf(float f) { unsigned u = __builtin_bit_cast(unsigned, f); return (u + 0x7fffu + ((u >> 16) & 1u)) >> 16; }
__device__ __forceinline__ unsigned pk2(float lo, float hi) { return f2bf(lo) | (f2bf(hi) << 16); }

#define XB_TMO      128
#define XB_XCNT(j)  (256  + 64 * (j))
#define XB_XSUB(j)  (1280 + 64 * (j))
#define XB_XGEN(j)  (2304 + 64 * (j))
#define XB_TOP      3328
#define XB_TOPGEN   3392
#define XCD_BAR_WORDS 3456
#define XB_SPIN_CAP (1u << 18)

__device__ __forceinline__ unsigned xb_ld(unsigned* p)              { return __hip_atomic_load(p, __ATOMIC_RELAXED, __HIP_MEMORY_SCOPE_AGENT); }
__device__ __forceinline__ unsigned xb_add(unsigned* p, unsigned v) { return __hip_atomic_fetch_add(p, v, __ATOMIC_RELAXED, __HIP_MEMORY_SCOPE_AGENT); }
__device__ __forceinline__ unsigned xb_xcc_id() { return (unsigned)__builtin_amdgcn_s_getreg((3 << 11) | 20) & 0xFu; }
#define XB_SPIN(cond, bar) do { unsigned _sp = 0; while (cond) { __builtin_amdgcn_s_sleep(1); \
    if ((++_sp & 255u) == 0u) { if (xb_ld(&(bar)[XB_TMO])) break; if (_sp > XB_SPIN_CAP) { atomicAdd(&(bar)[XB_TMO], 1u); break; } } } } while (0)

struct XcdBarrier {
    unsigned wv;
    unsigned* bar; unsigned x;
    volatile LAS unsigned* st;
};

__device__ __forceinline__ bool xb_thread0(unsigned wv) { unsigned z = 0u; asm volatile("" : "+v"(z)); return wv == 0u && __builtin_amdgcn_mbcnt_hi(~0u, __builtin_amdgcn_mbcnt_lo(~0u, z)) == 0u; }
__device__ __forceinline__ XcdBarrier xcd_barrier_post(unsigned* bar, volatile LAS unsigned* st, unsigned wv) {
    XcdBarrier b; b.wv = wv; b.bar = bar; b.x = (unsigned)__builtin_amdgcn_readfirstlane((int)xb_xcc_id());     b.st = st;
    if (xb_thread0(wv)) (void)xb_add(&bar[XB_XCNT(b.x)], 1u);
    return b;
}
__device__ __forceinline__ void xcd_barrier_complete(unsigned* bar, unsigned x, unsigned& nloc, unsigned& nx) {
    const unsigned G = gridDim.x * gridDim.y * gridDim.z;
    unsigned sum, cnt, mine, sp = 0u;
    for (;;) {
        sum = 0u; cnt = 0u; mine = 0u;
#pragma unroll
        for (unsigned j = 0; j < 16; ++j) { const unsigned c = xb_ld(&bar[XB_XCNT(j)]); sum += c; cnt += (c > 0u) ? 1u : 0u; mine = (j == x) ? c : mine; }
        if (sum == G) break;
        __builtin_amdgcn_s_sleep(1);
        if ((++sp & 255u) == 0u) { if (xb_ld(&bar[XB_TMO])) break; if (sp > XB_SPIN_CAP) { atomicAdd(&bar[XB_TMO], 1u); break; } }
    }
    nloc = mine > 0u ? mine : 1u; nx = cnt > 0u ? cnt : 1u;
}

__device__ __forceinline__ void xcd_barrier(const XcdBarrier& b) {
    asm volatile("s_waitcnt vmcnt(0)" ::: "memory");
    __syncthreads();
    if (xb_thread0(b.wv)) {
        unsigned* bar = b.bar;
        __builtin_amdgcn_s_waitcnt(0);
        unsigned nloc = b.st[0], nx = b.st[1];
        if (nloc == 0u) { xcd_barrier_complete(bar, b.x, nloc, nx); b.st[0] = nloc; b.st[1] = nx; }
        const unsigned old = xb_add(&bar[XB_XSUB(b.x)], 1u);
        const unsigned gen = old / nloc;
        if (old + 1u == (gen + 1u) * nloc) {
            __builtin_amdgcn_fence(__ATOMIC_RELEASE, "agent");
            asm volatile("s_waitcnt vmcnt(0)" ::: "memory");
            const unsigned og = xb_add(&bar[XB_TOP], 1u);
            const unsigned tg = og / nx;
            if (og + 1u == (tg + 1u) * nx) xb_add(&bar[XB_TOPGEN], 1u);
            else XB_SPIN(xb_ld(&bar[XB_TOPGEN]) == tg, bar);
            __builtin_amdgcn_fence(__ATOMIC_ACQUIRE, "agent");
            xb_add(&bar[XB_XGEN(b.x)], 1u);
            asm volatile("s_waitcnt vmcnt(0)" ::: "memory");
        } else {
            XB_SPIN(xb_ld(&bar[XB_XGEN(b.x)]) == gen, bar);
            __builtin_amdgcn_fence(__ATOMIC_ACQUIRE, "agent");
            asm volatile("s_waitcnt vmcnt(0)" ::: "memory");
        }
    }
    __syncthreads();
}

constexpr int NWAVES = 8;
constexpr int BATCH = 32, T = 2048, D = 1024, FF = 2816, NL = 2;
constexpr int M = BATCH * T;
constexpr int DIN = 3784;
constexpr int ZN = 4352;
constexpr int ZA = 2304, ZGN = 2048;
constexpr int Z_QL = 0, Z_QI = 1024, Z_PI = 1536, Z_CKV = 2048, Z_KI = 2176, Z_WI = 2240;
constexpr int R_GA = 2304, R_GB = 3328;
constexpr int S_Q = 0, S_CKV = 512, S_QI = 640, S_KI = 1152, S_WI = 1216, S_PI = 1224, S_GA = 1736, S_GB = 2760;
constexpr float EPS = 1e-6f;
constexpr float IDX_SCALE = 0.044194173824159216f;
constexpr float QSCALE = 0.125f * 1.4426950408889634f;

constexpr size_t MiB = 1u << 20;
constexpr size_t WS_CTL = 0, CTL_ZERO_BYTES = 1 * MiB;
constexpr size_t WS_W = 1 * MiB, LW = 46 * MiB + MiB / 2;
constexpr size_t O_WGU1 = 0, O_WD1 = 11 * MiB, O_WIN = 16 * MiB + MiB / 2, O_WA = 25 * MiB, O_WP = 27 * MiB, O_WO = 28 * MiB, O_WGU2 = 30 * MiB, O_WD2 = 41 * MiB;
constexpr size_t WS_XR = 96 * MiB;
constexpr size_t WS_ZA = 224 * MiB;
constexpr size_t WS_ZG = 512 * MiB;
constexpr size_t WS_OL = 768 * MiB;
constexpr size_t WS_XN = WS_OL;
constexpr size_t WS_PO = 896 * MiB;
constexpr size_t WS_CK = 960 * MiB;
constexpr size_t WS_MASK = 976 * MiB;
constexpr size_t WS_END = 992 * MiB;
static_assert(WS_W + NL * LW <= WS_XR && WS_XR + (size_t)M * D * 2 <= WS_ZA && WS_ZA + (size_t)M * ZA * 2 <= WS_ZG && WS_ZG + (size_t)M * ZGN * 2 <= WS_OL && WS_ZA + (size_t)M * FF * 2 <= WS_OL, "d_ws map");
static_assert(O_WD2 + (size_t)D * FF * 2 <= LW && O_WIN + (size_t)ZN * D * 2 <= O_WA, "weight map");
constexpr int CW_TMO = 0, CW_CODE = 1, CW_BAR = 4096;

constexpr int RING_OFF = 0, RING_BYTES = 131072;
constexpr int LDSCTL_OFF = RING_BYTES, MISC_OFF = LDSCTL_OFF + 320;
constexpr int LDS_BYTES = 147456;

struct Args { const float* in[20]; float* out; unsigned char* ws; };
typedef const Args __attribute__((address_space(4)))* cargs_t;
struct Frame {
    LAS unsigned char* lds;
    volatile LAS unsigned* MISC;
    gu32* ctl;
    int wave;
    int vcu, G;
};

typedef unsigned u32x4 __attribute__((ext_vector_type(4)));
typedef unsigned u32x2 __attribute__((ext_vector_type(2)));
typedef float f32x16 __attribute__((ext_vector_type(16)));
typedef short s16x4 __attribute__((ext_vector_type(4)));
using pg8::pk_bf16; using pg8::bf_lo; using pg8::bf_hi;

__device__ __forceinline__ float shx(float v, int m, int lane) { return __int_as_float(__builtin_amdgcn_ds_bpermute((lane ^ m) << 2, __float_as_int(v))); }
__device__ __forceinline__ float wave_sum(float v, int lane) {
#pragma unroll
    for (int o = 1; o < 64; o <<= 1) v += shx(v, o, lane);
    return v;
}
__device__ __forceinline__ int sopq(int v) { asm volatile("" : "+s"(v)); return v; }

__device__ __forceinline__ void tr_item(const float* W, int ldw, int c0, int k0, bf16* WT, int Kd, int drow0, LAS float* scr, int lane) {
#pragma unroll 16
    for (int i = 0; i < 32; ++i) { const int kk = 2 * i + (lane >> 5); scr[kk * 33 + (lane & 31)] = W[(size_t)(k0 + kk) * ldw + c0 + (lane & 31)]; }
    LDS_WAIT(); asm volatile("" ::: "memory");
    const int c = lane & 7;
#pragma unroll
    for (int j = 0; j < 4; ++j) { const int n = (lane >> 3) + 8 * j; const LAS float* s = scr + (8 * c) * 33 + n;
        v4u o; o.x = pk2(s[0 * 33], s[1 * 33]); o.y = pk2(s[2 * 33], s[3 * 33]); o.z = pk2(s[4 * 33], s[5 * 33]); o.w = pk2(s[6 * 33], s[7 * 33]);
        *(GAS v4u*)(WT + (size_t)(drow0 + n) * Kd + k0 + 8 * c) = o; }
    LDS_WAIT(); asm volatile("" ::: "memory");
}
constexpr int I_GU = 16 * 88, I_DN = 44 * 32, I_WO = 16 * 32, I_WIN = 16 * 103, I_ZERO = 1, I_QL = 1024, I_WA = 2048, I_WP = 1024;
constexpr int I_LAYER = 6 * I_GU + I_WO + I_WIN + I_ZERO + I_QL + I_WA + I_WP;
static_assert(I_GU == I_DN, "item counts");

__device__ __forceinline__ void prologue_item(cargs_t ka, int it, LAS float* scr, int lane) {
    const float* const __attribute__((address_space(4)))* in = ka->in; unsigned char* ws = ka->ws;
    const int l = it / I_LAYER; int r = it - l * I_LAYER;
    unsigned char* wl = ws + WS_W + (size_t)l * LW;
    if (r < I_WA) {
        const int hh = r >> 8, cb = (r >> 4) & 15, ib = r & 15, n = 64 * ib + lane;
        const float* wuv = in[9] + (size_t)l * 128 * 8 * 64; const float* wba = in[12] + (size_t)l * 512 * 1024;
        float a[8];
#pragma unroll
        for (int j = 0; j < 8; ++j) a[j] = 0.f;
#pragma unroll 16
        for (int d = 0; d < 64; ++d) { const float wv = wba[(size_t)(hh * 64 + d) * 1024 + n];
#pragma unroll
            for (int j = 0; j < 8; ++j) a[j] += wuv[((8 * cb + j) * 8 + hh) * 64 + d] * wv; }
        v4u o; o.x = pk2(a[0], a[1]); o.y = pk2(a[2], a[3]); o.z = pk2(a[4], a[5]); o.w = pk2(a[6], a[7]);
        *(GAS v4u*)((bf16*)(wl + O_WA) + (size_t)n * 1024 + hh * 128 + 8 * cb) = o; return; }
    r -= I_WA;
    if (r < I_WP) {
        const int g = r >> 8, cb = (r >> 4) & 15, ib = r & 15, n = 64 * ib + lane;
        const float* pw = in[10] + (size_t)l * 4 * 128 * 128; const float* ps = in[11] + (size_t)l * 512; const float* wbp = in[13] + (size_t)l * 512 * 1024;
        float a[8];
#pragma unroll
        for (int j = 0; j < 8; ++j) a[j] = 0.f;
#pragma unroll 16
        for (int d = 0; d < 128; ++d) { const float wv = wbp[(size_t)(g * 128 + d) * 1024 + n] * ps[g * 128 + d];
#pragma unroll
            for (int j = 0; j < 8; ++j) a[j] += pw[(size_t)(g * 128 + 8 * cb + j) * 128 + d] * wv; }
        v4u o; o.x = pk2(a[0], a[1]); o.y = pk2(a[2], a[3]); o.z = pk2(a[4], a[5]); o.w = pk2(a[6], a[7]);
        *(GAS v4u*)((bf16*)(wl + O_WP) + (size_t)n * 512 + g * 128 + 8 * cb) = o; return; }
    r -= I_WP;
    if (r < I_QL) {
        const int n = r, hh = n >> 7, c = n & 127;
        const float* win = in[6] + (size_t)l * D * DIN; const f32x4* wuk = (const f32x4*)(in[8] + (size_t)l * 128 * 8 * 64 + (size_t)(c * 8 + hh) * 64);
        bf16* dst = (bf16*)(wl + O_WIN) + (size_t)n * D;
        for (int i = 0; i < 16; ++i) { const int k = 64 * i + lane; const f32x4* wr = (const f32x4*)(win + (size_t)k * DIN + hh * 64); float a = 0.f;
#pragma unroll 4
            for (int d4 = 0; d4 < 16; ++d4) { const f32x4 x = wr[d4], y = wuk[d4]; a += (x.x * y.x + x.y * y.y) + (x.z * y.z + x.w * y.w); }
            dst[k] = (bf16)f2bf(a * QSCALE); }
        return; }
    r -= I_QL;
    if (r < I_GU) { const int kb = r / 88, nb = r % 88, n0 = 32 * nb; tr_item(in[2] + (size_t)l * D * FF, FF, n0, 64 * kb, (bf16*)(wl + O_WGU1), D, 256 * (n0 >> 7) + (n0 & 127), scr, lane); return; }
    r -= I_GU;
    if (r < I_GU) { const int kb = r / 88, nb = r % 88, n0 = 32 * nb; tr_item(in[3] + (size_t)l * D * FF, FF, n0, 64 * kb, (bf16*)(wl + O_WGU1), D, 256 * (n0 >> 7) + 128 + (n0 & 127), scr, lane); return; }
    r -= I_GU;
    if (r < I_DN) { const int kb = r / 32, nb = r % 32; tr_item(in[4] + (size_t)l * FF * D, D, 32 * nb, 64 * kb, (bf16*)(wl + O_WD1), FF, 32 * nb, scr, lane); return; }
    r -= I_DN;
    if (r < I_GU) { const int kb = r / 88, nb = r % 88, n0 = 32 * nb; tr_item(in[16] + (size_t)l * D * FF, FF, n0, 64 * kb, (bf16*)(wl + O_WGU2), D, 256 * (n0 >> 7) + (n0 & 127), scr, lane); return; }
    r -= I_GU;
    if (r < I_GU) { const int kb = r / 88, nb = r % 88, n0 = 32 * nb; tr_item(in[17] + (size_t)l * D * FF, FF, n0, 64 * kb, (bf16*)(wl + O_WGU2), D, 256 * (n0 >> 7) + 128 + (n0 & 127), scr, lane); return; }
    r -= I_GU;
    if (r < I_DN) { const int kb = r / 32, nb = r % 32; tr_item(in[18] + (size_t)l * FF * D, D, 32 * nb, 64 * kb, (bf16*)(wl + O_WD2), FF, 32 * nb, scr, lane); return; }
    r -= I_DN;
    if (r < I_WO) { const int kb = r / 32, nb = r % 32; tr_item(in[14] + (size_t)l * D * D, D, 32 * nb, 64 * kb, (bf16*)(wl + O_WO), D, 32 * nb, scr, lane); return; }
    r -= I_WO;
    if (r < I_WIN) {
        const int kb = r / 103, v = 32 * (r % 103); int c0, d0;
        if (v < 512) { c0 = S_QI + v; d0 = Z_QI + v; }
        else if (v < 1024) { c0 = S_PI + (v - 512); d0 = Z_PI + (v - 512); }
        else if (v < 2048) { c0 = S_GA + (v - 1024); d0 = R_GA + (v - 1024); }
        else if (v < 3072) { c0 = S_GB + (v - 2048); d0 = R_GB + (v - 2048); }
        else if (v < 3200) { c0 = S_CKV + (v - 3072); d0 = Z_CKV + (v - 3072); }
        else { c0 = S_KI + (v - 3200); d0 = Z_KI + (v - 3200); }
        tr_item(in[6] + (size_t)l * D * DIN, DIN, c0, 64 * kb, (bf16*)(wl + O_WIN), D, d0, scr, lane); return; }
    r -= I_WIN;
    {
        v4u z; z.x = 0u; z.y = 0u; z.z = 0u; z.w = 0u; GAS v4u* p = (GAS v4u*)((bf16*)(wl + O_WIN) + (size_t)(Z_KI + 96) * D);
        for (int i = lane; i < 32 * D / 8; i += 64) p[i] = z; }
}

__device__ __forceinline__ void rms_phase(const bf16* src, const float* g, bf16* dst, int gw, int NGW, int lane) {
    f32x4 gv[4];
#pragma unroll
    for (int j = 0; j < 4; ++j) gv[j] = ((const f32x4*)g)[64 * j + lane];
    for (int m = gw; m < M; m += NGW) {
        const GAS u32x2* xr = (const GAS u32x2*)(src + (size_t)m * D) + lane;
        f32x4 v[4]; float s = 0.f;
#pragma unroll
        for (int j = 0; j < 4; ++j) { const u32x2 w = xr[64 * j]; v[j].x = bf_lo(w.x); v[j].y = bf_hi(w.x); v[j].z = bf_lo(w.y); v[j].w = bf_hi(w.y); s += (v[j].x * v[j].x + v[j].y * v[j].y) + (v[j].z * v[j].z + v[j].w * v[j].w); }
        const float rstd = 1.f / sqrtf(wave_sum(s, lane) * (1.f / D) + EPS);
        GAS u32x2* o8 = (GAS u32x2*)(dst + (size_t)m * D) + lane;
#pragma unroll
        for (int j = 0; j < 4; ++j) { u32x2 w; w.x = pk_bf16(v[j].x * rstd * gv[j].x, v[j].y * rstd * gv[j].y); w.y = pk_bf16(v[j].z * rstd * gv[j].z, v[j].w * rstd * gv[j].w); o8[64 * j] = w; }
    }
}
__device__ __forceinline__ void rms_phase_in(const float* src, const float* g, bf16* xr_out, bf16* dst, int gw, int NGW, int lane) {
    f32x4 gv[4];
#pragma unroll
    for (int j = 0; j < 4; ++j) gv[j] = ((const f32x4*)g)[64 * j + lane];
    for (int m = gw; m < M; m += NGW) {
        const GAS f32x4* xr = (const GAS f32x4*)(src + (size_t)m * D) + lane;
        f32x4 v[4]; float s = 0.f;
#pragma unroll
        for (int j = 0; j < 4; ++j) { v[j] = xr[64 * j]; s += (v[j].x * v[j].x + v[j].y * v[j].y) + (v[j].z * v[j].z + v[j].w * v[j].w); }
        const float rstd = 1.f / sqrtf(wave_sum(s, lane) * (1.f / D) + EPS);
        GAS u32x2* o8 = (GAS u32x2*)(dst + (size_t)m * D) + lane; GAS u32x2* x8 = (GAS u32x2*)(xr_out + (size_t)m * D) + lane;
#pragma unroll
        for (int j = 0; j < 4; ++j) { u32x2 w; w.x = pk_bf16(v[j].x * rstd * gv[j].x, v[j].y * rstd * gv[j].y); w.y = pk_bf16(v[j].z * rstd * gv[j].z, v[j].w * rstd * gv[j].w); o8[64 * j] = w;
            u32x2 q; q.x = pk_bf16(v[j].x, v[j].y); q.y = pk_bf16(v[j].z, v[j].w); x8[64 * j] = q; }
    }
}
__device__ __forceinline__ void final_norm_phase(const bf16* src, float* out, const float* g, int gw, int NGW, int lane, bool poison, const unsigned* diagp = nullptr) {
    f32x4 gv[4];
#pragma unroll
    for (int j = 0; j < 4; ++j) gv[j] = ((const f32x4*)g)[64 * j + lane];
    const float qnan = __builtin_nanf("");
    for (int m = gw; m < M; m += NGW) {
        const GAS u32x2* xr = (const GAS u32x2*)(src + (size_t)m * D) + lane;
        f32x4 v[4]; float s = 0.f;
#pragma unroll
        for (int j = 0; j < 4; ++j) { const u32x2 w = xr[64 * j]; v[j].x = bf_lo(w.x); v[j].y = bf_hi(w.x); v[j].z = bf_lo(w.y); v[j].w = bf_hi(w.y); s += (v[j].x * v[j].x + v[j].y * v[j].y) + (v[j].z * v[j].z + v[j].w * v[j].w); }
        float rstd = 1.f / sqrtf(wave_sum(s, lane) * (1.f / D) + EPS);
        if (poison) rstd = qnan;
#if DIAG_SEL
        { const unsigned long long* dg = (const unsigned long long*)diagp; const float tot = (float)(dg[0] + dg[1] + dg[2] + dg[3]); rstd *= 1.0f + floorf((float)dg[DIAG_SEL - 1] / tot * 16.0f + 0.5f) * (1.0f / 16.0f); }
#endif
        GAS f32x4* o = (GAS f32x4*)(out + (size_t)m * D) + lane;
#pragma unroll
        for (int j = 0; j < 4; ++j) o[64 * j] = v[j] * rstd * gv[j];
    }
}
__device__ __forceinline__ void prep_phase(const bf16* Z, const float* gkv, bf16* CK, bf16* PO, int gw, int NGW, int lane) {
    {
        const int sub = lane >> 4, ch = lane & 15;
        float gk[8];
#pragma unroll
        for (int e = 0; e < 8; ++e) gk[e] = gkv[8 * ch + e];
        for (int r0 = gw; r0 < M / 4; r0 += 4 * NGW) {
            u32x4 w[4];
#pragma unroll
            for (int q = 0; q < 4; ++q) { const int r4 = r0 + q * NGW < M / 4 ? r0 + q * NGW : r0; w[q] = *(const GAS u32x4*)(Z + ((size_t)r4 * 4 + sub) * ZA + Z_CKV + 8 * ch); }
#pragma unroll
            for (int q = 0; q < 4; ++q) {
                const int r4 = r0 + q * NGW; if (r4 < M / 4) {
                const size_t m = (size_t)r4 * 4 + sub;
                float x[8] = {bf_lo(w[q].x), bf_hi(w[q].x), bf_lo(w[q].y), bf_hi(w[q].y), bf_lo(w[q].z), bf_hi(w[q].z), bf_lo(w[q].w), bf_hi(w[q].w)};
                float s = 0.f;
#pragma unroll
                for (int e = 0; e < 8; ++e) s += x[e] * x[e];
                s += shx(s, 1, lane); s += shx(s, 2, lane); s += shx(s, 4, lane); s += shx(s, 8, lane);
                const float rstd = 1.f / sqrtf(s * (1.f / 128.f) + EPS);
                u32x4 o; o.x = pk_bf16(x[0] * rstd * gk[0], x[1] * rstd * gk[1]); o.y = pk_bf16(x[2] * rstd * gk[2], x[3] * rstd * gk[3]);
                o.z = pk_bf16(x[4] * rstd * gk[4], x[5] * rstd * gk[5]); o.w = pk_bf16(x[6] * rstd * gk[6], x[7] * rstd * gk[7]);
                *(GAS u32x4*)(CK + m * 128 + 8 * ch) = o; }
            }
        }
    }
    {
        const int wdw = 2 << (lane >> 4);
        for (int blk = gw; blk < M / 8; blk += NGW) {
            const int m0 = 8 * blk, t0 = m0 & (T - 1);
            u32x4 xr[23];
#pragma unroll
            for (int i = 0; i < 23; ++i) { int mr = m0 - 15 + i; mr = mr < 0 ? 0 : mr; xr[i] = *(const GAS u32x4*)(Z + (size_t)mr * ZA + Z_PI + 8 * lane); }
#pragma unroll
            for (int r = 0; r < 8; ++r) {
                const int t = t0 + r; const int cnt = (t + 1) < wdw ? (t + 1) : wdw;
                float a[8];
#pragma unroll
                for (int e = 0; e < 8; ++e) a[e] = 0.f;
#pragma unroll
                for (int jj = 0; jj < 16; ++jj) { const float mk = jj < cnt ? 1.f : 0.f; const u32x4 w = xr[15 + r - jj];
                    a[0] = fmaf(bf_lo(w.x), mk, a[0]); a[1] = fmaf(bf_hi(w.x), mk, a[1]); a[2] = fmaf(bf_lo(w.y), mk, a[2]); a[3] = fmaf(bf_hi(w.y), mk, a[3]);
                    a[4] = fmaf(bf_lo(w.z), mk, a[4]); a[5] = fmaf(bf_hi(w.z), mk, a[5]); a[6] = fmaf(bf_lo(w.w), mk, a[6]); a[7] = fmaf(bf_hi(w.w), mk, a[7]); }
                const u32x4 sw = xr[15 + r]; const float inv = 1.f / (float)cnt;
                u32x4 o; o.x = pk_bf16(a[0] * inv - bf_lo(sw.x), a[1] * inv - bf_hi(sw.x)); o.y = pk_bf16(a[2] * inv - bf_lo(sw.y), a[3] * inv - bf_hi(sw.y));
                o.z = pk_bf16(a[4] * inv - bf_lo(sw.z), a[5] * inv - bf_hi(sw.z)); o.w = pk_bf16(a[6] * inv - bf_lo(sw.w), a[7] * inv - bf_hi(sw.w));
                *(GAS u32x4*)(PO + (size_t)(m0 + r) * 512 + 8 * lane) = o;
            }
        }
    }
}

__device__ __forceinline__ bool mix_unit(int i, int vcu, int G, int& b, int& qb) {
    const int U = vcu + i * G; if (U >= BATCH * 64) return false;
    const int ii = U >> 8, r = U & 7; b = (U & 255) >> 3; qb = (ii & 1) ? 16 * (ii >> 1) + 15 - r : 16 * (ii >> 1) + r; return true;
}
__device__ __forceinline__ unsigned fkey(float s) { const unsigned u = __float_as_uint(s); return (u & 0x80000000u) ? ~u : (u | 0x80000000u); }
__device__ __forceinline__ float funkey(unsigned k) { return __uint_as_float((k & 0x80000000u) ? (k & 0x7fffffffu) : ~k); }
__device__ __forceinline__ unsigned half_sum(unsigned v, int hh) {
    v += (unsigned)__builtin_amdgcn_update_dpp(0, (int)v, 0xB1, 0xF, 0xF, false);
    v += (unsigned)__builtin_amdgcn_update_dpp(0, (int)v, 0x4E, 0xF, 0xF, false);
    v += (unsigned)__builtin_amdgcn_update_dpp(0, (int)v, 0x141, 0xF, 0xF, false);
    v += (unsigned)__builtin_amdgcn_update_dpp(0, (int)v, 0x140, 0xF, 0xF, false);
    const unsigned a = __builtin_amdgcn_readlane(v, 0) + __builtin_amdgcn_readlane(v, 16), b = __builtin_amdgcn_readlane(v, 32) + __builtin_amdgcn_readlane(v, 48);
    return hh ? b : a;
}
__device__ __forceinline__ float rl_f(float v, int l) { return __uint_as_float((unsigned)__builtin_amdgcn_readlane((int)__float_as_uint(v), l)); }
__device__ __forceinline__ float half_max(float v, int hh) {
    v = fmaxf(v, __builtin_amdgcn_update_dpp(v, v, 0xB1, 0xF, 0xF, false)); v = fmaxf(v, __builtin_amdgcn_update_dpp(v, v, 0x4E, 0xF, 0xF, false));
    v = fmaxf(v, __builtin_amdgcn_update_dpp(v, v, 0x141, 0xF, 0xF, false)); v = fmaxf(v, __builtin_amdgcn_update_dpp(v, v, 0x140, 0xF, 0xF, false));
    const float a = fmaxf(rl_f(v, 0), rl_f(v, 16)), b = fmaxf(rl_f(v, 32), rl_f(v, 48));
    return hh ? b : a;
}
__device__ __forceinline__ float half_min(float v, int hh) {
    v = fminf(v, __builtin_amdgcn_update_dpp(v, v, 0xB1, 0xF, 0xF, false)); v = fminf(v, __builtin_amdgcn_update_dpp(v, v, 0x4E, 0xF, 0xF, false));
    v = fminf(v, __builtin_amdgcn_update_dpp(v, v, 0x141, 0xF, 0xF, false)); v = fminf(v, __builtin_amdgcn_update_dpp(v, v, 0x140, 0xF, 0xF, false));
    const float a = fminf(rl_f(v, 0), rl_f(v, 16)), b = fminf(rl_f(v, 32), rl_f(v, 48));
    return hh ? b : a;
}
__device__ __forceinline__ float sel_cand(float lo, float hi, float glo, float ghi) {
    float c = lo + (hi - lo) * (glo / (glo - ghi));
    if (!(c > lo && c < hi)) c = funkey((fkey(lo) >> 1) + (fkey(hi) >> 1) + (fkey(lo) & fkey(hi) & 1u));
    return c;
}

#if DIAG_SEL
#define DIAG_T(sec) do { if (blockIdx.x == 0 && wid == 0) { const unsigned long long t_ = __builtin_amdgcn_s_memrealtime(); if (lane_in == 0) atomicAdd((unsigned long long*)diag + (sec), t_ - tprev_); tprev_ = t_; } } while (0)
#else
#define DIAG_T(sec) do { } while (0)
#endif
__device__ __forceinline__ void select_unit(const bf16* Z, unsigned* MASK, int b, int qb, int wid, int lane_in, unsigned* diag = nullptr) {
#if DIAG_SEL
    unsigned long long tprev_ = __builtin_amdgcn_s_memrealtime();
#endif
    int lane = lane_in; asm volatile("" : "+v"(lane));
    const int col = lane & 31, hh = lane >> 5;
    const size_t mb = (size_t)b * T + 32 * qb + 4 * wid;
    const int tql_r = 2 * (col >> 4) + ((col >> 2) & 1), j_r = 4 * ((col >> 3) & 1) + (col & 3);
    bf16x8 qa[4];
#pragma unroll
    for (int s = 0; s < 4; ++s) qa[s] = *(const GAS bf16x8*)(Z + (mb + tql_r) * ZA + Z_QI + j_r * 64 + 16 * s + 8 * hh);
    float wA[8], wB[8];
    { const u32x4 a = *(const GAS u32x4*)(Z + (mb + hh) * ZA + Z_WI), c = *(const GAS u32x4*)(Z + (mb + 2 + hh) * ZA + Z_WI);
      wA[0] = bf_lo(a.x) * IDX_SCALE; wA[1] = bf_hi(a.x) * IDX_SCALE; wA[2] = bf_lo(a.y) * IDX_SCALE; wA[3] = bf_hi(a.y) * IDX_SCALE;
      wA[4] = bf_lo(a.z) * IDX_SCALE; wA[5] = bf_hi(a.z) * IDX_SCALE; wA[6] = bf_lo(a.w) * IDX_SCALE; wA[7] = bf_hi(a.w) * IDX_SCALE;
      wB[0] = bf_lo(c.x) * IDX_SCALE; wB[1] = bf_hi(c.x) * IDX_SCALE; wB[2] = bf_lo(c.y) * IDX_SCALE; wB[3] = bf_hi(c.y) * IDX_SCALE;
      wB[4] = bf_lo(c.z) * IDX_SCALE; wB[5] = bf_hi(c.z) * IDX_SCALE; wB[6] = bf_lo(c.w) * IDX_SCALE; wB[7] = bf_hi(c.w) * IDX_SCALE; }
    const int dA = 32 * qb + 4 * wid + hh - col, dB = dA + 2;
    float sA[64], sB[64];
    const bf16* kp = Z + ((size_t)b * T + col) * ZA + Z_KI + 8 * hh;
    bf16x8 kb0[4], kb1[4], kb2[4];
#pragma unroll
    for (int s = 0; s < 4; ++s) { kb0[s] = *(const GAS bf16x8*)(kp + 16 * s); kb1[s] = *(const GAS bf16x8*)(kp + (size_t)32 * ZA + 16 * s); }
    kp += (size_t)32 * ZA;
#if DIAG_SEL
    asm volatile("s_waitcnt vmcnt(0)" ::: "memory");
#endif
    DIAG_T(0);
#pragma unroll
    for (int kt = 0; kt < 64; ++kt) { sA[kt] = -INFINITY; sB[kt] = -INFINITY; }
#pragma unroll
    for (int c8 = 0; c8 < 8; ++c8) {
        if (8 * c8 <= qb) {
#pragma unroll
            for (int k = 0; k < 8; ++k) {
                const int kt = 8 * c8 + k;
                kp += (size_t)32 * ZA; asm volatile("" : "+v"(kp));
#pragma unroll
                for (int s = 0; s < 4; ++s) { const bf16x8 ld = *(const GAS bf16x8*)(kp + 16 * s); if ((kt + 2) % 3 == 0) kb0[s] = ld; else if ((kt + 2) % 3 == 1) kb1[s] = ld; else kb2[s] = ld; }
                f32x16 acc;
#pragma unroll
                for (int i = 0; i < 16; ++i) acc[i] = 0.f;
#pragma unroll
                for (int s = 0; s < 4; ++s) acc = __builtin_amdgcn_mfma_f32_32x32x16_bf16(qa[s], kt % 3 == 0 ? kb0[s] : (kt % 3 == 1 ? kb1[s] : kb2[s]), acc, 0, 0, 0);
                float sa = 0.f, sb = 0.f;
#pragma unroll
                for (int j = 0; j < 8; ++j) {
                    const int ra = __float_as_int(acc[j]), rb = __float_as_int(acc[8 + j]);
                    sa = fmaf(__int_as_float(ra > 0 ? ra : 0), wA[j], sa); sb = fmaf(__int_as_float(rb > 0 ? rb : 0), wB[j], sb); }
                sA[kt] = (32 * kt <= dA) ? sa : -INFINITY; sB[kt] = (32 * kt <= dB) ? sb : -INFINITY;
                __builtin_amdgcn_sched_barrier(0);
            }
        }
    }
    DIAG_T(1);
    float thrA = -3.0e38f, thrB = -3.0e38f;
    if (qb >= 8) {
        float mnA = sA[0], mnB = sB[0], mxA = sA[0], mxB = sB[0];
#pragma unroll
        for (int k = 1; k < 8; ++k) { mnA = fminf(mnA, sA[k]); mnB = fminf(mnB, sB[k]); }
#pragma unroll
        for (int c8 = 0; c8 < 8; ++c8) {
            if (8 * c8 <= qb) {
#pragma unroll
                for (int k = 0; k < 8; ++k) { mxA = fmaxf(mxA, sA[8 * c8 + k]); mxB = fmaxf(mxB, sB[8 * c8 + k]); }
            }
        }
        float loA = half_min(mnA, hh), loB = half_min(mnB, hh);
        float hiA = funkey(fkey(half_max(mxA, hh)) + 1u), hiB = funkey(fkey(half_max(mxB, hh)) + 1u);
        const float nv = (float)(32 * qb + 16);
        float gloA = nv - 256.5f, ghiA = -256.5f, gloB = gloA, ghiB = ghiA;
        int sdA = 0, sdB = 0;
        unsigned nloA = 0x40000000u, nhiA = 0u, nloB = 0x40000000u, nhiB = 0u;
        int stA = 0, stB = 0;
        bool dnA = false, dnB = false;
#pragma unroll 1
        for (int it = 0; it < 96; ++it) {
            const float cA = sel_cand(loA, hiA, gloA, ghiA), cB = sel_cand(loB, hiB, gloB, ghiB);
            unsigned nA = 0u, nB = 0u;
#pragma unroll
            for (int c8 = 0; c8 < 8; ++c8) {
                if (8 * c8 <= qb) {
                    unsigned ba = 0u, bb = 0u;
#pragma unroll
                    for (int k = 0; k < 8; ++k) { ba = __builtin_amdgcn_alignbit(ba, __float_as_uint(sA[8 * c8 + k] - cA), 31); bb = __builtin_amdgcn_alignbit(bb, __float_as_uint(sB[8 * c8 + k] - cB), 31); }
                    nA += 8u - (unsigned)__builtin_popcount(ba); nB += 8u - (unsigned)__builtin_popcount(bb);
                }
            }
            nA = half_sum(nA, hh); nB = half_sum(nB, hh);
            if (!dnA) {
                const float g = (float)nA - 256.5f; const unsigned w0_ = nloA - nhiA;
                if (nA == 256u) { loA = cA; dnA = true; }
                else if (nA > 256u) { loA = cA; nloA = nA; gloA = g; if (sdA > 0) ghiA *= 0.5f; sdA = 1; }
                else { hiA = cA; nhiA = nA; ghiA = g; if (sdA < 0) gloA *= 0.5f; sdA = -1; }
                stA = (nloA - nhiA == w0_) ? stA + 1 : 0;
                if (!dnA && fkey(hiA) - fkey(loA) <= 1u) dnA = true;
            }
            if (!dnB) {
                const float g = (float)nB - 256.5f; const unsigned w0_ = nloB - nhiB;
                if (nB == 256u) { loB = cB; dnB = true; }
                else if (nB > 256u) { loB = cB; nloB = nB; gloB = g; if (sdB > 0) ghiB *= 0.5f; sdB = 1; }
                else { hiB = cB; nhiB = nB; ghiB = g; if (sdB < 0) gloB *= 0.5f; sdB = -1; }
                stB = (nloB - nhiB == w0_) ? stB + 1 : 0;
                if (!dnB && fkey(hiB) - fkey(loB) <= 1u) dnB = true;
            }
            if (__all(dnA && dnB)) break;
            if (__any((!dnA && stA >= 2) || (!dnB && stB >= 2))) {
                float mnA_ = INFINITY, mxA_ = -INFINITY, mnB_ = INFINITY, mxB_ = -INFINITY;
#pragma unroll
                for (int c8 = 0; c8 < 8; ++c8) {
                    if (8 * c8 <= qb) {
#pragma unroll
                        for (int k = 0; k < 8; ++k) {
                            const float a = sA[8 * c8 + k], b2 = sB[8 * c8 + k];
                            const bool ia = (a >= loA) && (a < hiA), ib = (b2 >= loB) && (b2 < hiB);
                            mnA_ = ia ? fminf(mnA_, a) : mnA_; mxA_ = ia ? fmaxf(mxA_, a) : mxA_;
                            mnB_ = ib ? fminf(mnB_, b2) : mnB_; mxB_ = ib ? fmaxf(mxB_, b2) : mxB_;
                        }
                    }
                }
                mnA_ = half_min(mnA_, hh); mxA_ = half_max(mxA_, hh); mnB_ = half_min(mnB_, hh); mxB_ = half_max(mxB_, hh);
                if (!dnA && stA >= 2) { if (mnA_ == mxA_) { loA = mnA_; dnA = true; } else { loA = mnA_; hiA = funkey(fkey(mxA_) + 1u); stA = 0; } }
                if (!dnB && stB >= 2) { if (mnB_ == mxB_) { loB = mnB_; dnB = true; } else { loB = mnB_; hiB = funkey(fkey(mxB_) + 1u); stB = 0; } }
                if (__all(dnA && dnB)) break;
            }
        }
        thrA = loA; thrB = loB;
    }
    DIAG_T(2);
    unsigned w0 = 0u, w1 = 0u, w2 = 0u, w3 = 0u;
    int lane2 = lane; asm volatile("" : "+v"(lane2));
#pragma unroll
    for (int c8 = 0; c8 < 8; ++c8) {
        if (8 * c8 <= qb) {
#pragma unroll
            for (int k = 0; k < 8; ++k) { const int kt = 8 * c8 + k;
                const unsigned long long bA = __ballot(sA[kt] >= thrA), bB = __ballot(sB[kt] >= thrB);
                const bool mine = (lane2 == kt);
                w0 = mine ? (unsigned)bA : w0; w1 = mine ? (unsigned)(bA >> 32) : w1; w2 = mine ? (unsigned)bB : w2; w3 = mine ? (unsigned)(bB >> 32) : w3; }
        }
    }
    GAS unsigned* mo = (GAS unsigned*)MASK + mb * 64 + lane;
    mo[0] = w0; mo[64] = w1; mo[128] = w2; mo[192] = w3;
#if DIAG_SEL
    asm volatile("s_waitcnt vmcnt(0)" ::: "memory");
#endif
    DIAG_T(3);
}

__device__ __forceinline__ unsigned off_b(unsigned row, unsigned ch) { return 256u * row + 16u * (ch ^ (((row & 3u) << 2) | ((row >> 2) & 3u))); }
__device__ __forceinline__ s16x4 vtr(const LAS unsigned char* p) { typedef short v4i16_t __attribute__((ext_vector_type(4))); return __builtin_bit_cast(s16x4, __builtin_amdgcn_ds_read_tr16_b64_v4i16((LAS v4i16_t*)p)); }
__device__ __forceinline__ void attn_unit(LAS unsigned char* kbuf, const bf16* Z, const bf16* CK, const unsigned* MASK, bf16* OL, const float* gkv, int b, int qb, int wid, int lane_in) {
    int lane = lane_in; asm volatile("" : "+v"(lane));
    const int r32 = lane & 31, hh = lane >> 5, tql = r32 >> 3, head = r32 & 7;
    const size_t m = (size_t)b * T + 32 * qb + 4 * wid + tql;
    bf16x8 qf[8];
#pragma unroll
    for (int s = 0; s < 8; ++s) qf[s] = *(const GAS bf16x8*)(Z + m * ZA + Z_QL + head * 128 + 16 * s + 8 * hh);
    const GAS unsigned* mrow = (const GAS unsigned*)MASK + m * 64;
    float mref;
    { float gm = fmaxf(fabsf(gkv[lane]), fabsf(gkv[lane + 64]));
#pragma unroll
      for (int o = 1; o < 64; o <<= 1) gm = fmaxf(gm, shx(gm, o, lane));
      float qn = 0.f;
#pragma unroll
      for (int s = 0; s < 8; ++s)
#pragma unroll
          for (int e = 0; e < 8; ++e) { const float x = __uint_as_float(((unsigned)(unsigned short)qf[s][e]) << 16); qn += x * x; }
      qn += shx(qn, 32, lane);
      mref = fminf(sqrtf(qn) * gm * (1.02f * 11.313708499f), 60.f); }
    f32x16 zero16;
#pragma unroll
    for (int i = 0; i < 16; ++i) zero16[i] = 0.f;
    f32x16 o[4];
#pragma unroll
    for (int dt = 0; dt < 4; ++dt)
#pragma unroll
        for (int i = 0; i < 16; ++i) o[dt][i] = 0.f;
    float lrun = 0.f;
    const int ns = (qb + 8) >> 3;
    const int lr = lane >> 4;
    const bf16* gsrc0 = CK + ((size_t)b * T + 32 * wid + lr) * 128;
    LAS unsigned char* ldst0 = kbuf + (32 * wid) * 256;
#define ATT_DMA_STAGE(st_) do { _Pragma("unroll") for (int i_ = 0; i_ < 8; ++i_) { const int ch_ = (lane & 15) ^ ((lr << 2) | (i_ & 3)); \
        __builtin_amdgcn_global_load_lds((const unsigned*)(gsrc0 + (size_t)(st_) * 256 * 128 + i_ * 4 * 128 + 8 * ch_), (LAS unsigned*)(ldst0 + ((st_) & 1) * 65536 + i_ * 1024), 16, 0, 0); } } while (0)
    const unsigned q4 = (lane & 15) >> 2, p4 = lane & 3, blk = (lane >> 4) & 1;
    const unsigned fh = (unsigned)r32 & 3u, fl = ((unsigned)r32 >> 2) & 3u;
    const unsigned kl0 = 256u * (unsigned)r32 + 16u * (((unsigned)hh ^ fl) & 3u), kl1 = 256u * (unsigned)r32 + 16u * (((2u + (unsigned)hh) ^ fl) & 3u);
#define ATT_KA(s_) ((((s_) & 1) ? kl1 : kl0) + 64u * ((unsigned)((s_) >> 1) ^ fh))
    const unsigned vb = 256u * (4u * hh + q4) + 8u * (p4 & 1u), cl = 2u * blk + (p4 >> 1);
    const unsigned vlo0 = vb + 16u * ((cl ^ (unsigned)hh) & 3u), vlo1 = vb + 2048u + 16u * ((cl ^ (2u + (unsigned)hh)) & 3u);
    asm volatile("s_waitcnt lgkmcnt(0)" ::: "memory"); __builtin_amdgcn_s_barrier(); asm volatile("" ::: "memory");
    u32x4 mw0 = *(const GAS u32x4*)(mrow), mw1 = *(const GAS u32x4*)(mrow + 4);
    ATT_DMA_STAGE(0);
    for (int st = 0; st < ns; ++st) {
        asm volatile("s_waitcnt vmcnt(0) lgkmcnt(0)" ::: "memory"); __builtin_amdgcn_s_barrier(); asm volatile("" ::: "memory");
        if (st + 1 < ns) ATT_DMA_STAGE(st + 1);
        const LAS unsigned char* sb = kbuf + (st & 1) * 65536;
#define ATT_QK(S_, k_) do { bf16x8 kf_[2]; \
        _Pragma("unroll") for (int s_ = 0; s_ < 8; s_ += 2) { kf_[0] = *(const LAS bf16x8*)(sb + (k_) * 8192 + ATT_KA(s_)); kf_[1] = *(const LAS bf16x8*)(sb + (k_) * 8192 + ATT_KA(s_ + 1)); \
            S_ = __builtin_amdgcn_mfma_f32_32x32x16_bf16(kf_[0], qf[s_], s_ == 0 ? zero16 : S_, 0, 0, 0); S_ = __builtin_amdgcn_mfma_f32_32x32x16_bf16(kf_[1], qf[s_ + 1], S_, 0, 0, 0); } } while (0)
        f32x16 S;
        ATT_QK(S, 0);
#pragma unroll
        for (int k = 0; k < 8; ++k) {
            const LAS unsigned char* kb = sb + k * 8192;
            const unsigned wsh = (k < 4 ? mw0[k & 3] : mw1[k & 3]) >> (4 * hh);
            float ps = 0.f;
#pragma unroll
            for (int i = 0; i < 16; ++i) { const int pos = (i & 3) + 8 * (i >> 2);
                unsigned sel; asm("v_bfe_i32 %0, %1, %2, 1" : "=v"(sel) : "v"(wsh), "n"(pos));
                S[i] = __uint_as_float(__float_as_uint(__builtin_amdgcn_exp2f(S[i] - mref)) & sel); ps += S[i]; }
            lrun += ps;
            bf16x8 pf[2];
#pragma unroll
            for (int s = 0; s < 2; ++s) { u32x4 pw; pw.x = pk_bf16(S[8 * s + 0], S[8 * s + 1]); pw.y = pk_bf16(S[8 * s + 2], S[8 * s + 3]); pw.z = pk_bf16(S[8 * s + 4], S[8 * s + 5]); pw.w = pk_bf16(S[8 * s + 6], S[8 * s + 7]); pf[s] = __builtin_bit_cast(bf16x8, pw); }
            __builtin_amdgcn_sched_barrier(0);
            if (k < 7) ATT_QK(S, k + 1);
#pragma unroll
            for (int dt = 0; dt < 4; ++dt)
#pragma unroll
                for (int s = 0; s < 2; ++s) {
                    const s16x4 lo = vtr(kb + 4096 * s + vlo0 + 64u * ((unsigned)dt ^ q4));
                    const s16x4 hi = vtr(kb + 4096 * s + vlo1 + 64u * ((unsigned)dt ^ q4));
                    const bf16x8 vt = __builtin_shufflevector(lo, hi, 0, 1, 2, 3, 4, 5, 6, 7);
                    o[dt] = __builtin_amdgcn_mfma_f32_32x32x16_bf16(vt, pf[s], o[dt], 0, 0, 0);
                }
            if (k == 3) mw0 = *(const GAS u32x4*)(mrow + 8 * (st + 1));
            if (k == 7) mw1 = *(const GAS u32x4*)(mrow + 8 * (st + 1) + 4);
            __builtin_amdgcn_sched_barrier(0);
        }
#undef ATT_QK
#undef ATT_KA
    }
#undef ATT_DMA_STAGE
    lrun += shx(lrun, 32, lane);
    const float inv = 1.f / lrun;
    bf16* orow = OL + m * 1024 + head * 128 + 4 * hh;
#pragma unroll
    for (int dt = 0; dt < 4; ++dt)
#pragma unroll
        for (int g = 0; g < 4; ++g) { u32x2 w; w.x = pk_bf16(o[dt][4 * g] * inv, o[dt][4 * g + 1] * inv); w.y = pk_bf16(o[dt][4 * g + 2] * inv, o[dt][4 * g + 3] * inv);
            *(GAS u32x2*)(orow + 32 * dt + 8 * g) = w; }
}

__device__ __forceinline__ cargs_t kargs() { cargs_t p = (cargs_t)__builtin_amdgcn_kernarg_segment_ptr(); asm volatile("" : "+s"(p)); return p; }
__device__ __forceinline__ int lane_id() { unsigned z = 0u; asm volatile("" : "+v"(z)); int v = (int)__builtin_amdgcn_mbcnt_hi(~0u, __builtin_amdgcn_mbcnt_lo(~0u, z)); asm volatile("" : "+v"(v)); return v; }
__global__ void __launch_bounds__(NWAVES * 64, 2) fwd(Args args_unused) {
    extern __shared__ __attribute__((aligned(16))) unsigned char lds[];
    Frame F;
    F.lds = (LAS unsigned char*)lds;
    F.MISC = (volatile LAS unsigned*)(F.lds + MISC_OFF);
    F.wave = __builtin_amdgcn_readfirstlane((int)threadIdx.x >> 6);
    F.G = gridDim.x; { const int bx = blockIdx.x; F.vcu = (F.G % 8 == 0) ? (bx % 8) * (F.G / 8) + bx / 8 : bx; }
    F.ctl = (gu32*)(kargs()->ws + WS_CTL);
    for (int u = threadIdx.x; u < (LDS_BYTES - LDSCTL_OFF) / 4; u += NWAVES * 64) ((LAS unsigned*)(F.lds + LDSCTL_OFF))[u] = 0u;
    __syncthreads();
    XcdBarrier bar = xcd_barrier_post((unsigned*)(F.ctl + CW_BAR), F.MISC + 8, (unsigned)F.wave);
#define GRID_BAR() xcd_barrier(bar)
    const int gw = F.vcu * NWAVES + F.wave, NGW = F.G * NWAVES;
#define WSP(off) (kargs()->ws + (off))

    {
        LAS float* scr = (LAS float*)(F.lds + RING_OFF + F.wave * 16384);
        const cargs_t a = kargs(); const int lane = lane_id();
        for (int rep_ = 0; rep_ < (PROBE_DUP == 1 ? 2 : 1); ++rep_) {
        for (int it = sopq(gw); it < NL * I_LAYER; it += NGW) prologue_item(a, it, scr, lane);
        rms_phase_in(a->in[0], a->in[1], (bf16*)(a->ws + WS_XR), (bf16*)(a->ws + WS_XN), sopq(gw), NGW, lane);
        GRID_BAR(); }
    }
#define GEMM_PHASE(EPI_T, A_, B_, N_, K_, E_) do { const pg8::Gemm g_{(const pg8::bf16_t*)(A_), (const pg8::bf16_t*)(B_), M, (N_), (K_)}; pg8::StaticOrder S_; S_.init(M, (N_), F.G, (int)blockIdx.x); \
        pg8::gemm_phase<EPI_T, pg8::StaticOrder, true, true>(F.lds + RING_OFF, g_, S_, (E_), F.wave); } while (0)

#if PROBE_DUP == 9
    for (int xb_ = 0; xb_ < 16; ++xb_) GRID_BAR();
#endif
    for (int fi = 0; fi < 2 * NL; ++fi) {
        const int l = fi >> 1; const bool second = (fi & 1) != 0;
        const size_t wlo = WS_W + (size_t)l * LW;
        if (fi > 0) for (int rep_ = 0; rep_ < (PROBE_DUP == 1 ? 2 : 1); ++rep_) { const cargs_t a = kargs(); rms_phase((const bf16*)(a->ws + WS_XR), (second ? a->in[15] : a->in[1]) + (size_t)l * D, (bf16*)(a->ws + WS_XN), sopq(gw), NGW, lane_id()); GRID_BAR(); }
#if PROBE_DUP == 8
        { const cargs_t a = kargs(); const pg8::EpiSwiglu E{(pg8::bf16_t*)(a->ws + WS_ZA), FF}; GEMM_PHASE(pg8::EpiSwiglu, a->ws + WS_XN, a->ws + wlo + (second ? O_WGU2 : O_WGU1), 2 * FF, 256, E); GRID_BAR(); }
#endif
        for (int rep_ = 0; rep_ < (PROBE_DUP == 5 ? 2 : 1); ++rep_) { const cargs_t a = kargs(); const pg8::EpiSwiglu E{(pg8::bf16_t*)(a->ws + WS_ZA), FF}; GEMM_PHASE(pg8::EpiSwiglu, a->ws + WS_XN, a->ws + wlo + (second ? O_WGU2 : O_WGU1), 2 * FF, D, E); GRID_BAR(); }
        { const cargs_t a = kargs(); const pg8::EpiResid<1> E{(pg8::bf16_t*)(a->ws + WS_XR), D}; GEMM_PHASE(pg8::EpiResid<1>, a->ws + WS_ZA, a->ws + wlo + (second ? O_WD2 : O_WD1), D, FF, E); GRID_BAR(); }
        if (!second) {
            for (int rep_ = 0; rep_ < (PROBE_DUP == 1 ? 2 : 1); ++rep_) { const cargs_t a = kargs(); rms_phase((const bf16*)(a->ws + WS_XR), a->in[5] + (size_t)l * D, (bf16*)(a->ws + WS_XN), sopq(gw), NGW, lane_id()); GRID_BAR(); }
            for (int rep_ = 0; rep_ < (PROBE_DUP == 6 ? 2 : 1); ++rep_) { const cargs_t a = kargs(); const pg8::EpiPlainBf16 E{(pg8::bf16_t*)(a->ws + WS_ZA), ZA, (pg8::bf16_t*)(a->ws + WS_ZG), ZGN, ZA / 256}; GEMM_PHASE(pg8::EpiPlainBf16, a->ws + WS_XN, a->ws + wlo + O_WIN, ZN, D, E); GRID_BAR(); }
            { const cargs_t a = kargs(); const int lane = lane_id();
              for (int rep_ = 0; rep_ < (PROBE_DUP == 2 ? 2 : 1); ++rep_)
              prep_phase((const bf16*)(a->ws + WS_ZA), a->in[7] + (size_t)l * 128, (bf16*)(a->ws + WS_CK), (bf16*)(a->ws + WS_PO), sopq(gw), NGW, lane);
              for (int rep_ = 0; rep_ < (PROBE_DUP == 4 ? 2 : 1); ++rep_) {
              int b, qb; for (int i = 0; mix_unit(i, F.vcu, F.G, b, qb); ++i) select_unit((const bf16*)(a->ws + WS_ZA), (unsigned*)(a->ws + WS_MASK), b, qb, F.wave, lane, (unsigned*)(F.ctl + 2048)); }
              GRID_BAR(); }
            for (int rep_ = 0; rep_ < (PROBE_DUP == 3 ? 2 : 1); ++rep_) { const cargs_t a = kargs(); const int tid = F.wave * 64 + lane_id();
              int b, qb; for (int i = 0; mix_unit(i, F.vcu, F.G, b, qb); ++i) attn_unit(F.lds + RING_OFF, (const bf16*)(a->ws + WS_ZA), (const bf16*)(a->ws + WS_CK), (const unsigned*)(a->ws + WS_MASK), (bf16*)(a->ws + WS_OL), a->in[7] + (size_t)l * 128, b, qb, F.wave, tid & 63);
              asm volatile("s_waitcnt vmcnt(0) lgkmcnt(0)" ::: "memory"); __syncthreads();
              GRID_BAR(); }
            { const cargs_t a = kargs(); const pg8::EpiGate<false> E{(pg8::bf16_t*)(a->ws + WS_ZA), D, (const pg8::bf16_t*)(a->ws + WS_ZG), ZGN}; GEMM_PHASE(pg8::EpiGate<false>, a->ws + WS_OL, a->ws + wlo + O_WA, D, D, E); GRID_BAR(); }
            { const cargs_t a = kargs(); const pg8::EpiGate<true> E{(pg8::bf16_t*)(a->ws + WS_ZA), D, (const pg8::bf16_t*)(a->ws + WS_ZG) + 1024, ZGN}; GEMM_PHASE(pg8::EpiGate<true>, a->ws + WS_PO, a->ws + wlo + O_WP, D, 512, E); GRID_BAR(); }
            { const cargs_t a = kargs(); const pg8::EpiResid<0> E{(pg8::bf16_t*)(a->ws + WS_XR), D}; GEMM_PHASE(pg8::EpiResid<0>, a->ws + WS_ZA, a->ws + wlo + O_WO, D, D, E); GRID_BAR(); }
        }
    }
    {
        const cargs_t a = kargs();
        const bool poison = __hip_atomic_load((gu32*)(F.ctl + CW_BAR + XB_TMO), RLX_AGENT) != 0u;
        final_norm_phase((const bf16*)(a->ws + WS_XR), a->out, a->in[19], sopq(gw), NGW, lane_id(), poison, (const unsigned*)(F.ctl + 2048));
    }
}

extern "C" void kernel_launch(void* const* d_in, const int* in_sizes, int n_in, void* d_out, int out_size, void* d_ws, size_t ws_size, hipStream_t stream) {
    static int grid = 0;
    if (grid == 0) {
        if (n_in != 20 || in_sizes[0] != M * D || out_size != M * D || ws_size < WS_END) { fprintf(stderr, "kernel_launch: unexpected shapes (n_in %d, in0 %d, out %d, ws %zu); nothing launched\n", n_in, n_in > 0 ? in_sizes[0] : -1, out_size, ws_size); grid = -1; return; }
        int dev = 0, cus = 0, per_cu = 0;
        if (hipGetDevice(&dev) != hipSuccess || hipDeviceGetAttribute(&cus, hipDeviceAttributeMultiprocessorCount, dev) != hipSuccess) { fprintf(stderr, "kernel_launch: device query failed\n"); grid = -1; return; }
        if (hipFuncSetAttribute((const void*)fwd, hipFuncAttributeMaxDynamicSharedMemorySize, LDS_BYTES) != hipSuccess) { fprintf(stderr, "kernel_launch: hipFuncSetAttribute failed\n"); grid = -1; return; }
        if (hipOccupancyMaxActiveBlocksPerMultiprocessor(&per_cu, (const void*)fwd, NWAVES * 64, LDS_BYTES) != hipSuccess || per_cu < 1)
            fprintf(stderr, "kernel_launch: note: occupancy query reports %d workgroups per CU\n", per_cu);
        (void)hipGetLastError();
        grid = cus;
    }
    if (grid < 0) return;
    if (hipMemsetAsync((char*)d_ws + WS_CTL, 0, CTL_ZERO_BYTES, stream) != hipSuccess) { fprintf(stderr, "kernel_launch: hipMemsetAsync failed\n"); return; }
    Args a{};
    for (int i = 0; i < 20; ++i) a.in[i] = (const float*)d_in[i];
    a.out = (float*)d_out; a.ws = (unsigned char*)d_ws;
    hipLaunchKernelGGL(fwd, dim3(grid), dim3(NWAVES * 64), LDS_BYTES, stream, a);
    const hipError_t le = hipPeekAtLastError();
    if (le != hipSuccess) fprintf(stderr, "kernel_launch: launch failed: %s\n", hipGetErrorName(le));
}
```

```cpp
#ifndef PROBE_DUP
#define PROBE_DUP 0
#endif
#ifndef DIAG_SEL
#define DIAG_SEL 0
#endif
#include <hip/hip_runtime.h>
#include <cstdio>
#include <cstdint>
#include <cmath>
namespace pg8 {
#define PG8_LAS __attribute__((address_space(3)))
typedef unsigned short bf16_t;
typedef short bf16x8 __attribute__((ext_vector_type(8)));
typedef float f32x4 __attribute__((ext_vector_type(4)));
typedef unsigned u32x4 __attribute__((ext_vector_type(4)));
constexpr int BM = 256, BK = 64, HALF = 128, HTB = HALF * BK * 2  , STAGE_BYTES = 8 * HTB, NXCD = 8, WGM = 8;

__host__ __device__ __forceinline__ int lds_byte(int r, int c) { const int st = (r >> 4) * 2 + (c >> 5), rr = r & 15, cc = c & 31, ob = rr * 64 + cc * 2; return st * 1024 + (ob ^ (((ob >> 9) & 1) << 5)); }
__host__ __device__ __forceinline__ void stage_rc(int b, int& R, int& C) { const int st = b / 1024, sb = b % 1024, swz = sb ^ (((sb >> 9) & 1) << 5); R = (st >> 1) * 16 + swz / 64; C = (st & 1) * 32 + (swz % 64) / 2; }
__host__ __device__ __forceinline__ int perm32(int rho) { const int n = rho >> 4, i = rho & 15; return 8 * (i >> 2) + 4 * n + (i & 3); }

struct Unit { int pm, pn; };
struct Gemm { const bf16_t* A; const bf16_t* Bt; int M, N, K; };

struct StaticOrder {
    int nM, nN, nwg, G, c;
    __host__ __device__ void init(int M, int N, int G_, int c_) { nM = M / BM; nN = N / BM; nwg = nM * nN; G = G_; c = c_; }
    __host__ __device__ bool next(int i, Unit& u) const {
        const long L = (long)i * G + c; if (L >= nwg) return false;
        int wgid = (int)L; { const int q = nwg / NXCD, r = nwg % NXCD, xcd = wgid % NXCD, off = wgid / NXCD; wgid = (xcd < r ? xcd * (q + 1) : r * (q + 1) + (xcd - r) * q) + off; }
        const int nig = WGM * nN, gid = wgid / nig, fm = gid * WGM, gsz = (nM - fm) < WGM ? (nM - fm) : WGM;
        u.pm = fm + ((wgid % nig) % gsz); u.pn = (wgid % nig) / gsz; return true;
    }
    __device__ __forceinline__ void a_ready(const Unit&) const {}
    __device__ __forceinline__ void done(const Unit&) const {}
};

__device__ __forceinline__ unsigned cvt_pk_bf16(float lo, float hi) { unsigned r; asm volatile("v_cvt_pk_bf16_f32 %0, %1, %2" : "=v"(r) : "v"(lo), "v"(hi)); return r; }
typedef float f32x2 __attribute__((ext_vector_type(2)));
typedef __bf16 bf16x2_t __attribute__((ext_vector_type(2)));
__device__ __forceinline__ unsigned pk_bf16(float lo, float hi) { f32x2 v = {lo, hi}; bf16x2_t b = __builtin_convertvector(v, bf16x2_t); return __builtin_bit_cast(unsigned, b); }
__device__ __forceinline__ float sigm(float g) { return __builtin_amdgcn_rcpf(1.0f + __builtin_amdgcn_exp2f(-1.4426950408889634f * g)); }
__device__ __forceinline__ float bf_lo(unsigned w) { return __uint_as_float(w << 16); }
__device__ __forceinline__ float bf_hi(unsigned w) { return __uint_as_float(w & 0xffff0000u); }

__device__ __forceinline__ float xlane(float v, int m, int lane) { return __int_as_float(__builtin_amdgcn_ds_bpermute((lane ^ m) << 2, __float_as_int(v))); }
struct EpiPlainBf16 {
    static constexpr bool PERM = true, AFTER_DRAIN = false;
    bf16_t* O1; int ld1; bf16_t* O2; int ld2; int nsplit; const PG8_LAS float* rstab; const PG8_LAS unsigned char* pmap;
    __device__ __forceinline__ void operator()(const f32x4 (&acc)[2][2][4][2], const Unit& u, int wr, int wc, int fr, int fq) const {
        const PG8_LAS float* rs = rstab + 256 * (int)pmap[u.pm] + wr * 64 + fr;
        const bool first = u.pn < nsplit; bf16_t* O = first ? O1 : O2; const int ldc = first ? ld1 : ld2;
        const int row0 = u.pm * BM + wr * 64 + fr, col0 = (first ? u.pn : u.pn - nsplit) * BM + wc * 32 + 8 * fq;
#pragma unroll
        for (int ai = 0; ai < 2; ++ai)
#pragma unroll
            for (int m = 0; m < 4; ++m) { bf16_t* rowp = O + (size_t)(row0 + ai * HALF + m * 16) * ldc + col0;
                const float rr = rs[ai * HALF + m * 16];
#pragma unroll
                for (int bj = 0; bj < 2; ++bj) { const f32x4 v0 = acc[ai][bj][m][0] * rr, v1 = acc[ai][bj][m][1] * rr;
                    u32x4 w; w.x = pk_bf16(v0[0], v0[1]); w.y = pk_bf16(v0[2], v0[3]); w.z = pk_bf16(v1[0], v1[1]); w.w = pk_bf16(v1[2], v1[3]);
                    *(u32x4*)(rowp + bj * HALF) = w; } }
    }
};
struct EpiSwiglu {
    static constexpr bool PERM = true, AFTER_DRAIN = false;
    bf16_t* O; int ldc; const PG8_LAS float* rstab; const PG8_LAS unsigned char* pmap;
    __device__ __forceinline__ void operator()(const f32x4 (&acc)[2][2][4][2], const Unit& u, int wr, int wc, int fr, int fq) const {
        const PG8_LAS float* rs = rstab + 256 * (int)pmap[u.pm] + wr * 64 + fr;
        const int row0 = u.pm * BM + wr * 64 + fr, col0 = u.pn * HALF + wc * 32 + 8 * fq;
#pragma unroll
        for (int ai = 0; ai < 2; ++ai)
#pragma unroll
            for (int m = 0; m < 4; ++m) { bf16_t* rowp = O + (size_t)(row0 + ai * HALF + m * 16) * ldc + col0;
                const float rr = rs[ai * HALF + m * 16];
                f32x4 h0, h1;
#pragma unroll
                for (int j = 0; j < 4; ++j) { const float g0 = acc[ai][0][m][0][j] * rr, g1 = acc[ai][0][m][1][j] * rr;
                    h0[j] = g0 * sigm(g0) * (acc[ai][1][m][0][j] * rr); h1[j] = g1 * sigm(g1) * (acc[ai][1][m][1][j] * rr); }
                u32x4 w; w.x = pk_bf16(h0[0], h0[1]); w.y = pk_bf16(h0[2], h0[3]); w.z = pk_bf16(h1[0], h1[1]); w.w = pk_bf16(h1[2], h1[3]);
                *(u32x4*)rowp = w; }
    }
};
template <int HALFSTEP> struct EpiResid {
    static constexpr bool PERM = false, AFTER_DRAIN = false;
    bf16_t* X; int ldc; float* ssq;
    __device__ __forceinline__ void operator()(const f32x4 (&acc)[2][2][4][2], const Unit& u, int wr, int wc, int fr, int fq) const {
        const int row0 = u.pm * BM + wr * 64 + fr, col0 = u.pn * BM + wc * 32 + 4 * fq, lane = fr + 16 * fq;
        typedef unsigned u32x2_t __attribute__((ext_vector_type(2)));
#pragma unroll
        for (int ai = 0; ai < 2; ++ai) {
            u32x2_t b[4][2][2];
#pragma unroll
            for (int m = 0; m < 4; ++m)
#pragma unroll
                for (int bj = 0; bj < 2; ++bj)
#pragma unroll
                    for (int n = 0; n < 2; ++n) b[m][bj][n] = *(const u32x2_t*)(X + (size_t)(row0 + ai * HALF + m * 16) * ldc + col0 + bj * HALF + n * 16);
#pragma unroll
            for (int m = 0; m < 4; ++m) { const size_t r = (size_t)(row0 + ai * HALF + m * 16); bf16_t* rowp = X + r * ldc + col0; float ss = 0.f;
#pragma unroll
                for (int bj = 0; bj < 2; ++bj)
#pragma unroll
                    for (int n = 0; n < 2; ++n) { const f32x4 a = acc[ai][bj][m][n] * (HALFSTEP ? 0.5f : 1.0f); const u32x2_t bb = b[m][bj][n];
                        const float x0 = bf_lo(bb.x) + a[0], x1 = bf_hi(bb.x) + a[1], x2 = bf_lo(bb.y) + a[2], x3 = bf_hi(bb.y) + a[3];
                        u32x2_t w; w.x = pk_bf16(x0, x1); w.y = pk_bf16(x2, x3);
                        *(u32x2_t*)(rowp + bj * HALF + n * 16) = w; ss += (x0 * x0 + x1 * x1) + (x2 * x2 + x3 * x3); }
                ss += xlane(ss, 16, lane); ss += xlane(ss, 32, lane);
                if (fq == 0) ssq[r * 16 + 4 * u.pn + wc] = ss; }
            __builtin_amdgcn_sched_barrier(0);
        }
    }
};
template <bool ADD> struct EpiGate {
    static constexpr bool PERM = true, AFTER_DRAIN = false;
    bf16_t* O; int ldc; const bf16_t* G; int ldg;
    __device__ __forceinline__ void operator()(const f32x4 (&acc)[2][2][4][2], const Unit& u, int wr, int wc, int fr, int fq) const {
        const int row0 = u.pm * BM + wr * 64 + fr, col0 = u.pn * BM + wc * 32 + 8 * fq;
#pragma unroll
        for (int ai = 0; ai < 2; ++ai) {
            u32x4 gq[4][2], oq[4][2];
#pragma unroll
            for (int m = 0; m < 4; ++m)
#pragma unroll
                for (int bj = 0; bj < 2; ++bj) { const size_t r = (size_t)(row0 + ai * HALF + m * 16);
                    gq[m][bj] = *(const u32x4*)(G + r * ldg + col0 + bj * HALF);
                    if (ADD) oq[m][bj] = *(const u32x4*)(O + r * ldc + col0 + bj * HALF); }
#pragma unroll
            for (int m = 0; m < 4; ++m) { const size_t r = (size_t)(row0 + ai * HALF + m * 16);
#pragma unroll
                for (int bj = 0; bj < 2; ++bj) { const f32x4 v0 = acc[ai][bj][m][0], v1 = acc[ai][bj][m][1]; const u32x4 g = gq[m][bj];
                    float r0 = sigm(bf_lo(g.x)) * v0[0], r1 = sigm(bf_hi(g.x)) * v0[1], r2 = sigm(bf_lo(g.y)) * v0[2], r3 = sigm(bf_hi(g.y)) * v0[3];
                    float r4 = sigm(bf_lo(g.z)) * v1[0], r5 = sigm(bf_hi(g.z)) * v1[1], r6 = sigm(bf_lo(g.w)) * v1[2], r7 = sigm(bf_hi(g.w)) * v1[3];
                    if (ADD) { const u32x4 o = oq[m][bj]; r0 += bf_lo(o.x); r1 += bf_hi(o.x); r2 += bf_lo(o.y); r3 += bf_hi(o.y); r4 += bf_lo(o.z); r5 += bf_hi(o.z); r6 += bf_lo(o.w); r7 += bf_hi(o.w); }
                    u32x4 w; w.x = pk_bf16(r0, r1); w.y = pk_bf16(r2, r3); w.z = pk_bf16(r4, r5); w.w = pk_bf16(r6, r7);
                    *(u32x4*)(O + r * ldc + col0 + bj * HALF) = w; } }
            __builtin_amdgcn_sched_barrier(0);
        }
    }
};
template <class Epi, class Sched, bool ALIGN_EPI = false, bool SP2 = false>
__device__ __forceinline__ void gemm_phase(PG8_LAS unsigned char* lds, const Gemm g, const Sched S, const Epi E, const int wave_id) {
    unsigned z_o = 0u; asm volatile("" : "+v"(z_o)); int tid_o = wave_id * 64 + (int)__builtin_amdgcn_mbcnt_hi(~0u, __builtin_amdgcn_mbcnt_lo(~0u, z_o)); asm volatile("" : "+v"(tid_o));
    const int tid = tid_o, wid = __builtin_amdgcn_readfirstlane(tid >> 6), lane = tid & 63, wr = wid >> 2, wc = wid & 3, fr = lane & 15, fq = lane >> 4;
    const int K = g.K, nt = K / BK;
    unsigned voffA[2], voffB[2];
#pragma unroll
    for (int i = 0; i < 2; ++i) { int R, C; stage_rc(tid * 16 + i * 8192, R, C); const int Rb = Epi::PERM ? ((R & ~31) + perm32(R & 31)) : R;
        voffA[i] = (unsigned)(R * K + C) * 2u; voffB[i] = (unsigned)(Rb * K + C) * 2u; }
    const size_t kstep = (size_t)(BK * 2);
    const size_t hstep = (size_t)HALF * K * 2;
    const size_t tstep = 2 * hstep;
    const unsigned ldsw = (unsigned)wid * 1024u;
    const int aoff = lds_byte(wr * 64 + fr, fq * 8), boff = lds_byte(wc * 32 + fr, fq * 8);
#define PG8_SA(b, h) (((b) * 2 + (h)) * HTB)
#define PG8_SB(b, h) ((4 + (b) * 2 + (h)) * HTB)
#define PG8_STAGE(bufoff, gbase, voff) do { _Pragma("unroll") for (int _i = 0; _i < 2; ++_i) \
        __builtin_amdgcn_global_load_lds((const unsigned*)((const char*)(gbase) + (voff)[_i]), (PG8_LAS unsigned*)(lds + (bufoff) + ldsw + _i * 8192), 16, 0, 0); } while (0)
#define PG8_LDA(dst, b, h) do { _Pragma("unroll") for (int m = 0; m < 4; ++m) _Pragma("unroll") for (int k = 0; k < 2; ++k) dst[m][k] = *(const PG8_LAS bf16x8*)(lds + PG8_SA(b, h) + aoff + m * 2048 + k * 1024); } while (0)
#define PG8_LDB(dst, b, h) do { _Pragma("unroll") for (int n = 0; n < 2; ++n) _Pragma("unroll") for (int k = 0; k < 2; ++k) dst[n][k] = *(const PG8_LAS bf16x8*)(lds + PG8_SB(b, h) + boff + n * 2048 + k * 1024); } while (0)
#define PG8_MMA(ai, bj, At, Bt) do { __builtin_amdgcn_s_setprio(1); _Pragma("unroll") for (int m = 0; m < 4; ++m) _Pragma("unroll") for (int n = 0; n < 2; ++n) _Pragma("unroll") for (int k = 0; k < 2; ++k) \
        acc[ai][bj][m][n] = __builtin_amdgcn_mfma_f32_16x16x32_bf16(Bt[n][k], At[m][k], acc[ai][bj][m][n], 0, 0, 0); __builtin_amdgcn_s_setprio(0); } while (0)
#define PG8_WAIT_V(n) asm volatile("s_waitcnt vmcnt(" #n ")" ::: "memory")
#define PG8_WAIT_L(n) asm volatile("s_waitcnt lgkmcnt(" #n ")" ::: "memory")
#define PG8_BAR __builtin_amdgcn_s_barrier()
#define PG8_SCHED __builtin_amdgcn_sched_barrier(0)
    Unit cur, nxt; int ui = 0;
    if (!S.next(0, cur)) return;
    f32x4 acc[2][2][4][2];
#pragma unroll
    for (int a = 0; a < 2; ++a)
#pragma unroll
        for (int b = 0; b < 2; ++b)
#pragma unroll
            for (int m = 0; m < 4; ++m)
#pragma unroll
                for (int n = 0; n < 2; ++n) acc[a][b][m][n] = (f32x4){0.f, 0.f, 0.f, 0.f};
    bf16x8 At[4][2], B0[2][2], B1[2][2];
    const char* cA = (const char*)g.A + (size_t)cur.pm * tstep; const char* cB = (const char*)g.Bt + (size_t)cur.pn * tstep;
    S.a_ready(cur);
    if constexpr (SP2) {
        PG8_STAGE(PG8_SB(0, 0), cB, voffB); PG8_STAGE(PG8_SB(0, 1), cB + hstep, voffB); PG8_STAGE(PG8_SA(0, 0), cA, voffA); PG8_STAGE(PG8_SA(0, 1), cA + hstep, voffA);
        if (wr == 1) PG8_BAR;
        PG8_WAIT_V(2); PG8_BAR;
        PG8_STAGE(PG8_SB(1, 0), cB + kstep, voffB); PG8_STAGE(PG8_SA(1, 0), cA + kstep, voffA); PG8_STAGE(PG8_SB(1, 1), cB + hstep + kstep, voffB);
        PG8_WAIT_V(6); PG8_BAR;
    } else {
        PG8_STAGE(PG8_SB(0, 0), cB, voffB); PG8_STAGE(PG8_SA(0, 0), cA, voffA); PG8_STAGE(PG8_SB(0, 1), cB + hstep, voffB); PG8_STAGE(PG8_SA(0, 1), cA + hstep, voffA);
        if (wr == 1) PG8_BAR;
        PG8_WAIT_V(4); PG8_BAR;
        PG8_STAGE(PG8_SB(1, 0), cB + kstep, voffB); PG8_STAGE(PG8_SA(1, 0), cA + kstep, voffA); PG8_STAGE(PG8_SB(1, 1), cB + hstep + kstep, voffB);
        PG8_WAIT_V(6); PG8_BAR;
    }
    for (;;) {
        const bool has_next = S.next(ui + 1, nxt);
        const char* nA = has_next ? (const char*)g.A + (size_t)nxt.pm * tstep : cA; const char* nB = has_next ? (const char*)g.Bt + (size_t)nxt.pn * tstep : cB;
        for (int t = 0; t < nt; t += 2) {
            const bool last = (t == nt - 2);
            const char* a1 = cA + (size_t)(t + 1) * kstep;
            const char* a2 = last ? nA : cA + (size_t)(t + 2) * kstep; const char* b2 = last ? nB : cB + (size_t)(t + 2) * kstep;
            const char* a3 = a2 + kstep; const char* b3 = b2 + kstep;
            if (last && has_next) S.a_ready(nxt);
            if constexpr (SP2) {
            PG8_LDB(B0, 0, 0); PG8_LDB(B1, 0, 1); PG8_SCHED; PG8_LDA(At, 0, 0); PG8_STAGE(PG8_SA(1, 1), a1 + hstep, voffA);
            PG8_WAIT_V(8); PG8_WAIT_L(0); PG8_BAR; PG8_MMA(0, 0, At, B0); PG8_MMA(0, 1, At, B1); PG8_BAR; PG8_SCHED;
            PG8_LDA(At, 0, 1); PG8_STAGE(PG8_SB(0, 0), b2, voffB); PG8_STAGE(PG8_SB(0, 1), b2 + hstep, voffB); PG8_STAGE(PG8_SA(0, 0), a2, voffA);
            PG8_WAIT_V(8); PG8_WAIT_L(0); PG8_BAR; PG8_MMA(1, 0, At, B0); PG8_MMA(1, 1, At, B1); PG8_BAR; PG8_SCHED;
            PG8_LDB(B0, 1, 0); PG8_LDB(B1, 1, 1); PG8_SCHED; PG8_LDA(At, 1, 0); PG8_STAGE(PG8_SA(0, 1), a2 + hstep, voffA);
            PG8_WAIT_V(8); PG8_WAIT_L(0); PG8_BAR; PG8_MMA(0, 0, At, B0); PG8_MMA(0, 1, At, B1); PG8_BAR; PG8_SCHED;
            PG8_LDA(At, 1, 1); PG8_STAGE(PG8_SB(1, 0), b3, voffB); PG8_STAGE(PG8_SB(1, 1), b3 + hstep, voffB); PG8_STAGE(PG8_SA(1, 0), a3, voffA);
            PG8_WAIT_V(8); PG8_WAIT_L(0); PG8_BAR; PG8_MMA(1, 0, At, B0); PG8_MMA(1, 1, At, B1); PG8_BAR; PG8_SCHED;
            } else {
            PG8_LDB(B0, 0, 0); PG8_SCHED; PG8_LDA(At, 0, 0); PG8_STAGE(PG8_SA(1, 1), a1 + hstep, voffA);
            PG8_WAIT_L(8); PG8_BAR; PG8_WAIT_L(0); PG8_MMA(0, 0, At, B0); PG8_BAR; PG8_SCHED;
            PG8_LDB(B1, 0, 1); PG8_STAGE(PG8_SB(0, 0), b2, voffB);
            PG8_BAR; PG8_WAIT_L(0); PG8_MMA(0, 1, At, B1); PG8_BAR;
            PG8_LDA(At, 0, 1); PG8_STAGE(PG8_SA(0, 0), a2, voffA);
            PG8_BAR; PG8_WAIT_L(0); PG8_MMA(1, 0, At, B0); PG8_BAR; PG8_SCHED;
            PG8_STAGE(PG8_SB(0, 1), b2 + hstep, voffB);
            PG8_WAIT_V(6); PG8_BAR; PG8_MMA(1, 1, At, B1); PG8_BAR;
            PG8_LDB(B0, 1, 0); PG8_SCHED; PG8_LDA(At, 1, 0); PG8_STAGE(PG8_SA(0, 1), a2 + hstep, voffA);
            PG8_WAIT_L(8); PG8_BAR; PG8_WAIT_L(0); PG8_MMA(0, 0, At, B0); PG8_BAR; PG8_SCHED;
            PG8_LDB(B1, 1, 1); PG8_STAGE(PG8_SB(1, 0), b3, voffB);
            PG8_BAR; PG8_WAIT_L(0); PG8_MMA(0, 1, At, B1); PG8_BAR;
            PG8_LDA(At, 1, 1); PG8_STAGE(PG8_SA(1, 0), a3, voffA);
            PG8_BAR; PG8_WAIT_L(0); PG8_MMA(1, 0, At, B0); PG8_BAR; PG8_SCHED;
            PG8_STAGE(PG8_SB(1, 1), b3 + hstep, voffB);
            PG8_WAIT_V(6); PG8_BAR; PG8_MMA(1, 1, At, B1); PG8_BAR;
            }
        }
        if constexpr (ALIGN_EPI) { if (wr == 0) PG8_BAR; }
        if constexpr (!Epi::AFTER_DRAIN) { E(acc, cur, wr, wc, fr, fq); S.done(cur); }
        if (!has_next) break;
#pragma unroll
        for (int a = 0; a < 2; ++a)
#pragma unroll
            for (int b = 0; b < 2; ++b)
#pragma unroll
                for (int m = 0; m < 4; ++m)
#pragma unroll
                    for (int n = 0; n < 2; ++n) acc[a][b][m][n] = (f32x4){0.f, 0.f, 0.f, 0.f};
        cur = nxt; cA = nA; cB = nB; ++ui;
        if constexpr (ALIGN_EPI) { if (wr == 1) PG8_BAR; }
    }
    PG8_WAIT_V(0);
    if constexpr (!ALIGN_EPI) { if (wr == 0) PG8_BAR; }
    PG8_BAR;
    if constexpr (Epi::AFTER_DRAIN) { E.fused(acc, cur, wr, wc, fr, fq, lds, wid, lane); S.done(cur); }
#undef PG8_SA
#undef PG8_SB
#undef PG8_STAGE
#undef PG8_LDA
#undef PG8_LDB
#undef PG8_MMA
#undef PG8_WAIT_V
#undef PG8_WAIT_L
#undef PG8_BAR
#undef PG8_SCHED
}
}
#define GAS __attribute__((address_space(1)))
#define LAS __attribute__((address_space(3)))
typedef unsigned short bf16;
typedef unsigned v4u __attribute__((ext_vector_type(4)));
typedef float f32x4 __attribute__((ext_vector_type(4)));
typedef short bf16x8 __attribute__((ext_vector_type(8)));
typedef GAS unsigned gu32;
typedef GAS unsigned long long gu64;
#define RLX_AGENT __ATOMIC_RELAXED, __HIP_MEMORY_SCOPE_AGENT
#define LDS_WAIT() asm volatile("s_waitcnt lgkmcnt(0)" ::: "memory")
#define VM_WAIT() asm volatile("s_waitcnt vmcnt(0)" ::: "memory")
__device__ __forceinline__ unsigned long long rt() { return __builtin_amdgcn_s_memrealtime(); }
__device__ __forceinline__ unsigned f2bf(float f) { unsigned u = __builtin_bit_cast(unsigned, f); return (u + 0x7fffu + ((u >> 16) & 1u)) >> 16; }
__device__ __forceinline__ unsigned pk2(float lo, float hi) { return f2bf(lo) | (f2bf(hi) << 16); }

#define XB_TMO      128
#define XB_XCNT(j)  (256  + 64 * (j))
#define XB_XSUB(j)  (1280 + 64 * (j))
#define XB_XGEN(j)  (2304 + 64 * (j))
#define XB_TOP      3328
#define XB_TOPGEN   3392
#define XCD_BAR_WORDS 3456
#define XB_SPIN_CAP (1u << 18)

__device__ __forceinline__ unsigned xb_ld(unsigned* p)              { return __hip_atomic_load(p, __ATOMIC_RELAXED, __HIP_MEMORY_SCOPE_AGENT); }
__device__ __forceinline__ unsigned xb_add(unsigned* p, unsigned v) { return __hip_atomic_fetch_add(p, v, __ATOMIC_RELAXED, __HIP_MEMORY_SCOPE_AGENT); }
__device__ __forceinline__ unsigned xb_xcc_id() { return (unsigned)__builtin_amdgcn_s_getreg((3 << 11) | 20) & 0xFu; }
#define XB_SPIN(cond, bar) do { unsigned _sp = 0; while (cond) { __builtin_amdgcn_s_sleep(1); \
    if ((++_sp & 255u) == 0u) { if (xb_ld(&(bar)[XB_TMO])) break; if (_sp > XB_SPIN_CAP) { atomicAdd(&(bar)[XB_TMO], 1u); break; } } } } while (0)

struct XcdBarrier {
    unsigned wv;
    unsigned* bar; unsigned x;
    volatile LAS unsigned* st;
};

__device__ __forceinline__ bool xb_thread0(unsigned wv) { unsigned z = 0u; asm volatile("" : "+v"(z)); return wv == 0u && __builtin_amdgcn_mbcnt_hi(~0u, __builtin_amdgcn_mbcnt_lo(~0u, z)) == 0u; }
__device__ __forceinline__ XcdBarrier xcd_barrier_post(unsigned* bar, volatile LAS unsigned* st, unsigned wv) {
    XcdBarrier b; b.wv = wv; b.bar = bar; b.x = (unsigned)__builtin_amdgcn_readfirstlane((int)xb_xcc_id());     b.st = st;
    if (xb_thread0(wv)) (void)xb_add(&bar[XB_XCNT(b.x)], 1u);
    return b;
}
__device__ __forceinline__ void xcd_barrier_complete(unsigned* bar, unsigned x, unsigned& nloc, unsigned& nx) {
    const unsigned G = gridDim.x * gridDim.y * gridDim.z;
    unsigned sum, cnt, mine, sp = 0u;
    for (;;) {
        sum = 0u; cnt = 0u; mine = 0u;
#pragma unroll
        for (unsigned j = 0; j < 16; ++j) { const unsigned c = xb_ld(&bar[XB_XCNT(j)]); sum += c; cnt += (c > 0u) ? 1u : 0u; mine = (j == x) ? c : mine; }
        if (sum == G) break;
        __builtin_amdgcn_s_sleep(1);
        if ((++sp & 255u) == 0u) { if (xb_ld(&bar[XB_TMO])) break; if (sp > XB_SPIN_CAP) { atomicAdd(&bar[XB_TMO], 1u); break; } }
    }
    nloc = mine > 0u ? mine : 1u; nx = cnt > 0u ? cnt : 1u;
}

__device__ __forceinline__ void xcd_barrier(const XcdBarrier& b) {
    asm volatile("s_waitcnt vmcnt(0)" ::: "memory");
    __syncthreads();
    if (xb_thread0(b.wv)) {
        unsigned* bar = b.bar;
        __builtin_amdgcn_s_waitcnt(0);
        unsigned nloc = b.st[0], nx = b.st[1];
        if (nloc == 0u) { xcd_barrier_complete(bar, b.x, nloc, nx); b.st[0] = nloc; b.st[1] = nx; }
        const unsigned old = xb_add(&bar[XB_XSUB(b.x)], 1u);
        const unsigned gen = old / nloc;
        if (old + 1u == (gen + 1u) * nloc) {
            __builtin_amdgcn_fence(__ATOMIC_RELEASE, "agent");
            asm volatile("s_waitcnt vmcnt(0)" ::: "memory");
            const unsigned og = xb_add(&bar[XB_TOP], 1u);
            const unsigned tg = og / nx;
            if (og + 1u == (tg + 1u) * nx) xb_add(&bar[XB_TOPGEN], 1u);
            else XB_SPIN(xb_ld(&bar[XB_TOPGEN]) == tg, bar);
            __builtin_amdgcn_fence(__ATOMIC_ACQUIRE, "agent");
            xb_add(&bar[XB_XGEN(b.x)], 1u);
            asm volatile("s_waitcnt vmcnt(0)" ::: "memory");
        } else {
            XB_SPIN(xb_ld(&bar[XB_XGEN(b.x)]) == gen, bar);
            __builtin_amdgcn_fence(__ATOMIC_ACQUIRE, "agent");
            asm volatile("s_waitcnt vmcnt(0)" ::: "memory");
        }
    }
    __syncthreads();
}

constexpr int NWAVES = 8;
constexpr int BATCH = 32, T = 2048, D = 1024, FF = 2816, NL = 2;
constexpr int M = BATCH * T;
constexpr int DIN = 3784;
constexpr int ZN = 4352;
constexpr int ZA = 2304, ZGN = 2048;
constexpr int Z_QL = 0, Z_QI = 1024, Z_PI = 1536, Z_CKV = 2048, Z_KI = 2176, Z_WI = 2240;
constexpr int R_GA = 2304, R_GB = 3328;
constexpr int S_Q = 0, S_CKV = 512, S_QI = 640, S_KI = 1152, S_WI = 1216, S_PI = 1224, S_GA = 1736, S_GB = 2760;
constexpr float EPS = 1e-6f;
constexpr float IDX_SCALE = 0.044194173824159216f;
constexpr float QSCALE = 0.125f * 1.4426950408889634f;

constexpr size_t MiB = 1u << 20;
constexpr size_t WS_CTL = 0, CTL_ZERO_BYTES = 1 * MiB;
constexpr size_t WS_W = 1 * MiB, LW = 46 * MiB + MiB / 2;
constexpr size_t O_WGU1 = 0, O_WD1 = 11 * MiB, O_WIN = 16 * MiB + MiB / 2, O_WA = 25 * MiB, O_WP = 27 * MiB, O_WO = 28 * MiB, O_WGU2 = 30 * MiB, O_WD2 = 41 * MiB;
constexpr size_t WS_XR = 96 * MiB;
constexpr size_t WS_ZA = 224 * MiB;
constexpr size_t WS_ZG = 512 * MiB;
constexpr size_t WS_OL = 768 * MiB;
constexpr size_t WS_XN = WS_OL;
constexpr size_t WS_PO = 896 * MiB;
constexpr size_t WS_CK = 960 * MiB;
constexpr size_t WS_MASK = 976 * MiB;
constexpr size_t WS_SSQ = 992 * MiB;
constexpr size_t WS_END = 996 * MiB;
static_assert(WS_W + NL * LW <= WS_XR && WS_XR + (size_t)M * D * 2 <= WS_ZA && WS_ZA + (size_t)M * ZA * 2 <= WS_ZG && WS_ZG + (size_t)M * ZGN * 2 <= WS_OL && WS_ZA + (size_t)M * FF * 2 <= WS_OL, "d_ws map");
static_assert(O_WD2 + (size_t)D * FF * 2 <= LW && O_WIN + (size_t)ZN * D * 2 <= O_WA, "weight map");
constexpr int CW_TMO = 0, CW_CODE = 1, CW_BAR = 4096;

constexpr int RING_OFF = 0, RING_BYTES = 131072;
constexpr int LDSCTL_OFF = RING_BYTES, MISC_OFF = LDSCTL_OFF + 320;
constexpr int RSTAB_OFF = LDSCTL_OFF + 512, RSTAB_SLOTS = 8, PMAP_OFF = RSTAB_OFF + RSTAB_SLOTS * 1024, PLIST_OFF = PMAP_OFF + 256;
constexpr int LDS_BYTES = 147456;

struct Args { const float* in[20]; float* out; unsigned char* ws; };
typedef const Args __attribute__((address_space(4)))* cargs_t;
struct Frame {
    LAS unsigned char* lds;
    volatile LAS unsigned* MISC;
    gu32* ctl;
    int wave;
    int vcu, G;
};

typedef unsigned u32x4 __attribute__((ext_vector_type(4)));
typedef unsigned u32x2 __attribute__((ext_vector_type(2)));
typedef float f32x16 __attribute__((ext_vector_type(16)));
typedef short s16x4 __attribute__((ext_vector_type(4)));
using pg8::pk_bf16; using pg8::bf_lo; using pg8::bf_hi;

__device__ __forceinline__ float shx(float v, int m, int lane) { return __int_as_float(__builtin_amdgcn_ds_bpermute((lane ^ m) << 2, __float_as_int(v))); }
__device__ __forceinline__ float wave_sum(float v, int lane) {
#pragma unroll
    for (int o = 1; o < 64; o <<= 1) v += shx(v, o, lane);
    return v;
}
__device__ __forceinline__ int sopq(int v) { asm volatile("" : "+s"(v)); return v; }

__device__ __forceinline__ void tr_item(const float* W, int ldw, int c0, int k0, bf16* WT, int Kd, int drow0, LAS float* scr, int lane, const float* gk = nullptr) {
#pragma unroll 16
    for (int i = 0; i < 32; ++i) { const int kk = 2 * i + (lane >> 5); const float gg = gk ? gk[k0 + kk] : 1.0f; scr[kk * 33 + (lane & 31)] = W[(size_t)(k0 + kk) * ldw + c0 + (lane & 31)] * gg; }
    LDS_WAIT(); asm volatile("" ::: "memory");
    const int c = lane & 7;
#pragma unroll
    for (int j = 0; j < 4; ++j) { const int n = (lane >> 3) + 8 * j; const LAS float* s = scr + (8 * c) * 33 + n;
        v4u o; o.x = pk2(s[0 * 33], s[1 * 33]); o.y = pk2(s[2 * 33], s[3 * 33]); o.z = pk2(s[4 * 33], s[5 * 33]); o.w = pk2(s[6 * 33], s[7 * 33]);
        *(GAS v4u*)(WT + (size_t)(drow0 + n) * Kd + k0 + 8 * c) = o; }
    LDS_WAIT(); asm volatile("" ::: "memory");
}
constexpr int I_GU = 16 * 88, I_DN = 44 * 32, I_WO = 16 * 32, I_WIN = 16 * 103, I_ZERO = 1, I_QL = 1024, I_WA = 2048, I_WP = 1024;
constexpr int I_LAYER = 6 * I_GU + I_WO + I_WIN + I_ZERO + I_QL + I_WA + I_WP;
static_assert(I_GU == I_DN, "item counts");

__device__ __forceinline__ void prologue_item(cargs_t ka, int it, LAS float* scr, int lane) {
    const float* const __attribute__((address_space(4)))* in = ka->in; unsigned char* ws = ka->ws;
    const int l = it / I_LAYER; int r = it - l * I_LAYER;
    unsigned char* wl = ws + WS_W + (size_t)l * LW;
    if (r < I_WA) {
        const int hh = r >> 8, cb = (r >> 4) & 15, ib = r & 15, n = 64 * ib + lane;
        const float* wuv = in[9] + (size_t)l * 128 * 8 * 64; const float* wba = in[12] + (size_t)l * 512 * 1024;
        float a[8];
#pragma unroll
        for (int j = 0; j < 8; ++j) a[j] = 0.f;
#pragma unroll 16
        for (int d = 0; d < 64; ++d) { const float wv = wba[(size_t)(hh * 64 + d) * 1024 + n];
#pragma unroll
            for (int j = 0; j < 8; ++j) a[j] += wuv[((8 * cb + j) * 8 + hh) * 64 + d] * wv; }
        v4u o; o.x = pk2(a[0], a[1]); o.y = pk2(a[2], a[3]); o.z = pk2(a[4], a[5]); o.w = pk2(a[6], a[7]);
        *(GAS v4u*)((bf16*)(wl + O_WA) + (size_t)n * 1024 + hh * 128 + 8 * cb) = o; return; }
    r -= I_WA;
    if (r < I_WP) {
        const int g = r >> 8, cb = (r >> 4) & 15, ib = r & 15, n = 64 * ib + lane;
        const float* pw = in[10] + (size_t)l * 4 * 128 * 128; const float* ps = in[11] + (size_t)l * 512; const float* wbp = in[13] + (size_t)l * 512 * 1024;
        float a[8];
#pragma unroll
        for (int j = 0; j < 8; ++j) a[j] = 0.f;
#pragma unroll 16
        for (int d = 0; d < 128; ++d) { const float wv = wbp[(size_t)(g * 128 + d) * 1024 + n] * ps[g * 128 + d];
#pragma unroll
            for (int j = 0; j < 8; ++j) a[j] += pw[(size_t)(g * 128 + 8 * cb + j) * 128 + d] * wv; }
        v4u o; o.x = pk2(a[0], a[1]); o.y = pk2(a[2], a[3]); o.z = pk2(a[4], a[5]); o.w = pk2(a[6], a[7]);
        *(GAS v4u*)((bf16*)(wl + O_WP) + (size_t)n * 512 + g * 128 + 8 * cb) = o; return; }
    r -= I_WP;
    if (r < I_QL) {
        const int n = r, hh = n >> 7, c = n & 127;
        const float* win = in[6] + (size_t)l * D * DIN; const f32x4* wuk = (const f32x4*)(in[8] + (size_t)l * 128 * 8 * 64 + (size_t)(c * 8 + hh) * 64);
        bf16* dst = (bf16*)(wl + O_WIN) + (size_t)n * D;
        for (int i = 0; i < 16; ++i) { const int k = 64 * i + lane; const f32x4* wr = (const f32x4*)(win + (size_t)k * DIN + hh * 64); float a = 0.f;
#pragma unroll 4
            for (int d4 = 0; d4 < 16; ++d4) { const f32x4 x = wr[d4], y = wuk[d4]; a += (x.x * y.x + x.y * y.y) + (x.z * y.z + x.w * y.w); }
            dst[k] = (bf16)f2bf(a * (QSCALE * in[5][(size_t)l * D + k])); }
        return; }
    r -= I_QL;
    if (r < I_GU) { const int kb = r / 88, nb = r % 88, n0 = 32 * nb; tr_item(in[2] + (size_t)l * D * FF, FF, n0, 64 * kb, (bf16*)(wl + O_WGU1), D, 256 * (n0 >> 7) + (n0 & 127), scr, lane, in[1] + (size_t)l * D); return; }
    r -= I_GU;
    if (r < I_GU) { const int kb = r / 88, nb = r % 88, n0 = 32 * nb; tr_item(in[3] + (size_t)l * D * FF, FF, n0, 64 * kb, (bf16*)(wl + O_WGU1), D, 256 * (n0 >> 7) + 128 + (n0 & 127), scr, lane, in[1] + (size_t)l * D); return; }
    r -= I_GU;
    if (r < I_DN) { const int kb = r / 32, nb = r % 32; tr_item(in[4] + (size_t)l * FF * D, D, 32 * nb, 64 * kb, (bf16*)(wl + O_WD1), FF, 32 * nb, scr, lane); return; }
    r -= I_DN;
    if (r < I_GU) { const int kb = r / 88, nb = r % 88, n0 = 32 * nb; tr_item(in[16] + (size_t)l * D * FF, FF, n0, 64 * kb, (bf16*)(wl + O_WGU2), D, 256 * (n0 >> 7) + (n0 & 127), scr, lane, in[15] + (size_t)l * D); return; }
    r -= I_GU;
    if (r < I_GU) { const int kb = r / 88, nb = r % 88, n0 = 32 * nb; tr_item(in[17] + (size_t)l * D * FF, FF, n0, 64 * kb, (bf16*)(wl + O_WGU2), D, 256 * (n0 >> 7) + 128 + (n0 & 127), scr, lane, in[15] + (size_t)l * D); return; }
    r -= I_GU;
    if (r < I_DN) { const int kb = r / 32, nb = r % 32; tr_item(in[18] + (size_t)l * FF * D, D, 32 * nb, 64 * kb, (bf16*)(wl + O_WD2), FF, 32 * nb, scr, lane); return; }
    r -= I_DN;
    if (r < I_WO) { const int kb = r / 32, nb = r % 32; tr_item(in[14] + (size_t)l * D * D, D, 32 * nb, 64 * kb, (bf16*)(wl + O_WO), D, 32 * nb, scr, lane); return; }
    r -= I_WO;
    if (r < I_WIN) {
        const int kb = r / 103, v = 32 * (r % 103); int c0, d0;
        if (v < 512) { c0 = S_QI + v; d0 = Z_QI + v; }
        else if (v < 1024) { c0 = S_PI + (v - 512); d0 = Z_PI + (v - 512); }
        else if (v < 2048) { c0 = S_GA + (v - 1024); d0 = R_GA + (v - 1024); }
        else if (v < 3072) { c0 = S_GB + (v - 2048); d0 = R_GB + (v - 2048); }
        else if (v < 3200) { c0 = S_CKV + (v - 3072); d0 = Z_CKV + (v - 3072); }
        else { c0 = S_KI + (v - 3200); d0 = Z_KI + (v - 3200); }
        tr_item(in[6] + (size_t)l * D * DIN, DIN, c0, 64 * kb, (bf16*)(wl + O_WIN), D, d0, scr, lane, in[5] + (size_t)l * D); return; }
    r -= I_WIN;
    {
        v4u z; z.x = 0u; z.y = 0u; z.z = 0u; z.w = 0u; GAS v4u* p = (GAS v4u*)((bf16*)(wl + O_WIN) + (size_t)(Z_KI + 96) * D);
        for (int i = lane; i < 32 * D / 8; i += 64) p[i] = z; }
}

__device__ __forceinline__ void rms_phase(const bf16* src, const float* g, bf16* dst, int gw, int NGW, int lane) {
    f32x4 gv[4];
#pragma unroll
    for (int j = 0; j < 4; ++j) gv[j] = ((const f32x4*)g)[64 * j + lane];
    for (int m0 = gw; m0 < M; m0 += 4 * NGW) {
        u32x2 w[4][4];
#pragma unroll
        for (int r = 0; r < 4; ++r) { const int m = m0 + r * NGW < M ? m0 + r * NGW : m0; const GAS u32x2* xr = (const GAS u32x2*)(src + (size_t)m * D) + lane;
#pragma unroll
            for (int j = 0; j < 4; ++j) w[r][j] = xr[64 * j]; }
#pragma unroll
        for (int r = 0; r < 4; ++r) { const int m = m0 + r * NGW; if (m < M) {
            f32x4 v[4]; float s = 0.f;
#pragma unroll
            for (int j = 0; j < 4; ++j) { v[j].x = bf_lo(w[r][j].x); v[j].y = bf_hi(w[r][j].x); v[j].z = bf_lo(w[r][j].y); v[j].w = bf_hi(w[r][j].y); s += (v[j].x * v[j].x + v[j].y * v[j].y) + (v[j].z * v[j].z + v[j].w * v[j].w); }
            const float rstd = 1.f / sqrtf(wave_sum(s, lane) * (1.f / D) + EPS);
            GAS u32x2* o8 = (GAS u32x2*)(dst + (size_t)m * D) + lane;
#pragma unroll
            for (int j = 0; j < 4; ++j) { u32x2 q; q.x = pk_bf16(v[j].x * rstd * gv[j].x, v[j].y * rstd * gv[j].y); q.y = pk_bf16(v[j].z * rstd * gv[j].z, v[j].w * rstd * gv[j].w); o8[64 * j] = q; } } }
    }
}
__device__ __forceinline__ void xr_init_phase(const float* src, bf16* xr_out, float* ssq, int gw, int NGW, int lane) {
    for (int m0 = gw; m0 < M; m0 += 2 * NGW) {
        f32x4 v[2][4]; float s[2];
#pragma unroll
        for (int r = 0; r < 2; ++r) { const int m = m0 + r * NGW < M ? m0 + r * NGW : m0; const GAS f32x4* xr = (const GAS f32x4*)(src + (size_t)m * D) + lane; s[r] = 0.f;
#pragma unroll
            for (int j = 0; j < 4; ++j) { v[r][j] = xr[64 * j]; s[r] += (v[r][j].x * v[r][j].x + v[r][j].y * v[r][j].y) + (v[r][j].z * v[r][j].z + v[r][j].w * v[r][j].w); } }
#pragma unroll
        for (int r = 0; r < 2; ++r) { const int m = m0 + r * NGW; if (m < M) {
            const float tot = wave_sum(s[r], lane);
            GAS u32x2* x8 = (GAS u32x2*)(xr_out + (size_t)m * D) + lane;
#pragma unroll
            for (int j = 0; j < 4; ++j) { u32x2 q; q.x = pk_bf16(v[r][j].x, v[r][j].y); q.y = pk_bf16(v[r][j].z, v[r][j].w); x8[64 * j] = q; }
            if (lane < 16) ssq[(size_t)m * 16 + lane] = lane == 0 ? tot : 0.f; } }
    }
}
template <class Sched> __device__ __forceinline__ void rstab_fill(LAS unsigned char* lds, const Sched& S, const float* ssq, int tid) {
    LAS unsigned char* pmap = lds + PMAP_OFF; LAS int* plist = (LAS int*)(lds + PLIST_OFF); LAS float* tab = (LAS float*)(lds + RSTAB_OFF);
    if (tid < 256) pmap[tid] = 0xff;
    __syncthreads();
    if (tid == 0) { int np = 0; pg8::Unit u;
        for (int i = 0; S.next(i, u); ++i) if (pmap[u.pm] == 0xff && np < RSTAB_SLOTS) { pmap[u.pm] = (unsigned char)np; plist[np] = u.pm; ++np; }
        plist[RSTAB_SLOTS] = np; }
    __syncthreads();
    const int np = plist[RSTAB_SLOTS + (tid >> 16)];
    for (int e = tid; e < np * 256; e += NWAVES * 64) { const int slot = e >> 8, row = e & 255; const size_t m = (size_t)plist[slot] * 256 + row;
        const GAS f32x4* p = (const GAS f32x4*)(ssq + m * 16); const f32x4 a = p[0], b = p[1], c = p[2], d = p[3];
        const float t = (((a.x + a.y) + (a.z + a.w)) + ((b.x + b.y) + (b.z + b.w))) + (((c.x + c.y) + (c.z + c.w)) + ((d.x + d.y) + (d.z + d.w)));
        tab[e] = 1.f / sqrtf(t * (1.f / D) + EPS); }
    __syncthreads();
}
__device__ __forceinline__ void final_norm_phase(const bf16* src, float* out, const float* g, int gw, int NGW, int lane, bool poison, const unsigned* diagp = nullptr) {
    f32x4 gv[4];
#pragma unroll
    for (int j = 0; j < 4; ++j) gv[j] = ((const f32x4*)g)[64 * j + lane];
    const float qnan = __builtin_nanf("");
    for (int m0 = gw; m0 < M; m0 += 4 * NGW) {
        u32x2 w[4][4];
#pragma unroll
        for (int r = 0; r < 4; ++r) { const int m = m0 + r * NGW < M ? m0 + r * NGW : m0; const GAS u32x2* xr = (const GAS u32x2*)(src + (size_t)m * D) + lane;
#pragma unroll
            for (int j = 0; j < 4; ++j) w[r][j] = xr[64 * j]; }
#pragma unroll
        for (int r = 0; r < 4; ++r) { const int m = m0 + r * NGW; if (m < M) {
            f32x4 v[4]; float s = 0.f;
#pragma unroll
            for (int j = 0; j < 4; ++j) { v[j].x = bf_lo(w[r][j].x); v[j].y = bf_hi(w[r][j].x); v[j].z = bf_lo(w[r][j].y); v[j].w = bf_hi(w[r][j].y); s += (v[j].x * v[j].x + v[j].y * v[j].y) + (v[j].z * v[j].z + v[j].w * v[j].w); }
            float rstd = 1.f / sqrtf(wave_sum(s, lane) * (1.f / D) + EPS);
            if (poison) rstd = qnan;
#if DIAG_SEL
            { const unsigned long long* dg = (const unsigned long long*)diagp; const float tot = (float)(dg[0] + dg[1] + dg[2] + dg[3]); rstd *= 1.0f + floorf((float)dg[DIAG_SEL - 1] / tot * 16.0f + 0.5f) * (1.0f / 16.0f); }
#endif
            GAS f32x4* o = (GAS f32x4*)(out + (size_t)m * D) + lane;
#pragma unroll
            for (int j = 0; j < 4; ++j) o[64 * j] = v[j] * rstd * gv[j]; } }
    }
}
__device__ __forceinline__ void prep_phase(const bf16* Z, const float* gkv, bf16* CK, bf16* PO, int gw, int NGW, int lane) {
    {
        const int sub = lane >> 4, ch = lane & 15;
        float gk[8];
#pragma unroll
        for (int e = 0; e < 8; ++e) gk[e] = gkv[8 * ch + e];
        for (int r0 = gw; r0 < M / 4; r0 += 4 * NGW) {
            u32x4 w[4];
#pragma unroll
            for (int q = 0; q < 4; ++q) { const int r4 = r0 + q * NGW < M / 4 ? r0 + q * NGW : r0; w[q] = *(const GAS u32x4*)(Z + ((size_t)r4 * 4 + sub) * ZA + Z_CKV + 8 * ch); }
#pragma unroll
            for (int q = 0; q < 4; ++q) {
                const int r4 = r0 + q * NGW; if (r4 < M / 4) {
                const size_t m = (size_t)r4 * 4 + sub;
                float x[8] = {bf_lo(w[q].x), bf_hi(w[q].x), bf_lo(w[q].y), bf_hi(w[q].y), bf_lo(w[q].z), bf_hi(w[q].z), bf_lo(w[q].w), bf_hi(w[q].w)};
                float s = 0.f;
#pragma unroll
                for (int e = 0; e < 8; ++e) s += x[e] * x[e];
                s += shx(s, 1, lane); s += shx(s, 2, lane); s += shx(s, 4, lane); s += shx(s, 8, lane);
                const float rstd = 1.f / sqrtf(s * (1.f / 128.f) + EPS);
                u32x4 o; o.x = pk_bf16(x[0] * rstd * gk[0], x[1] * rstd * gk[1]); o.y = pk_bf16(x[2] * rstd * gk[2], x[3] * rstd * gk[3]);
                o.z = pk_bf16(x[4] * rstd * gk[4], x[5] * rstd * gk[5]); o.w = pk_bf16(x[6] * rstd * gk[6], x[7] * rstd * gk[7]);
                *(GAS u32x4*)(CK + m * 128 + 8 * ch) = o; }
            }
        }
    }
    {
        const int wdw = 2 << (lane >> 4);
        for (int blk = gw; blk < M / 8; blk += NGW) {
            const int m0 = 8 * blk, t0 = m0 & (T - 1);
            u32x4 xr[23];
#pragma unroll
            for (int i = 0; i < 23; ++i) { int mr = m0 - 15 + i; mr = mr < 0 ? 0 : mr; xr[i] = *(const GAS u32x4*)(Z + (size_t)mr * ZA + Z_PI + 8 * lane); }
#pragma unroll
            for (int r = 0; r < 8; ++r) {
                const int t = t0 + r; const int cnt = (t + 1) < wdw ? (t + 1) : wdw;
                float a[8];
#pragma unroll
                for (int e = 0; e < 8; ++e) a[e] = 0.f;
#pragma unroll
                for (int jj = 0; jj < 16; ++jj) { const float mk = jj < cnt ? 1.f : 0.f; const u32x4 w = xr[15 + r - jj];
                    a[0] = fmaf(bf_lo(w.x), mk, a[0]); a[1] = fmaf(bf_hi(w.x), mk, a[1]); a[2] = fmaf(bf_lo(w.y), mk, a[2]); a[3] = fmaf(bf_hi(w.y), mk, a[3]);
                    a[4] = fmaf(bf_lo(w.z), mk, a[4]); a[5] = fmaf(bf_hi(w.z), mk, a[5]); a[6] = fmaf(bf_lo(w.w), mk, a[6]); a[7] = fmaf(bf_hi(w.w), mk, a[7]); }
                const u32x4 sw = xr[15 + r]; const float inv = 1.f / (float)cnt;
                u32x4 o; o.x = pk_bf16(a[0] * inv - bf_lo(sw.x), a[1] * inv - bf_hi(sw.x)); o.y = pk_bf16(a[2] * inv - bf_lo(sw.y), a[3] * inv - bf_hi(sw.y));
                o.z = pk_bf16(a[4] * inv - bf_lo(sw.z), a[5] * inv - bf_hi(sw.z)); o.w = pk_bf16(a[6] * inv - bf_lo(sw.w), a[7] * inv - bf_hi(sw.w));
                *(GAS u32x4*)(PO + (size_t)(m0 + r) * 512 + 8 * lane) = o;
            }
        }
    }
}

__device__ __forceinline__ bool mix_unit(int i, int vcu, int G, int& b, int& qb) {
    const int U = vcu + i * G; if (U >= BATCH * 64) return false;
    const int ii = U >> 8, r = U & 7; b = (U & 255) >> 3; qb = (ii & 1) ? 16 * (ii >> 1) + 15 - r : 16 * (ii >> 1) + r; return true;
}
__device__ __forceinline__ unsigned fkey(float s) { const unsigned u = __float_as_uint(s); return (u & 0x80000000u) ? ~u : (u | 0x80000000u); }
__device__ __forceinline__ float funkey(unsigned k) { return __uint_as_float((k & 0x80000000u) ? (k & 0x7fffffffu) : ~k); }
__device__ __forceinline__ unsigned half_sum(unsigned v, int hh) {
    v += (unsigned)__builtin_amdgcn_update_dpp(0, (int)v, 0xB1, 0xF, 0xF, false);
    v += (unsigned)__builtin_amdgcn_update_dpp(0, (int)v, 0x4E, 0xF, 0xF, false);
    v += (unsigned)__builtin_amdgcn_update_dpp(0, (int)v, 0x141, 0xF, 0xF, false);
    v += (unsigned)__builtin_amdgcn_update_dpp(0, (int)v, 0x140, 0xF, 0xF, false);
    const unsigned a = __builtin_amdgcn_readlane(v, 0) + __builtin_amdgcn_readlane(v, 16), b = __builtin_amdgcn_readlane(v, 32) + __builtin_amdgcn_readlane(v, 48);
    return hh ? b : a;
}
__device__ __forceinline__ float rl_f(float v, int l) { return __uint_as_float((unsigned)__builtin_amdgcn_readlane((int)__float_as_uint(v), l)); }
__device__ __forceinline__ float half_max(float v, int hh) {
    v = fmaxf(v, __builtin_amdgcn_update_dpp(v, v, 0xB1, 0xF, 0xF, false)); v = fmaxf(v, __builtin_amdgcn_update_dpp(v, v, 0x4E, 0xF, 0xF, false));
    v = fmaxf(v, __builtin_amdgcn_update_dpp(v, v, 0x141, 0xF, 0xF, false)); v = fmaxf(v, __builtin_amdgcn_update_dpp(v, v, 0x140, 0xF, 0xF, false));
    const float a = fmaxf(rl_f(v, 0), rl_f(v, 16)), b = fmaxf(rl_f(v, 32), rl_f(v, 48));
    return hh ? b : a;
}
__device__ __forceinline__ float half_min(float v, int hh) {
    v = fminf(v, __builtin_amdgcn_update_dpp(v, v, 0xB1, 0xF, 0xF, false)); v = fminf(v, __builtin_amdgcn_update_dpp(v, v, 0x4E, 0xF, 0xF, false));
    v = fminf(v, __builtin_amdgcn_update_dpp(v, v, 0x141, 0xF, 0xF, false)); v = fminf(v, __builtin_amdgcn_update_dpp(v, v, 0x140, 0xF, 0xF, false));
    const float a = fminf(rl_f(v, 0), rl_f(v, 16)), b = fminf(rl_f(v, 32), rl_f(v, 48));
    return hh ? b : a;
}
__device__ __forceinline__ float sel_cand(float lo, float hi, float glo, float ghi) {
    float c = lo + (hi - lo) * (glo / (glo - ghi));
    if (!(c > lo && c < hi)) c = funkey((fkey(lo) >> 1) + (fkey(hi) >> 1) + (fkey(lo) & fkey(hi) & 1u));
    return c;
}

#if DIAG_SEL
#define DIAG_T(sec) do { if (blockIdx.x == 0 && wid == 0) { const unsigned long long t_ = __builtin_amdgcn_s_memrealtime(); if (lane_in == 0) atomicAdd((unsigned long long*)diag + (sec), t_ - tprev_); tprev_ = t_; } } while (0)
#else
#define DIAG_T(sec) do { } while (0)
#endif
__device__ __forceinline__ void select_unit(const bf16* Z, unsigned* MASK, int b, int qb, int wid, int lane_in, unsigned* diag = nullptr) {
#if DIAG_SEL
    unsigned long long tprev_ = __builtin_amdgcn_s_memrealtime();
#endif
    int lane = lane_in; asm volatile("" : "+v"(lane));
    const int col = lane & 31, hh = lane >> 5;
    const size_t mb = (size_t)b * T + 32 * qb + 4 * wid;
    const int tql_r = 2 * (col >> 4) + ((col >> 2) & 1), j_r = 4 * ((col >> 3) & 1) + (col & 3);
    bf16x8 qa[4];
#pragma unroll
    for (int s = 0; s < 4; ++s) qa[s] = *(const GAS bf16x8*)(Z + (mb + tql_r) * ZA + Z_QI + j_r * 64 + 16 * s + 8 * hh);
    float wA[8], wB[8];
    { const u32x4 a = *(const GAS u32x4*)(Z + (mb + hh) * ZA + Z_WI), c = *(const GAS u32x4*)(Z + (mb + 2 + hh) * ZA + Z_WI);
      wA[0] = bf_lo(a.x) * IDX_SCALE; wA[1] = bf_hi(a.x) * IDX_SCALE; wA[2] = bf_lo(a.y) * IDX_SCALE; wA[3] = bf_hi(a.y) * IDX_SCALE;
      wA[4] = bf_lo(a.z) * IDX_SCALE; wA[5] = bf_hi(a.z) * IDX_SCALE; wA[6] = bf_lo(a.w) * IDX_SCALE; wA[7] = bf_hi(a.w) * IDX_SCALE;
      wB[0] = bf_lo(c.x) * IDX_SCALE; wB[1] = bf_hi(c.x) * IDX_SCALE; wB[2] = bf_lo(c.y) * IDX_SCALE; wB[3] = bf_hi(c.y) * IDX_SCALE;
      wB[4] = bf_lo(c.z) * IDX_SCALE; wB[5] = bf_hi(c.z) * IDX_SCALE; wB[6] = bf_lo(c.w) * IDX_SCALE; wB[7] = bf_hi(c.w) * IDX_SCALE; }
    const int dA = 32 * qb + 4 * wid + hh - col, dB = dA + 2;
    float sA[64], sB[64];
    const bf16* kp = Z + ((size_t)b * T + col) * ZA + Z_KI + 8 * hh;
    bf16x8 kb0[4], kb1[4], kb2[4];
#pragma unroll
    for (int s = 0; s < 4; ++s) { kb0[s] = *(const GAS bf16x8*)(kp + 16 * s); kb1[s] = *(const GAS bf16x8*)(kp + (size_t)32 * ZA + 16 * s); }
    kp += (size_t)32 * ZA;
#if DIAG_SEL
    asm volatile("s_waitcnt vmcnt(0)" ::: "memory");
#endif
    DIAG_T(0);
#pragma unroll
    for (int kt = 0; kt < 64; ++kt) { sA[kt] = -INFINITY; sB[kt] = -INFINITY; }
#pragma unroll
    for (int c8 = 0; c8 < 8; ++c8) {
        if (8 * c8 <= qb) {
#pragma unroll
            for (int k = 0; k < 8; ++k) {
                const int kt = 8 * c8 + k;
                kp += (size_t)32 * ZA; asm volatile("" : "+v"(kp));
#pragma unroll
                for (int s = 0; s < 4; ++s) { const bf16x8 ld = *(const GAS bf16x8*)(kp + 16 * s); if ((kt + 2) % 3 == 0) kb0[s] = ld; else if ((kt + 2) % 3 == 1) kb1[s] = ld; else kb2[s] = ld; }
                f32x16 acc;
#pragma unroll
                for (int i = 0; i < 16; ++i) acc[i] = 0.f;
#pragma unroll
                for (int s = 0; s < 4; ++s) acc = __builtin_amdgcn_mfma_f32_32x32x16_bf16(qa[s], kt % 3 == 0 ? kb0[s] : (kt % 3 == 1 ? kb1[s] : kb2[s]), acc, 0, 0, 0);
                float sa = 0.f, sb = 0.f;
#pragma unroll
                for (int j = 0; j < 8; ++j) {
                    const int ra = __float_as_int(acc[j]), rb = __float_as_int(acc[8 + j]);
                    sa = fmaf(__int_as_float(ra > 0 ? ra : 0), wA[j], sa); sb = fmaf(__int_as_float(rb > 0 ? rb : 0), wB[j], sb); }
                sA[kt] = (32 * kt <= dA) ? sa : -INFINITY; sB[kt] = (32 * kt <= dB) ? sb : -INFINITY;
                __builtin_amdgcn_sched_barrier(0);
            }
        }
    }
    DIAG_T(1);
    float thrA = -3.0e38f, thrB = -3.0e38f;
    if (qb >= 8) {
        float mnA = sA[0], mnB = sB[0], mxA = sA[0], mxB = sB[0];
#pragma unroll
        for (int k = 1; k < 8; ++k) { mnA = fminf(mnA, sA[k]); mnB = fminf(mnB, sB[k]); }
#pragma unroll
        for (int c8 = 0; c8 < 8; ++c8) {
            if (8 * c8 <= qb) {
#pragma unroll
                for (int k = 0; k < 8; ++k) { mxA = fmaxf(mxA, sA[8 * c8 + k]); mxB = fmaxf(mxB, sB[8 * c8 + k]); }
            }
        }
        float loA = half_min(mnA, hh), loB = half_min(mnB, hh);
        float hiA = funkey(fkey(half_max(mxA, hh)) + 1u), hiB = funkey(fkey(half_max(mxB, hh)) + 1u);
        const float nv = (float)(32 * qb + 16);
        float gloA = nv - 256.5f, ghiA = -256.5f, gloB = gloA, ghiB = ghiA;
        int sdA = 0, sdB = 0;
        unsigned nloA = 0x40000000u, nhiA = 0u, nloB = 0x40000000u, nhiB = 0u;
        int stA = 0, stB = 0;
        bool dnA = false, dnB = false;
#pragma unroll 1
        for (int it = 0; it < 96; ++it) {
            const float cA = sel_cand(loA, hiA, gloA, ghiA), cB = sel_cand(loB, hiB, gloB, ghiB);
            unsigned nA = 0u, nB = 0u;
#pragma unroll
            for (int c8 = 0; c8 < 8; ++c8) {
                if (8 * c8 <= qb) {
                    unsigned ba = 0u, bb = 0u;
#pragma unroll
                    for (int k = 0; k < 8; ++k) { ba = __builtin_amdgcn_alignbit(ba, __float_as_uint(sA[8 * c8 + k] - cA), 31); bb = __builtin_amdgcn_alignbit(bb, __float_as_uint(sB[8 * c8 + k] - cB), 31); }
                    nA += 8u - (unsigned)__builtin_popcount(ba); nB += 8u - (unsigned)__builtin_popcount(bb);
                }
            }
            nA = half_sum(nA, hh); nB = half_sum(nB, hh);
            if (!dnA) {
                const float g = (float)nA - 256.5f; const unsigned w0_ = nloA - nhiA;
                if (nA == 256u) { loA = cA; dnA = true; }
                else if (nA > 256u) { loA = cA; nloA = nA; gloA = g; if (sdA > 0) ghiA *= 0.5f; sdA = 1; }
                else { hiA = cA; nhiA = nA; ghiA = g; if (sdA < 0) gloA *= 0.5f; sdA = -1; }
                stA = (nloA - nhiA == w0_) ? stA + 1 : 0;
                if (!dnA && fkey(hiA) - fkey(loA) <= 1u) dnA = true;
            }
            if (!dnB) {
                const float g = (float)nB - 256.5f; const unsigned w0_ = nloB - nhiB;
                if (nB == 256u) { loB = cB; dnB = true; }
                else if (nB > 256u) { loB = cB; nloB = nB; gloB = g; if (sdB > 0) ghiB *= 0.5f; sdB = 1; }
                else { hiB = cB; nhiB = nB; ghiB = g; if (sdB < 0) gloB *= 0.5f; sdB = -1; }
                stB = (nloB - nhiB == w0_) ? stB + 1 : 0;
                if (!dnB && fkey(hiB) - fkey(loB) <= 1u) dnB = true;
            }
            if (__all(dnA && dnB)) break;
            if (__any((!dnA && stA >= 2) || (!dnB && stB >= 2))) {
                float mnA_ = INFINITY, mxA_ = -INFINITY, mnB_ = INFINITY, mxB_ = -INFINITY;
#pragma unroll
                for (int c8 = 0; c8 < 8; ++c8) {
                    if (8 * c8 <= qb) {
#pragma unroll
                        for (int k = 0; k < 8; ++k) {
                            const float a = sA[8 * c8 + k], b2 = sB[8 * c8 + k];
                            const bool ia = (a >= loA) && (a < hiA), ib = (b2 >= loB) && (b2 < hiB);
                            mnA_ = ia ? fminf(mnA_, a) : mnA_; mxA_ = ia ? fmaxf(mxA_, a) : mxA_;
                            mnB_ = ib ? fminf(mnB_, b2) : mnB_; mxB_ = ib ? fmaxf(mxB_, b2) : mxB_;
                        }
                    }
                }
                mnA_ = half_min(mnA_, hh); mxA_ = half_max(mxA_, hh); mnB_ = half_min(mnB_, hh); mxB_ = half_max(mxB_, hh);
                if (!dnA && stA >= 2) { if (mnA_ == mxA_) { loA = mnA_; dnA = true; } else { loA = mnA_; hiA = funkey(fkey(mxA_) + 1u); stA = 0; } }
                if (!dnB && stB >= 2) { if (mnB_ == mxB_) { loB = mnB_; dnB = true; } else { loB = mnB_; hiB = funkey(fkey(mxB_) + 1u); stB = 0; } }
                if (__all(dnA && dnB)) break;
            }
        }
        thrA = loA; thrB = loB;
    }
    DIAG_T(2);
    unsigned w0 = 0u, w1 = 0u, w2 = 0u, w3 = 0u;
    int lane2 = lane; asm volatile("" : "+v"(lane2));
#pragma unroll
    for (int c8 = 0; c8 < 8; ++c8) {
        if (8 * c8 <= qb) {
#pragma unroll
            for (int k = 0; k < 8; ++k) { const int kt = 8 * c8 + k;
                const unsigned long long bA = __ballot(sA[kt] >= thrA), bB = __ballot(sB[kt] >= thrB);
                const bool mine = (lane2 == kt);
                w0 = mine ? (unsigned)bA : w0; w1 = mine ? (unsigned)(bA >> 32) : w1; w2 = mine ? (unsigned)bB : w2; w3 = mine ? (unsigned)(bB >> 32) : w3; }
        }
    }
    GAS unsigned* mo = (GAS unsigned*)MASK + mb * 64 + lane;
    mo[0] = w0; mo[64] = w1; mo[128] = w2; mo[192] = w3;
#if DIAG_SEL
    asm volatile("s_waitcnt vmcnt(0)" ::: "memory");
#endif
    DIAG_T(3);
}

__device__ __forceinline__ unsigned off_b(unsigned row, unsigned ch) { return 256u * row + 16u * (ch ^ (((row & 3u) << 2) | ((row >> 2) & 3u))); }
__device__ __forceinline__ s16x4 vtr(const LAS unsigned char* p) { typedef short v4i16_t __attribute__((ext_vector_type(4))); return __builtin_bit_cast(s16x4, __builtin_amdgcn_ds_read_tr16_b64_v4i16((LAS v4i16_t*)p)); }
__device__ __forceinline__ void attn_unit(LAS unsigned char* kbuf, const bf16* Z, const bf16* CK, const unsigned* MASK, bf16* OL, const float* gkv, int b, int qb, int wid, int lane_in) {
    int lane = lane_in; asm volatile("" : "+v"(lane));
    const int r32 = lane & 31, hh = lane >> 5, tql = r32 >> 3, head = r32 & 7;
    const size_t m = (size_t)b * T + 32 * qb + 4 * wid + tql;
    const int lr = lane >> 4;
    const bf16* gsrc0 = CK + ((size_t)b * T + 32 * wid + lr) * 128;
    LAS unsigned char* ldst0 = kbuf + (32 * wid) * 256;
#define ATT_DMA_STAGE(st_) do { _Pragma("unroll") for (int i_ = 0; i_ < 8; ++i_) { const int ch_ = (lane & 15) ^ ((lr << 2) | (i_ & 3)); \
        __builtin_amdgcn_global_load_lds((const unsigned*)(gsrc0 + (size_t)(st_) * 256 * 128 + i_ * 4 * 128 + 8 * ch_), (LAS unsigned*)(ldst0 + ((st_) & 1) * 65536 + i_ * 1024), 16, 0, 0); } } while (0)
    asm volatile("s_waitcnt lgkmcnt(0)" ::: "memory"); __builtin_amdgcn_s_barrier(); asm volatile("" ::: "memory");
    ATT_DMA_STAGE(0);
    bf16x8 qf[8];
#pragma unroll
    for (int s = 0; s < 8; ++s) qf[s] = *(const GAS bf16x8*)(Z + m * ZA + Z_QL + head * 128 + 16 * s + 8 * hh);
    const GAS unsigned* mrow = (const GAS unsigned*)MASK + m * 64;
    float mref;
    { float gm = fmaxf(fabsf(gkv[lane]), fabsf(gkv[lane + 64]));
#pragma unroll
      for (int o = 1; o < 64; o <<= 1) gm = fmaxf(gm, shx(gm, o, lane));
      float qn = 0.f;
#pragma unroll
      for (int s = 0; s < 8; ++s)
#pragma unroll
          for (int e = 0; e < 8; ++e) { const float x = __uint_as_float(((unsigned)(unsigned short)qf[s][e]) << 16); qn += x * x; }
      qn += shx(qn, 32, lane);
      mref = fminf(sqrtf(qn) * gm * (1.02f * 11.313708499f), 60.f); }
    f32x16 zero16;
#pragma unroll
    for (int i = 0; i < 16; ++i) zero16[i] = 0.f;
    f32x16 o[4];
#pragma unroll
    for (int dt = 0; dt < 4; ++dt)
#pragma unroll
        for (int i = 0; i < 16; ++i) o[dt][i] = 0.f;
    float lrun = 0.f;
    const int ns = (qb + 8) >> 3;
    const unsigned q4 = (lane & 15) >> 2, p4 = lane & 3, blk = (lane >> 4) & 1;
    const unsigned fh = (unsigned)r32 & 3u, fl = ((unsigned)r32 >> 2) & 3u;
    const unsigned kl0 = 256u * (unsigned)r32 + 16u * (((unsigned)hh ^ fl) & 3u), kl1 = 256u * (unsigned)r32 + 16u * (((2u + (unsigned)hh) ^ fl) & 3u);
#define ATT_KA(s_) ((((s_) & 1) ? kl1 : kl0) + 64u * ((unsigned)((s_) >> 1) ^ fh))
    const unsigned vb = 256u * (4u * hh + q4) + 8u * (p4 & 1u), cl = 2u * blk + (p4 >> 1);
    const unsigned vlo0 = vb + 16u * ((cl ^ (unsigned)hh) & 3u), vlo1 = vb + 2048u + 16u * ((cl ^ (2u + (unsigned)hh)) & 3u);
    u32x4 mw0 = *(const GAS u32x4*)(mrow), mw1 = *(const GAS u32x4*)(mrow + 4);
    for (int st = 0; st < ns; ++st) {
        asm volatile("s_waitcnt vmcnt(0) lgkmcnt(0)" ::: "memory"); __builtin_amdgcn_s_barrier(); asm volatile("" ::: "memory");
        if (st + 1 < ns) ATT_DMA_STAGE(st + 1);
        const LAS unsigned char* sb = kbuf + (st & 1) * 65536;
#define ATT_QK(S_, k_) do { bf16x8 kf_[2]; \
        _Pragma("unroll") for (int s_ = 0; s_ < 8; s_ += 2) { kf_[0] = *(const LAS bf16x8*)(sb + (k_) * 8192 + ATT_KA(s_)); kf_[1] = *(const LAS bf16x8*)(sb + (k_) * 8192 + ATT_KA(s_ + 1)); \
            S_ = __builtin_amdgcn_mfma_f32_32x32x16_bf16(kf_[0], qf[s_], s_ == 0 ? zero16 : S_, 0, 0, 0); S_ = __builtin_amdgcn_mfma_f32_32x32x16_bf16(kf_[1], qf[s_ + 1], S_, 0, 0, 0); } } while (0)
        f32x16 S;
        ATT_QK(S, 0);
#pragma unroll
        for (int k = 0; k < 8; ++k) {
            const LAS unsigned char* kb = sb + k * 8192;
            const unsigned wsh = (k < 4 ? mw0[k & 3] : mw1[k & 3]) >> (4 * hh);
            float ps = 0.f;
#pragma unroll
            for (int i = 0; i < 16; ++i) { const int pos = (i & 3) + 8 * (i >> 2);
                unsigned sel; asm("v_bfe_i32 %0, %1, %2, 1" : "=v"(sel) : "v"(wsh), "n"(pos));
                S[i] = __uint_as_float(__float_as_uint(__builtin_amdgcn_exp2f(S[i] - mref)) & sel); ps += S[i]; }
            lrun += ps;
            bf16x8 pf[2];
#pragma unroll
            for (int s = 0; s < 2; ++s) { u32x4 pw; pw.x = pk_bf16(S[8 * s + 0], S[8 * s + 1]); pw.y = pk_bf16(S[8 * s + 2], S[8 * s + 3]); pw.z = pk_bf16(S[8 * s + 4], S[8 * s + 5]); pw.w = pk_bf16(S[8 * s + 6], S[8 * s + 7]); pf[s] = __builtin_bit_cast(bf16x8, pw); }
            __builtin_amdgcn_sched_barrier(0);
            if (k < 7) ATT_QK(S, k + 1);
#pragma unroll
            for (int dt = 0; dt < 4; ++dt)
#pragma unroll
                for (int s = 0; s < 2; ++s) {
                    const s16x4 lo = vtr(kb + 4096 * s + vlo0 + 64u * ((unsigned)dt ^ q4));
                    const s16x4 hi = vtr(kb + 4096 * s + vlo1 + 64u * ((unsigned)dt ^ q4));
                    const bf16x8 vt = __builtin_shufflevector(lo, hi, 0, 1, 2, 3, 4, 5, 6, 7);
                    o[dt] = __builtin_amdgcn_mfma_f32_32x32x16_bf16(vt, pf[s], o[dt], 0, 0, 0);
                }
            if (k == 3) mw0 = *(const GAS u32x4*)(mrow + 8 * (st + 1));
            if (k == 7) mw1 = *(const GAS u32x4*)(mrow + 8 * (st + 1) + 4);
            __builtin_amdgcn_sched_barrier(0);
        }
#undef ATT_QK
#undef ATT_KA
    }
#undef ATT_DMA_STAGE
    lrun += shx(lrun, 32, lane);
    const float inv = 1.f / lrun;
    bf16* orow = OL + m * 1024 + head * 128;
#pragma unroll
    for (int dt = 0; dt < 4; ++dt)
#pragma unroll
        for (int gp = 0; gp < 2; ++gp) {
            const int g0 = 2 * gp, g1 = 2 * gp + 1;
            const unsigned a0 = pk_bf16(o[dt][4 * g0] * inv, o[dt][4 * g0 + 1] * inv), a1 = pk_bf16(o[dt][4 * g0 + 2] * inv, o[dt][4 * g0 + 3] * inv);
            const unsigned b0 = pk_bf16(o[dt][4 * g1] * inv, o[dt][4 * g1 + 1] * inv), b1 = pk_bf16(o[dt][4 * g1 + 2] * inv, o[dt][4 * g1 + 3] * inv);
            const auto s0 = __builtin_amdgcn_permlane32_swap(a0, b0, false, false), s1 = __builtin_amdgcn_permlane32_swap(a1, b1, false, false);
            u32x4 w; w.x = s0[0]; w.y = s1[0]; w.z = s0[1]; w.w = s1[1];
            *(GAS u32x4*)(orow + 32 * dt + 8 * (hh ? g1 : g0)) = w;
        }
}

__device__ __forceinline__ cargs_t kargs() { cargs_t p = (cargs_t)__builtin_amdgcn_kernarg_segment_ptr(); asm volatile("" : "+s"(p)); return p; }
__device__ __forceinline__ int lane_id() { unsigned z = 0u; asm volatile("" : "+v"(z)); int v = (int)__builtin_amdgcn_mbcnt_hi(~0u, __builtin_amdgcn_mbcnt_lo(~0u, z)); asm volatile("" : "+v"(v)); return v; }
__global__ void __launch_bounds__(NWAVES * 64, 2) fwd(Args args_unused) {
    extern __shared__ __attribute__((aligned(16))) unsigned char lds[];
    Frame F;
    F.lds = (LAS unsigned char*)lds;
    F.MISC = (volatile LAS unsigned*)(F.lds + MISC_OFF);
    F.wave = __builtin_amdgcn_readfirstlane((int)threadIdx.x >> 6);
    F.G = gridDim.x; { const int bx = blockIdx.x; F.vcu = (F.G % 8 == 0) ? (bx % 8) * (F.G / 8) + bx / 8 : bx; }
    F.ctl = (gu32*)(kargs()->ws + WS_CTL);
    for (int u = threadIdx.x; u < (LDS_BYTES - LDSCTL_OFF) / 4; u += NWAVES * 64) ((LAS unsigned*)(F.lds + LDSCTL_OFF))[u] = 0u;
    __syncthreads();
    XcdBarrier bar = xcd_barrier_post((unsigned*)(F.ctl + CW_BAR), F.MISC + 8, (unsigned)F.wave);
#define GRID_BAR() xcd_barrier(bar)
    const int gw = F.vcu * NWAVES + F.wave, NGW = F.G * NWAVES;
#define WSP(off) (kargs()->ws + (off))

    {
        LAS float* scr = (LAS float*)(F.lds + RING_OFF + F.wave * 16384);
        const cargs_t a = kargs(); const int lane = lane_id();
        for (int rep_ = 0; rep_ < (PROBE_DUP == 1 ? 2 : 1); ++rep_) {
        for (int it = sopq(gw); it < NL * I_LAYER; it += NGW) prologue_item(a, it, scr, lane);
        xr_init_phase(a->in[0], (bf16*)(a->ws + WS_XR), (float*)(a->ws + WS_SSQ), sopq(gw), NGW, lane);
        GRID_BAR(); }
    }
#define GEMM_PHASE(EPI_T, A_, B_, N_, K_, E_) do { const pg8::Gemm g_{(const pg8::bf16_t*)(A_), (const pg8::bf16_t*)(B_), M, (N_), (K_)}; pg8::StaticOrder S_; S_.init(M, (N_), F.G, (int)blockIdx.x); \
        pg8::gemm_phase<EPI_T, pg8::StaticOrder, true, true>(F.lds + RING_OFF, g_, S_, (E_), F.wave); } while (0)

#if PROBE_DUP == 9
    for (int xb_ = 0; xb_ < 16; ++xb_) GRID_BAR();
#endif
#define GEMM_PHASE_RS(EPI_T, A_, B_, N_, K_, SSQ_, ...) do { const pg8::Gemm g_{(const pg8::bf16_t*)(A_), (const pg8::bf16_t*)(B_), M, (N_), (K_)}; pg8::StaticOrder S_; S_.init(M, (N_), F.G, (int)blockIdx.x); \
        rstab_fill(F.lds, S_, (SSQ_), F.wave * 64 + lane_id()); \
        const EPI_T E_{__VA_ARGS__, (const LAS float*)(F.lds + RSTAB_OFF), (const LAS unsigned char*)(F.lds + PMAP_OFF)}; \
        pg8::gemm_phase<EPI_T, pg8::StaticOrder, true, true>(F.lds + RING_OFF, g_, S_, E_, F.wave); } while (0)
    for (int fi = 0; fi < 2 * NL; ++fi) {
        const int l = fi >> 1; const bool second = (fi & 1) != 0;
        const size_t wlo = WS_W + (size_t)l * LW;
        for (int rep_ = 0; rep_ < (PROBE_DUP == 5 ? 2 : 1); ++rep_) { const cargs_t a = kargs(); GEMM_PHASE_RS(pg8::EpiSwiglu, a->ws + WS_XR, a->ws + wlo + (second ? O_WGU2 : O_WGU1), 2 * FF, D, (const float*)(a->ws + WS_SSQ), (pg8::bf16_t*)(a->ws + WS_ZA), FF); GRID_BAR(); }
        { const cargs_t a = kargs(); const pg8::EpiResid<1> E{(pg8::bf16_t*)(a->ws + WS_XR), D, (float*)(a->ws + WS_SSQ)}; GEMM_PHASE(pg8::EpiResid<1>, a->ws + WS_ZA, a->ws + wlo + (second ? O_WD2 : O_WD1), D, FF, E); GRID_BAR(); }
        if (!second) {
            for (int rep_ = 0; rep_ < (PROBE_DUP == 6 ? 2 : 1); ++rep_) { const cargs_t a = kargs(); GEMM_PHASE_RS(pg8::EpiPlainBf16, a->ws + WS_XR, a->ws + wlo + O_WIN, ZN, D, (const float*)(a->ws + WS_SSQ), (pg8::bf16_t*)(a->ws + WS_ZA), ZA, (pg8::bf16_t*)(a->ws + WS_ZG), ZGN, ZA / 256); GRID_BAR(); }
            { const cargs_t a = kargs(); const int lane = lane_id();
              for (int rep_ = 0; rep_ < (PROBE_DUP == 2 ? 2 : 1); ++rep_)
              prep_phase((const bf16*)(a->ws + WS_ZA), a->in[7] + (size_t)l * 128, (bf16*)(a->ws + WS_CK), (bf16*)(a->ws + WS_PO), sopq(gw), NGW, lane);
              for (int rep_ = 0; rep_ < (PROBE_DUP == 4 ? 2 : 1); ++rep_) {
              int b, qb; for (int i = 0; mix_unit(i, F.vcu, F.G, b, qb); ++i) select_unit((const bf16*)(a->ws + WS_ZA), (unsigned*)(a->ws + WS_MASK), b, qb, F.wave, lane, (unsigned*)(F.ctl + 2048)); }
              GRID_BAR(); }
            for (int rep_ = 0; rep_ < (PROBE_DUP == 3 ? 2 : 1); ++rep_) { const cargs_t a = kargs(); const int tid = F.wave * 64 + lane_id();
              int b, qb; for (int i = 0; mix_unit(i, F.vcu, F.G, b, qb); ++i) attn_unit(F.lds + RING_OFF, (const bf16*)(a->ws + WS_ZA), (const bf16*)(a->ws + WS_CK), (const unsigned*)(a->ws + WS_MASK), (bf16*)(a->ws + WS_OL), a->in[7] + (size_t)l * 128, b, qb, F.wave, tid & 63);
              asm volatile("s_waitcnt vmcnt(0) lgkmcnt(0)" ::: "memory"); __syncthreads();
              GRID_BAR(); }
            { const cargs_t a = kargs(); const pg8::EpiGate<false> E{(pg8::bf16_t*)(a->ws + WS_ZA), D, (const pg8::bf16_t*)(a->ws + WS_ZG), ZGN}; GEMM_PHASE(pg8::EpiGate<false>, a->ws + WS_OL, a->ws + wlo + O_WA, D, D, E); GRID_BAR(); }
            { const cargs_t a = kargs(); const pg8::EpiGate<true> E{(pg8::bf16_t*)(a->ws + WS_ZA), D, (const pg8::bf16_t*)(a->ws + WS_ZG) + 1024, ZGN}; GEMM_PHASE(pg8::EpiGate<true>, a->ws + WS_PO, a->ws + wlo + O_WP, D, 512, E); GRID_BAR(); }
            { const cargs_t a = kargs(); const pg8::EpiResid<0> E{(pg8::bf16_t*)(a->ws + WS_XR), D, (float*)(a->ws + WS_SSQ)}; GEMM_PHASE(pg8::EpiResid<0>, a->ws + WS_ZA, a->ws + wlo + O_WO, D, D, E); GRID_BAR(); }
        }
    }
    {
        const cargs_t a = kargs();
        const bool poison = __hip_atomic_load((gu32*)(F.ctl + CW_BAR + XB_TMO), RLX_AGENT) != 0u;
        final_norm_phase((const bf16*)(a->ws + WS_XR), a->out, a->in[19], sopq(gw), NGW, lane_id(), poison, (const unsigned*)(F.ctl + 2048));
    }
}

extern "C" void kernel_launch(void* const* d_in, const int* in_sizes, int n_in, void* d_out, int out_size, void* d_ws, size_t ws_size, hipStream_t stream) {
    static int grid = 0;
    if (grid == 0) {
        if (n_in != 20 || in_sizes[0] != M * D || out_size != M * D || ws_size < WS_END) { fprintf(stderr, "kernel_launch: unexpected shapes (n_in %d, in0 %d, out %d, ws %zu); nothing launched\n", n_in, n_in > 0 ? in_sizes[0] : -1, out_size, ws_size); grid = -1; return; }
        int dev = 0, cus = 0, per_cu = 0;
        if (hipGetDevice(&dev) != hipSuccess || hipDeviceGetAttribute(&cus, hipDeviceAttributeMultiprocessorCount, dev) != hipSuccess) { fprintf(stderr, "kernel_launch: device query failed\n"); grid = -1; return; }
        if (hipFuncSetAttribute((const void*)fwd, hipFuncAttributeMaxDynamicSharedMemorySize, LDS_BYTES) != hipSuccess) { fprintf(stderr, "kernel_launch: hipFuncSetAttribute failed\n"); grid = -1; return; }
        if (hipOccupancyMaxActiveBlocksPerMultiprocessor(&per_cu, (const void*)fwd, NWAVES * 64, LDS_BYTES) != hipSuccess || per_cu < 1)
            fprintf(stderr, "kernel_launch: note: occupancy query reports %d workgroups per CU\n", per_cu);
        (void)hipGetLastError();
        grid = cus;
    }
    if (grid < 0) return;
    if (hipMemsetAsync((char*)d_ws + WS_CTL, 0, CTL_ZERO_BYTES, stream) != hipSuccess) { fprintf(stderr, "kernel_launch: hipMemsetAsync failed\n"); return; }
    Args a{};
    for (int i = 0; i < 20; ++i) a.in[i] = (const float*)d_in[i];
    a.out = (float*)d_out; a.ws = (unsigned char*)d_ws;
    hipLaunchKernelGGL(fwd, dim3(grid), dim3(NWAVES * 64), LDS_BYTES, stream, a);
    const hipError_t le = hipPeekAtLastError();
    if (le != hipSuccess) fprintf(stderr, "kernel_launch: launch failed: %s\n", hipGetErrorName(le));
}
```

```cpp
#ifndef PROBE_DUP
#define PROBE_DUP 0
#endif
#ifndef DIAG_SEL
#define DIAG_SEL 0
#endif
#include <hip/hip_runtime.h>
#include <cstdio>
#include <cstdint>
#include <cmath>
namespace pg8 {
#define PG8_LAS __attribute__((address_space(3)))
typedef unsigned short bf16_t;
typedef short bf16x8 __attribute__((ext_vector_type(8)));
typedef float f32x4 __attribute__((ext_vector_type(4)));
typedef unsigned u32x4 __attribute__((ext_vector_type(4)));
constexpr int BM = 256, BK = 64, HALF = 128, HTB = HALF * BK * 2  , STAGE_BYTES = 8 * HTB, NXCD = 8, WGM = 8;

__host__ __device__ __forceinline__ int lds_byte(int r, int c) { const int st = (r >> 4) * 2 + (c >> 5), rr = r & 15, cc = c & 31, ob = rr * 64 + cc * 2; return st * 1024 + (ob ^ (((ob >> 9) & 1) << 5)); }
__host__ __device__ __forceinline__ void stage_rc(int b, int& R, int& C) { const int st = b / 1024, sb = b % 1024, swz = sb ^ (((sb >> 9) & 1) << 5); R = (st >> 1) * 16 + swz / 64; C = (st & 1) * 32 + (swz % 64) / 2; }
__host__ __device__ __forceinline__ int perm32(int rho) { const int n = rho >> 4, i = rho & 15; return 8 * (i >> 2) + 4 * n + (i & 3); }

struct Unit { int pm, pn; };
struct Gemm { const bf16_t* A; const bf16_t* Bt; int M, N, K; };

struct StaticOrder {
    int nM, nN, nwg, G, c;
    __host__ __device__ void init(int M, int N, int G_, int c_) { nM = M / BM; nN = N / BM; nwg = nM * nN; G = G_; c = c_; }
    __host__ __device__ bool next(int i, Unit& u) const {
        const long L = (long)i * G + c; if (L >= nwg) return false;
        int wgid = (int)L; { const int q = nwg / NXCD, r = nwg % NXCD, xcd = wgid % NXCD, off = wgid / NXCD; wgid = (xcd < r ? xcd * (q + 1) : r * (q + 1) + (xcd - r) * q) + off; }
        const int nig = WGM * nN, gid = wgid / nig, fm = gid * WGM, gsz = (nM - fm) < WGM ? (nM - fm) : WGM;
        u.pm = fm + ((wgid % nig) % gsz); u.pn = (wgid % nig) / gsz; return true;
    }
    __device__ __forceinline__ void a_ready(const Unit&) const {}
    __device__ __forceinline__ void done(const Unit&) const {}
};

__device__ __forceinline__ unsigned cvt_pk_bf16(float lo, float hi) { unsigned r; asm volatile("v_cvt_pk_bf16_f32 %0, %1, %2" : "=v"(r) : "v"(lo), "v"(hi)); return r; }
typedef float f32x2 __attribute__((ext_vector_type(2)));
typedef __bf16 bf16x2_t __attribute__((ext_vector_type(2)));
__device__ __forceinline__ unsigned pk_bf16(float lo, float hi) { f32x2 v = {lo, hi}; bf16x2_t b = __builtin_convertvector(v, bf16x2_t); return __builtin_bit_cast(unsigned, b); }
__device__ __forceinline__ float sigm(float g) { return __builtin_amdgcn_rcpf(1.0f + __builtin_amdgcn_exp2f(-1.4426950408889634f * g)); }
__device__ __forceinline__ float bf_lo(unsigned w) { return __uint_as_float(w << 16); }
__device__ __forceinline__ float bf_hi(unsigned w) { return __uint_as_float(w & 0xffff0000u); }

__device__ __forceinline__ float xlane(float v, int m, int lane) { return __int_as_float(__builtin_amdgcn_ds_bpermute((lane ^ m) << 2, __float_as_int(v))); }
struct EpiPlainBf16 {
    static constexpr bool PERM = true, AFTER_DRAIN = false;
    bf16_t* O1; int ld1; bf16_t* O2; int ld2; int nsplit; const PG8_LAS float* rstab; const PG8_LAS unsigned char* pmap;
    __device__ __forceinline__ void operator()(const f32x4 (&acc)[2][2][4][2], const Unit& u, int wr, int wc, int fr, int fq) const {
        const PG8_LAS float* rs = rstab + 256 * (int)pmap[u.pm] + wr * 64 + fr;
        const bool first = u.pn < nsplit; bf16_t* O = first ? O1 : O2; const int ldc = first ? ld1 : ld2;
        const int row0 = u.pm * BM + wr * 64 + fr, col0 = (first ? u.pn : u.pn - nsplit) * BM + wc * 32 + 8 * fq;
#pragma unroll
        for (int ai = 0; ai < 2; ++ai)
#pragma unroll
            for (int m = 0; m < 4; ++m) { bf16_t* rowp = O + (size_t)(row0 + ai * HALF + m * 16) * ldc + col0;
                const float rr = rs[ai * HALF + m * 16];
#pragma unroll
                for (int bj = 0; bj < 2; ++bj) { const f32x4 v0 = acc[ai][bj][m][0] * rr, v1 = acc[ai][bj][m][1] * rr;
                    u32x4 w; w.x = pk_bf16(v0[0], v0[1]); w.y = pk_bf16(v0[2], v0[3]); w.z = pk_bf16(v1[0], v1[1]); w.w = pk_bf16(v1[2], v1[3]);
                    *(u32x4*)(rowp + bj * HALF) = w; } }
    }
};
struct EpiSwiglu {
    static constexpr bool PERM = true, AFTER_DRAIN = false;
    bf16_t* O; int ldc; const PG8_LAS float* rstab; const PG8_LAS unsigned char* pmap;
    __device__ __forceinline__ void operator()(const f32x4 (&acc)[2][2][4][2], const Unit& u, int wr, int wc, int fr, int fq) const {
        const PG8_LAS float* rs = rstab + 256 * (int)pmap[u.pm] + wr * 64 + fr;
        const int row0 = u.pm * BM + wr * 64 + fr, col0 = u.pn * HALF + wc * 32 + 8 * fq;
#pragma unroll
        for (int ai = 0; ai < 2; ++ai)
#pragma unroll
            for (int m = 0; m < 4; ++m) { bf16_t* rowp = O + (size_t)(row0 + ai * HALF + m * 16) * ldc + col0;
                const float rr = rs[ai * HALF + m * 16];
                f32x4 h0, h1;
#pragma unroll
                for (int j = 0; j < 4; ++j) { const float g0 = acc[ai][0][m][0][j] * rr, g1 = acc[ai][0][m][1][j] * rr;
                    h0[j] = g0 * sigm(g0) * (acc[ai][1][m][0][j] * rr); h1[j] = g1 * sigm(g1) * (acc[ai][1][m][1][j] * rr); }
                u32x4 w; w.x = pk_bf16(h0[0], h0[1]); w.y = pk_bf16(h0[2], h0[3]); w.z = pk_bf16(h1[0], h1[1]); w.w = pk_bf16(h1[2], h1[3]);
                *(u32x4*)rowp = w; }
    }
};
template <int HALFSTEP> struct EpiResid {
    static constexpr bool PERM = false, AFTER_DRAIN = false;
    bf16_t* X; int ldc; float* ssq;
    __device__ __forceinline__ void operator()(const f32x4 (&acc)[2][2][4][2], const Unit& u, int wr, int wc, int fr, int fq) const {
        const int row0 = u.pm * BM + wr * 64 + fr, col0 = u.pn * BM + wc * 32 + 4 * fq, lane = fr + 16 * fq;
        typedef unsigned u32x2_t __attribute__((ext_vector_type(2)));
#pragma unroll
        for (int ai = 0; ai < 2; ++ai) {
            u32x2_t b[4][2][2];
#pragma unroll
            for (int m = 0; m < 4; ++m)
#pragma unroll
                for (int bj = 0; bj < 2; ++bj)
#pragma unroll
                    for (int n = 0; n < 2; ++n) b[m][bj][n] = *(const u32x2_t*)(X + (size_t)(row0 + ai * HALF + m * 16) * ldc + col0 + bj * HALF + n * 16);
#pragma unroll
            for (int m = 0; m < 4; ++m) { const size_t r = (size_t)(row0 + ai * HALF + m * 16); bf16_t* rowp = X + r * ldc + col0; float ss = 0.f;
#pragma unroll
                for (int bj = 0; bj < 2; ++bj)
#pragma unroll
                    for (int n = 0; n < 2; ++n) { const f32x4 a = acc[ai][bj][m][n] * (HALFSTEP ? 0.5f : 1.0f); const u32x2_t bb = b[m][bj][n];
                        const float x0 = bf_lo(bb.x) + a[0], x1 = bf_hi(bb.x) + a[1], x2 = bf_lo(bb.y) + a[2], x3 = bf_hi(bb.y) + a[3];
                        u32x2_t w; w.x = pk_bf16(x0, x1); w.y = pk_bf16(x2, x3);
                        *(u32x2_t*)(rowp + bj * HALF + n * 16) = w; ss += (x0 * x0 + x1 * x1) + (x2 * x2 + x3 * x3); }
                ss += xlane(ss, 16, lane); ss += xlane(ss, 32, lane);
                if (fq == 0) ssq[r * 16 + 4 * u.pn + wc] = ss; }
            __builtin_amdgcn_sched_barrier(0);
        }
    }
};
template <bool ADD> struct EpiGate {
    static constexpr bool PERM = true, AFTER_DRAIN = false;
    bf16_t* O; int ldc; const bf16_t* G; int ldg;
    __device__ __forceinline__ void operator()(const f32x4 (&acc)[2][2][4][2], const Unit& u, int wr, int wc, int fr, int fq) const {
        const int row0 = u.pm * BM + wr * 64 + fr, col0 = u.pn * BM + wc * 32 + 8 * fq;
#pragma unroll
        for (int ai = 0; ai < 2; ++ai) {
            u32x4 gq[4][2], oq[4][2];
#pragma unroll
            for (int m = 0; m < 4; ++m)
#pragma unroll
                for (int bj = 0; bj < 2; ++bj) { const size_t r = (size_t)(row0 + ai * HALF + m * 16);
                    gq[m][bj] = *(const u32x4*)(G + r * ldg + col0 + bj * HALF);
                    if (ADD) oq[m][bj] = *(const u32x4*)(O + r * ldc + col0 + bj * HALF); }
#pragma unroll
            for (int m = 0; m < 4; ++m) { const size_t r = (size_t)(row0 + ai * HALF + m * 16);
#pragma unroll
                for (int bj = 0; bj < 2; ++bj) { const f32x4 v0 = acc[ai][bj][m][0], v1 = acc[ai][bj][m][1]; const u32x4 g = gq[m][bj];
                    float r0 = sigm(bf_lo(g.x)) * v0[0], r1 = sigm(bf_hi(g.x)) * v0[1], r2 = sigm(bf_lo(g.y)) * v0[2], r3 = sigm(bf_hi(g.y)) * v0[3];
                    float r4 = sigm(bf_lo(g.z)) * v1[0], r5 = sigm(bf_hi(g.z)) * v1[1], r6 = sigm(bf_lo(g.w)) * v1[2], r7 = sigm(bf_hi(g.w)) * v1[3];
                    if (ADD) { const u32x4 o = oq[m][bj]; r0 += bf_lo(o.x); r1 += bf_hi(o.x); r2 += bf_lo(o.y); r3 += bf_hi(o.y); r4 += bf_lo(o.z); r5 += bf_hi(o.z); r6 += bf_lo(o.w); r7 += bf_hi(o.w); }
                    u32x4 w; w.x = pk_bf16(r0, r1); w.y = pk_bf16(r2, r3); w.z = pk_bf16(r4, r5); w.w = pk_bf16(r6, r7);
                    *(u32x4*)(O + r * ldc + col0 + bj * HALF) = w; } }
            __builtin_amdgcn_sched_barrier(0);
        }
    }
};
template <class Epi, class Sched, bool ALIGN_EPI = false, bool SP2 = false>
__device__ __forceinline__ void gemm_phase(PG8_LAS unsigned char* lds, const Gemm g, const Sched S, const Epi E, const int wave_id) {
    unsigned z_o = 0u; asm volatile("" : "+v"(z_o)); int tid_o = wave_id * 64 + (int)__builtin_amdgcn_mbcnt_hi(~0u, __builtin_amdgcn_mbcnt_lo(~0u, z_o)); asm volatile("" : "+v"(tid_o));
    const int tid = tid_o, wid = __builtin_amdgcn_readfirstlane(tid >> 6), lane = tid & 63, wr = wid >> 2, wc = wid & 3, fr = lane & 15, fq = lane >> 4;
    const int K = g.K, nt = K / BK;
    unsigned voffA[2], voffB[2];
#pragma unroll
    for (int i = 0; i < 2; ++i) { int R, C; stage_rc(tid * 16 + i * 8192, R, C); const int Rb = Epi::PERM ? ((R & ~31) + perm32(R & 31)) : R;
        voffA[i] = (unsigned)(R * K + C) * 2u; voffB[i] = (unsigned)(Rb * K + C) * 2u; }
    const size_t kstep = (size_t)(BK * 2);
    const size_t hstep = (size_t)HALF * K * 2;
    const size_t tstep = 2 * hstep;
    const unsigned ldsw = (unsigned)wid * 1024u;
    const int aoff = lds_byte(wr * 64 + fr, fq * 8), boff = lds_byte(wc * 32 + fr, fq * 8);
#define PG8_SA(b, h) (((b) * 2 + (h)) * HTB)
#define PG8_SB(b, h) ((4 + (b) * 2 + (h)) * HTB)
#define PG8_STAGE(bufoff, gbase, voff) do { _Pragma("unroll") for (int _i = 0; _i < 2; ++_i) \
        __builtin_amdgcn_global_load_lds((const unsigned*)((const char*)(gbase) + (voff)[_i]), (PG8_LAS unsigned*)(lds + (bufoff) + ldsw + _i * 8192), 16, 0, 0); } while (0)
#define PG8_LDA(dst, b, h) do { _Pragma("unroll") for (int m = 0; m < 4; ++m) _Pragma("unroll") for (int k = 0; k < 2; ++k) dst[m][k] = *(const PG8_LAS bf16x8*)(lds + PG8_SA(b, h) + aoff + m * 2048 + k * 1024); } while (0)
#define PG8_LDB(dst, b, h) do { _Pragma("unroll") for (int n = 0; n < 2; ++n) _Pragma("unroll") for (int k = 0; k < 2; ++k) dst[n][k] = *(const PG8_LAS bf16x8*)(lds + PG8_SB(b, h) + boff + n * 2048 + k * 1024); } while (0)
#define PG8_MMA(ai, bj, At, Bt) do { __builtin_amdgcn_s_setprio(1); _Pragma("unroll") for (int m = 0; m < 4; ++m) _Pragma("unroll") for (int n = 0; n < 2; ++n) _Pragma("unroll") for (int k = 0; k < 2; ++k) \
        acc[ai][bj][m][n] = __builtin_amdgcn_mfma_f32_16x16x32_bf16(Bt[n][k], At[m][k], acc[ai][bj][m][n], 0, 0, 0); __builtin_amdgcn_s_setprio(0); } while (0)
#define PG8_WAIT_V(n) asm volatile("s_waitcnt vmcnt(" #n ")" ::: "memory")
#define PG8_WAIT_L(n) asm volatile("s_waitcnt lgkmcnt(" #n ")" ::: "memory")
#define PG8_BAR __builtin_amdgcn_s_barrier()
#define PG8_SCHED __builtin_amdgcn_sched_barrier(0)
    Unit cur, nxt; int ui = 0;
    if (!S.next(0, cur)) return;
    f32x4 acc[2][2][4][2];
#pragma unroll
    for (int a = 0; a < 2; ++a)
#pragma unroll
        for (int b = 0; b < 2; ++b)
#pragma unroll
            for (int m = 0; m < 4; ++m)
#pragma unroll
                for (int n = 0; n < 2; ++n) acc[a][b][m][n] = (f32x4){0.f, 0.f, 0.f, 0.f};
    bf16x8 At[4][2], B0[2][2], B1[2][2];
    const char* cA = (const char*)g.A + (size_t)cur.pm * tstep; const char* cB = (const char*)g.Bt + (size_t)cur.pn * tstep;
    S.a_ready(cur);
    if constexpr (SP2) {
        PG8_STAGE(PG8_SB(0, 0), cB, voffB); PG8_STAGE(PG8_SB(0, 1), cB + hstep, voffB); PG8_STAGE(PG8_SA(0, 0), cA, voffA); PG8_STAGE(PG8_SA(0, 1), cA + hstep, voffA);
        if (wr == 1) PG8_BAR;
        PG8_WAIT_V(2); PG8_BAR;
        PG8_STAGE(PG8_SB(1, 0), cB + kstep, voffB); PG8_STAGE(PG8_SA(1, 0), cA + kstep, voffA); PG8_STAGE(PG8_SB(1, 1), cB + hstep + kstep, voffB);
        PG8_WAIT_V(6); PG8_BAR;
    } else {
        PG8_STAGE(PG8_SB(0, 0), cB, voffB); PG8_STAGE(PG8_SA(0, 0), cA, voffA); PG8_STAGE(PG8_SB(0, 1), cB + hstep, voffB); PG8_STAGE(PG8_SA(0, 1), cA + hstep, voffA);
        if (wr == 1) PG8_BAR;
        PG8_WAIT_V(4); PG8_BAR;
        PG8_STAGE(PG8_SB(1, 0), cB + kstep, voffB); PG8_STAGE(PG8_SA(1, 0), cA + kstep, voffA); PG8_STAGE(PG8_SB(1, 1), cB + hstep + kstep, voffB);
        PG8_WAIT_V(6); PG8_BAR;
    }
    for (;;) {
        const bool has_next = S.next(ui + 1, nxt);
        const char* nA = has_next ? (const char*)g.A + (size_t)nxt.pm * tstep : cA; const char* nB = has_next ? (const char*)g.Bt + (size_t)nxt.pn * tstep : cB;
        for (int t = 0; t < nt; t += 2) {
            const bool last = (t == nt - 2);
            const char* a1 = cA + (size_t)(t + 1) * kstep;
            const char* a2 = last ? nA : cA + (size_t)(t + 2) * kstep; const char* b2 = last ? nB : cB + (size_t)(t + 2) * kstep;
            const char* a3 = a2 + kstep; const char* b3 = b2 + kstep;
            if (last && has_next) S.a_ready(nxt);
            if constexpr (SP2) {
            PG8_LDB(B0, 0, 0); PG8_LDB(B1, 0, 1); PG8_SCHED; PG8_LDA(At, 0, 0); PG8_STAGE(PG8_SA(1, 1), a1 + hstep, voffA);
            PG8_WAIT_V(8); PG8_WAIT_L(0); PG8_BAR; PG8_MMA(0, 0, At, B0); PG8_MMA(0, 1, At, B1); PG8_BAR; PG8_SCHED;
            PG8_LDA(At, 0, 1); PG8_STAGE(PG8_SB(0, 0), b2, voffB); PG8_STAGE(PG8_SB(0, 1), b2 + hstep, voffB); PG8_STAGE(PG8_SA(0, 0), a2, voffA);
            PG8_WAIT_V(8); PG8_WAIT_L(0); PG8_BAR; PG8_MMA(1, 0, At, B0); PG8_MMA(1, 1, At, B1); PG8_BAR; PG8_SCHED;
            PG8_LDB(B0, 1, 0); PG8_LDB(B1, 1, 1); PG8_SCHED; PG8_LDA(At, 1, 0); PG8_STAGE(PG8_SA(0, 1), a2 + hstep, voffA);
            PG8_WAIT_V(8); PG8_WAIT_L(0); PG8_BAR; PG8_MMA(0, 0, At, B0); PG8_MMA(0, 1, At, B1); PG8_BAR; PG8_SCHED;
            PG8_LDA(At, 1, 1); PG8_STAGE(PG8_SB(1, 0), b3, voffB); PG8_STAGE(PG8_SB(1, 1), b3 + hstep, voffB); PG8_STAGE(PG8_SA(1, 0), a3, voffA);
            PG8_WAIT_V(8); PG8_WAIT_L(0); PG8_BAR; PG8_MMA(1, 0, At, B0); PG8_MMA(1, 1, At, B1); PG8_BAR; PG8_SCHED;
            } else {
            PG8_LDB(B0, 0, 0); PG8_SCHED; PG8_LDA(At, 0, 0); PG8_STAGE(PG8_SA(1, 1), a1 + hstep, voffA);
            PG8_WAIT_L(8); PG8_BAR; PG8_WAIT_L(0); PG8_MMA(0, 0, At, B0); PG8_BAR; PG8_SCHED;
            PG8_LDB(B1, 0, 1); PG8_STAGE(PG8_SB(0, 0), b2, voffB);
            PG8_BAR; PG8_WAIT_L(0); PG8_MMA(0, 1, At, B1); PG8_BAR;
            PG8_LDA(At, 0, 1); PG8_STAGE(PG8_SA(0, 0), a2, voffA);
            PG8_BAR; PG8_WAIT_L(0); PG8_MMA(1, 0, At, B0); PG8_BAR; PG8_SCHED;
            PG8_STAGE(PG8_SB(0, 1), b2 + hstep, voffB);
            PG8_WAIT_V(6); PG8_BAR; PG8_MMA(1, 1, At, B1); PG8_BAR;
            PG8_LDB(B0, 1, 0); PG8_SCHED; PG8_LDA(At, 1, 0); PG8_STAGE(PG8_SA(0, 1), a2 + hstep, voffA);
            PG8_WAIT_L(8); PG8_BAR; PG8_WAIT_L(0); PG8_MMA(0, 0, At, B0); PG8_BAR; PG8_SCHED;
            PG8_LDB(B1, 1, 1); PG8_STAGE(PG8_SB(1, 0), b3, voffB);
            PG8_BAR; PG8_WAIT_L(0); PG8_MMA(0, 1, At, B1); PG8_BAR;
            PG8_LDA(At, 1, 1); PG8_STAGE(PG8_SA(1, 0), a3, voffA);
            PG8_BAR; PG8_WAIT_L(0); PG8_MMA(1, 0, At, B0); PG8_BAR; PG8_SCHED;
            PG8_STAGE(PG8_SB(1, 1), b3 + hstep, voffB);
            PG8_WAIT_V(6); PG8_BAR; PG8_MMA(1, 1, At, B1); PG8_BAR;
            }
        }
        if constexpr (ALIGN_EPI) { if (wr == 0) PG8_BAR; }
        if constexpr (!Epi::AFTER_DRAIN) { E(acc, cur, wr, wc, fr, fq); S.done(cur); }
        if (!has_next) break;
#pragma unroll
        for (int a = 0; a < 2; ++a)
#pragma unroll
            for (int b = 0; b < 2; ++b)
#pragma unroll
                for (int m = 0; m < 4; ++m)
#pragma unroll
                    for (int n = 0; n < 2; ++n) acc[a][b][m][n] = (f32x4){0.f, 0.f, 0.f, 0.f};
        cur = nxt; cA = nA; cB = nB; ++ui;
        if constexpr (ALIGN_EPI) { if (wr == 1) PG8_BAR; }
    }
    PG8_WAIT_V(0);
    if constexpr (!ALIGN_EPI) { if (wr == 0) PG8_BAR; }
    PG8_BAR;
    if constexpr (Epi::AFTER_DRAIN) { E.fused(acc, cur, wr, wc, fr, fq, lds, wid, lane); S.done(cur); }
#undef PG8_SA
#undef PG8_SB
#undef PG8_STAGE
#undef PG8_LDA
#undef PG8_LDB
#undef PG8_MMA
#undef PG8_WAIT_V
#undef PG8_WAIT_L
#undef PG8_BAR
#undef PG8_SCHED
}
}
#define GAS __attribute__((address_space(1)))
#define LAS __attribute__((address_space(3)))
typedef unsigned short bf16;
typedef unsigned v4u __attribute__((ext_vector_type(4)));
typedef float f32x4 __attribute__((ext_vector_type(4)));
typedef short bf16x8 __attribute__((ext_vector_type(8)));
typedef GAS unsigned gu32;
typedef GAS unsigned long long gu64;
#define RLX_AGENT __ATOMIC_RELAXED, __HIP_MEMORY_SCOPE_AGENT
#define LDS_WAIT() asm volatile("s_waitcnt lgkmcnt(0)" ::: "memory")
#define VM_WAIT() asm volatile("s_waitcnt vmcnt(0)" ::: "memory")
__device__ __forceinline__ unsigned long long rt() { return __builtin_amdgcn_s_memrealtime(); }
__device__ __forceinline__ unsigned f2bf(float f) { unsigned u = __builtin_bit_cast(unsigned, f); return (u + 0x7fffu + ((u >> 16) & 1u)) >> 16; }
__device__ __forceinline__ unsigned pk2(float lo, float hi) { return f2bf(lo) | (f2bf(hi) << 16); }

#define XB_TMO      128
#define XB_XCNT(j)  (256  + 64 * (j))
#define XB_XSUB(j)  (1280 + 64 * (j))
#define XB_XGEN(j)  (2304 + 64 * (j))
#define XB_TOP      3328
#define XB_TOPGEN   3392
#define XCD_BAR_WORDS 3456
#define XB_SPIN_CAP (1u << 18)

__device__ __forceinline__ unsigned xb_ld(unsigned* p)              { return __hip_atomic_load(p, __ATOMIC_RELAXED, __HIP_MEMORY_SCOPE_AGENT); }
__device__ __forceinline__ unsigned xb_add(unsigned* p, unsigned v) { return __hip_atomic_fetch_add(p, v, __ATOMIC_RELAXED, __HIP_MEMORY_SCOPE_AGENT); }
__device__ __forceinline__ unsigned xb_xcc_id() { return (unsigned)__builtin_amdgcn_s_getreg((3 << 11) | 20) & 0xFu; }
#define XB_SPIN(cond, bar) do { unsigned _sp = 0; while (cond) { __builtin_amdgcn_s_sleep(1); \
    if ((++_sp & 255u) == 0u) { if (xb_ld(&(bar)[XB_TMO])) break; if (_sp > XB_SPIN_CAP) { atomicAdd(&(bar)[XB_TMO], 1u); break; } } } } while (0)

struct XcdBarrier {
    unsigned wv;
    unsigned* bar; unsigned x;
    volatile LAS unsigned* st;
};

__device__ __forceinline__ bool xb_thread0(unsigned wv) { unsigned z = 0u; asm volatile("" : "+v"(z)); return wv == 0u && __builtin_amdgcn_mbcnt_hi(~0u, __builtin_amdgcn_mbcnt_lo(~0u, z)) == 0u; }
__device__ __forceinline__ XcdBarrier xcd_barrier_post(unsigned* bar, volatile LAS unsigned* st, unsigned wv) {
    XcdBarrier b; b.wv = wv; b.bar = bar; b.x = (unsigned)__builtin_amdgcn_readfirstlane((int)xb_xcc_id());     b.st = st;
    if (xb_thread0(wv)) (void)xb_add(&bar[XB_XCNT(b.x)], 1u);
    return b;
}
__device__ __forceinline__ void xcd_barrier_complete(unsigned* bar, unsigned x, unsigned& nloc, unsigned& nx) {
    const unsigned G = gridDim.x * gridDim.y * gridDim.z;
    unsigned sum, cnt, mine, sp = 0u;
    for (;;) {
        sum = 0u; cnt = 0u; mine = 0u;
#pragma unroll
        for (unsigned j = 0; j < 16; ++j) { const unsigned c = xb_ld(&bar[XB_XCNT(j)]); sum += c; cnt += (c > 0u) ? 1u : 0u; mine = (j == x) ? c : mine; }
        if (sum == G) break;
        __builtin_amdgcn_s_sleep(1);
        if ((++sp & 255u) == 0u) { if (xb_ld(&bar[XB_TMO])) break; if (sp > XB_SPIN_CAP) { atomicAdd(&bar[XB_TMO], 1u); break; } }
    }
    nloc = mine > 0u ? mine : 1u; nx = cnt > 0u ? cnt : 1u;
}

__device__ __forceinline__ void xcd_barrier(const XcdBarrier& b) {
    asm volatile("s_waitcnt vmcnt(0)" ::: "memory");
    __syncthreads();
    if (xb_thread0(b.wv)) {
        unsigned* bar = b.bar;
        __builtin_amdgcn_s_waitcnt(0);
        unsigned nloc = b.st[0], nx = b.st[1];
        if (nloc == 0u) { xcd_barrier_complete(bar, b.x, nloc, nx); b.st[0] = nloc; b.st[1] = nx; }
        const unsigned old = xb_add(&bar[XB_XSUB(b.x)], 1u);
        const unsigned gen = old / nloc;
        if (old + 1u == (gen + 1u) * nloc) {
            __builtin_amdgcn_fence(__ATOMIC_RELEASE, "agent");
            asm volatile("s_waitcnt vmcnt(0)" ::: "memory");
            const unsigned og = xb_add(&bar[XB_TOP], 1u);
            const unsigned tg = og / nx;
            if (og + 1u == (tg + 1u) * nx) xb_add(&bar[XB_TOPGEN], 1u);
            else XB_SPIN(xb_ld(&bar[XB_TOPGEN]) == tg, bar);
            __builtin_amdgcn_fence(__ATOMIC_ACQUIRE, "agent");
            xb_add(&bar[XB_XGEN(b.x)], 1u);
            asm volatile("s_waitcnt vmcnt(0)" ::: "memory");
        } else {
            XB_SPIN(xb_ld(&bar[XB_XGEN(b.x)]) == gen, bar);
            __builtin_amdgcn_fence(__ATOMIC_ACQUIRE, "agent");
            asm volatile("s_waitcnt vmcnt(0)" ::: "memory");
        }
    }
    __syncthreads();
}

constexpr int NWAVES = 8;
constexpr int BATCH = 32, T = 2048, D = 1024, FF = 2816, NL = 2;
constexpr int M = BATCH * T;
constexpr int DIN = 3784;
constexpr int ZN = 4352;
constexpr int ZA = 2304, ZGN = 2048;
constexpr int Z_QL = 0, Z_QI = 1024, Z_PI = 1536, Z_CKV = 2048, Z_KI = 2176, Z_WI = 2240;
constexpr int R_GA = 2304, R_GB = 3328;
constexpr int S_Q = 0, S_CKV = 512, S_QI = 640, S_KI = 1152, S_WI = 1216, S_PI = 1224, S_GA = 1736, S_GB = 2760;
constexpr float EPS = 1e-6f;
constexpr float IDX_SCALE = 0.044194173824159216f;
constexpr float QSCALE = 0.125f * 1.4426950408889634f;

constexpr size_t MiB = 1u << 20;
constexpr size_t WS_CTL = 0, CTL_ZERO_BYTES = 1 * MiB;
constexpr size_t WS_W = 1 * MiB, LW = 46 * MiB + MiB / 2;
constexpr size_t O_WGU1 = 0, O_WD1 = 11 * MiB, O_WIN = 16 * MiB + MiB / 2, O_WA = 25 * MiB, O_WP = 27 * MiB, O_WO = 28 * MiB, O_WGU2 = 30 * MiB, O_WD2 = 41 * MiB;
constexpr size_t WS_XR = 96 * MiB;
constexpr size_t WS_ZA = 224 * MiB;
constexpr size_t WS_ZG = 512 * MiB;
constexpr size_t WS_OL = 768 * MiB;
constexpr size_t WS_XN = WS_OL;
constexpr size_t WS_PO = 896 * MiB;
constexpr size_t WS_CK = 960 * MiB;
constexpr size_t WS_MASK = 976 * MiB;
constexpr size_t WS_SSQ = 992 * MiB;
constexpr size_t WS_END = 996 * MiB;
static_assert(WS_W + NL * LW <= WS_XR && WS_XR + (size_t)M * D * 2 <= WS_ZA && WS_ZA + (size_t)M * ZA * 2 <= WS_ZG && WS_ZG + (size_t)M * ZGN * 2 <= WS_OL && WS_ZA + (size_t)M * FF * 2 <= WS_OL, "d_ws map");
static_assert(O_WD2 + (size_t)D * FF * 2 <= LW && O_WIN + (size_t)ZN * D * 2 <= O_WA, "weight map");
constexpr int CW_TMO = 0, CW_CODE = 1, CW_BAR = 4096;

constexpr int RING_OFF = 0, RING_BYTES = 131072;
constexpr int LDSCTL_OFF = RING_BYTES, MISC_OFF = LDSCTL_OFF + 320;
constexpr int RSTAB_OFF = LDSCTL_OFF + 512, RSTAB_SLOTS = 8, PMAP_OFF = RSTAB_OFF + RSTAB_SLOTS * 1024, PLIST_OFF = PMAP_OFF + 256;
constexpr int LDS_BYTES = 147456;

struct Args { const float* in[20]; float* out; unsigned char* ws; };
typedef const Args __attribute__((address_space(4)))* cargs_t;
struct Frame {
    LAS unsigned char* lds;
    volatile LAS unsigned* MISC;
    gu32* ctl;
    int wave;
    int vcu, G;
};

typedef unsigned u32x4 __attribute__((ext_vector_type(4)));
typedef unsigned u32x2 __attribute__((ext_vector_type(2)));
typedef float f32x16 __attribute__((ext_vector_type(16)));
typedef short s16x4 __attribute__((ext_vector_type(4)));
using pg8::pk_bf16; using pg8::bf_lo; using pg8::bf_hi;

__device__ __forceinline__ float shx(float v, int m, int lane) { return __int_as_float(__builtin_amdgcn_ds_bpermute((lane ^ m) << 2, __float_as_int(v))); }
__device__ __forceinline__ float wave_sum(float v, int lane) {
#pragma unroll
    for (int o = 1; o < 64; o <<= 1) v += shx(v, o, lane);
    return v;
}
__device__ __forceinline__ int sopq(int v) { asm volatile("" : "+s"(v)); return v; }

__device__ __forceinline__ void tr_item(const float* W, int ldw, int c0, int k0, bf16* WT, int Kd, int drow0, LAS float* scr, int lane, const float* gk = nullptr) {
#pragma unroll 16
    for (int i = 0; i < 32; ++i) { const int kk = 2 * i + (lane >> 5); const float gg = gk ? gk[k0 + kk] : 1.0f; scr[kk * 33 + (lane & 31)] = W[(size_t)(k0 + kk) * ldw + c0 + (lane & 31)] * gg; }
    LDS_WAIT(); asm volatile("" ::: "memory");
    const int c = lane & 7;
#pragma unroll
    for (int j = 0; j < 4; ++j) { const int n = (lane >> 3) + 8 * j; const LAS float* s = scr + (8 * c) * 33 + n;
        v4u o; o.x = pk2(s[0 * 33], s[1 * 33]); o.y = pk2(s[2 * 33], s[3 * 33]); o.z = pk2(s[4 * 33], s[5 * 33]); o.w = pk2(s[6 * 33], s[7 * 33]);
        *(GAS v4u*)(WT + (size_t)(drow0 + n) * Kd + k0 + 8 * c) = o; }
    LDS_WAIT(); asm volatile("" ::: "memory");
}
constexpr int I_GU = 16 * 88, I_DN = 44 * 32, I_WO = 16 * 32, I_WIN = 16 * 103, I_ZERO = 1, I_QL = 1024, I_WA = 2048, I_WP = 1024;
constexpr int I_LAYER = 6 * I_GU + I_WO + I_WIN + I_ZERO + I_QL + I_WA + I_WP;
static_assert(I_GU == I_DN, "item counts");

__device__ __forceinline__ void prologue_item(cargs_t ka, int it, LAS float* scr, int lane) {
    const float* const __attribute__((address_space(4)))* in = ka->in; unsigned char* ws = ka->ws;
    const int l = it / I_LAYER; int r = it - l * I_LAYER;
    unsigned char* wl = ws + WS_W + (size_t)l * LW;
    if (r < I_WA) {
        const int hh = r >> 8, cb = (r >> 4) & 15, ib = r & 15, n = 64 * ib + lane;
        const float* wuv = in[9] + (size_t)l * 128 * 8 * 64; const float* wba = in[12] + (size_t)l * 512 * 1024;
        float a[8];
#pragma unroll
        for (int j = 0; j < 8; ++j) a[j] = 0.f;
#pragma unroll 16
        for (int d = 0; d < 64; ++d) { const float wv = wba[(size_t)(hh * 64 + d) * 1024 + n];
#pragma unroll
            for (int j = 0; j < 8; ++j) a[j] += wuv[((8 * cb + j) * 8 + hh) * 64 + d] * wv; }
        v4u o; o.x = pk2(a[0], a[1]); o.y = pk2(a[2], a[3]); o.z = pk2(a[4], a[5]); o.w = pk2(a[6], a[7]);
        *(GAS v4u*)((bf16*)(wl + O_WA) + (size_t)n * 1024 + hh * 128 + 8 * cb) = o; return; }
    r -= I_WA;
    if (r < I_WP) {
        const int g = r >> 8, cb = (r >> 4) & 15, ib = r & 15, n = 64 * ib + lane;
        const float* pw = in[10] + (size_t)l * 4 * 128 * 128; const float* ps = in[11] + (size_t)l * 512; const float* wbp = in[13] + (size_t)l * 512 * 1024;
        float a[8];
#pragma unroll
        for (int j = 0; j < 8; ++j) a[j] = 0.f;
#pragma unroll 16
        for (int d = 0; d < 128; ++d) { const float wv = wbp[(size_t)(g * 128 + d) * 1024 + n] * ps[g * 128 + d];
#pragma unroll
            for (int j = 0; j < 8; ++j) a[j] += pw[(size_t)(g * 128 + 8 * cb + j) * 128 + d] * wv; }
        v4u o; o.x = pk2(a[0], a[1]); o.y = pk2(a[2], a[3]); o.z = pk2(a[4], a[5]); o.w = pk2(a[6], a[7]);
        *(GAS v4u*)((bf16*)(wl + O_WP) + (size_t)n * 512 + g * 128 + 8 * cb) = o; return; }
    r -= I_WP;
    if (r < I_QL) {
        const int n = r, hh = n >> 7, c = n & 127;
        const float* win = in[6] + (size_t)l * D * DIN; const f32x4* wuk = (const f32x4*)(in[8] + (size_t)l * 128 * 8 * 64 + (size_t)(c * 8 + hh) * 64);
        bf16* dst = (bf16*)(wl + O_WIN) + (size_t)n * D;
        for (int i = 0; i < 16; ++i) { const int k = 64 * i + lane; const f32x4* wr = (const f32x4*)(win + (size_t)k * DIN + hh * 64); float a = 0.f;
#pragma unroll 4
            for (int d4 = 0; d4 < 16; ++d4) { const f32x4 x = wr[d4], y = wuk[d4]; a += (x.x * y.x + x.y * y.y) + (x.z * y.z + x.w * y.w); }
            dst[k] = (bf16)f2bf(a * (QSCALE * in[5][(size_t)l * D + k])); }
        return; }
    r -= I_QL;
    if (r < I_GU) { const int kb = r / 88, nb = r % 88, n0 = 32 * nb; tr_item(in[2] + (size_t)l * D * FF, FF, n0, 64 * kb, (bf16*)(wl + O_WGU1), D, 256 * (n0 >> 7) + (n0 & 127), scr, lane, in[1] + (size_t)l * D); return; }
    r -= I_GU;
    if (r < I_GU) { const int kb = r / 88, nb = r % 88, n0 = 32 * nb; tr_item(in[3] + (size_t)l * D * FF, FF, n0, 64 * kb, (bf16*)(wl + O_WGU1), D, 256 * (n0 >> 7) + 128 + (n0 & 127), scr, lane, in[1] + (size_t)l * D); return; }
    r -= I_GU;
    if (r < I_DN) { const int kb = r / 32, nb = r % 32; tr_item(in[4] + (size_t)l * FF * D, D, 32 * nb, 64 * kb, (bf16*)(wl + O_WD1), FF, 32 * nb, scr, lane); return; }
    r -= I_DN;
    if (r < I_GU) { const int kb = r / 88, nb = r % 88, n0 = 32 * nb; tr_item(in[16] + (size_t)l * D * FF, FF, n0, 64 * kb, (bf16*)(wl + O_WGU2), D, 256 * (n0 >> 7) + (n0 & 127), scr, lane, in[15] + (size_t)l * D); return; }
    r -= I_GU;
    if (r < I_GU) { const int kb = r / 88, nb = r % 88, n0 = 32 * nb; tr_item(in[17] + (size_t)l * D * FF, FF, n0, 64 * kb, (bf16*)(wl + O_WGU2), D, 256 * (n0 >> 7) + 128 + (n0 & 127), scr, lane, in[15] + (size_t)l * D); return; }
    r -= I_GU;
    if (r < I_DN) { const int kb = r / 32, nb = r % 32; tr_item(in[18] + (size_t)l * FF * D, D, 32 * nb, 64 * kb, (bf16*)(wl + O_WD2), FF, 32 * nb, scr, lane); return; }
    r -= I_DN;
    if (r < I_WO) { const int kb = r / 32, nb = r % 32; tr_item(in[14] + (size_t)l * D * D, D, 32 * nb, 64 * kb, (bf16*)(wl + O_WO), D, 32 * nb, scr, lane); return; }
    r -= I_WO;
    if (r < I_WIN) {
        const int kb = r / 103, v = 32 * (r % 103); int c0, d0;
        if (v < 512) { c0 = S_QI + v; d0 = Z_QI + v; }
        else if (v < 1024) { c0 = S_PI + (v - 512); d0 = Z_PI + (v - 512); }
        else if (v < 2048) { c0 = S_GA + (v - 1024); d0 = R_GA + (v - 1024); }
        else if (v < 3072) { c0 = S_GB + (v - 2048); d0 = R_GB + (v - 2048); }
        else if (v < 3200) { c0 = S_CKV + (v - 3072); d0 = Z_CKV + (v - 3072); }
        else { c0 = S_KI + (v - 3200); d0 = Z_KI + (v - 3200); }
        tr_item(in[6] + (size_t)l * D * DIN, DIN, c0, 64 * kb, (bf16*)(wl + O_WIN), D, d0, scr, lane, in[5] + (size_t)l * D); return; }
    r -= I_WIN;
    {
        v4u z; z.x = 0u; z.y = 0u; z.z = 0u; z.w = 0u; GAS v4u* p = (GAS v4u*)((bf16*)(wl + O_WIN) + (size_t)(Z_KI + 96) * D);
        for (int i = lane; i < 32 * D / 8; i += 64) p[i] = z; }
}

__device__ __forceinline__ void rms_phase(const bf16* src, const float* g, bf16* dst, int gw, int NGW, int lane) {
    f32x4 gv[4];
#pragma unroll
    for (int j = 0; j < 4; ++j) gv[j] = ((const f32x4*)g)[64 * j + lane];
    for (int m0 = gw; m0 < M; m0 += 4 * NGW) {
        u32x2 w[4][4];
#pragma unroll
        for (int r = 0; r < 4; ++r) { const int m = m0 + r * NGW < M ? m0 + r * NGW : m0; const GAS u32x2* xr = (const GAS u32x2*)(src + (size_t)m * D) + lane;
#pragma unroll
            for (int j = 0; j < 4; ++j) w[r][j] = xr[64 * j]; }
#pragma unroll
        for (int r = 0; r < 4; ++r) { const int m = m0 + r * NGW; if (m < M) {
            f32x4 v[4]; float s = 0.f;
#pragma unroll
            for (int j = 0; j < 4; ++j) { v[j].x = bf_lo(w[r][j].x); v[j].y = bf_hi(w[r][j].x); v[j].z = bf_lo(w[r][j].y); v[j].w = bf_hi(w[r][j].y); s += (v[j].x * v[j].x + v[j].y * v[j].y) + (v[j].z * v[j].z + v[j].w * v[j].w); }
            const float rstd = 1.f / sqrtf(wave_sum(s, lane) * (1.f / D) + EPS);
            GAS u32x2* o8 = (GAS u32x2*)(dst + (size_t)m * D) + lane;
#pragma unroll
            for (int j = 0; j < 4; ++j) { u32x2 q; q.x = pk_bf16(v[j].x * rstd * gv[j].x, v[j].y * rstd * gv[j].y); q.y = pk_bf16(v[j].z * rstd * gv[j].z, v[j].w * rstd * gv[j].w); o8[64 * j] = q; } } }
    }
}
__device__ __forceinline__ void xr_init_phase(const float* src, bf16* xr_out, float* ssq, int gw, int NGW, int lane) {
    for (int m0 = gw; m0 < M; m0 += 2 * NGW) {
        f32x4 v[2][4]; float s[2];
#pragma unroll
        for (int r = 0; r < 2; ++r) { const int m = m0 + r * NGW < M ? m0 + r * NGW : m0; const GAS f32x4* xr = (const GAS f32x4*)(src + (size_t)m * D) + lane; s[r] = 0.f;
#pragma unroll
            for (int j = 0; j < 4; ++j) { v[r][j] = xr[64 * j]; s[r] += (v[r][j].x * v[r][j].x + v[r][j].y * v[r][j].y) + (v[r][j].z * v[r][j].z + v[r][j].w * v[r][j].w); } }
#pragma unroll
        for (int r = 0; r < 2; ++r) { const int m = m0 + r * NGW; if (m < M) {
            const float tot = wave_sum(s[r], lane);
            GAS u32x2* x8 = (GAS u32x2*)(xr_out + (size_t)m * D) + lane;
#pragma unroll
            for (int j = 0; j < 4; ++j) { u32x2 q; q.x = pk_bf16(v[r][j].x, v[r][j].y); q.y = pk_bf16(v[r][j].z, v[r][j].w); x8[64 * j] = q; }
            if (lane < 16) ssq[(size_t)m * 16 + lane] = lane == 0 ? tot : 0.f; } }
    }
}
template <class Sched> __device__ __forceinline__ void rstab_fill(LAS unsigned char* lds, const Sched& S, const float* ssq, int tid) {
    LAS unsigned char* pmap = lds + PMAP_OFF; LAS int* plist = (LAS int*)(lds + PLIST_OFF); LAS float* tab = (LAS float*)(lds + RSTAB_OFF);
    if (tid < 256) pmap[tid] = 0xff;
    __syncthreads();
    if (tid == 0) { int np = 0; pg8::Unit u;
        for (int i = 0; S.next(i, u); ++i) if (pmap[u.pm] == 0xff && np < RSTAB_SLOTS) { pmap[u.pm] = (unsigned char)np; plist[np] = u.pm; ++np; }
        plist[RSTAB_SLOTS] = np; }
    __syncthreads();
    const int np = plist[RSTAB_SLOTS + (tid >> 16)];
    for (int e = tid; e < np * 256; e += NWAVES * 64) { const int slot = e >> 8, row = e & 255; const size_t m = (size_t)plist[slot] * 256 + row;
        const GAS f32x4* p = (const GAS f32x4*)(ssq + m * 16); const f32x4 a = p[0], b = p[1], c = p[2], d = p[3];
        const float t = (((a.x + a.y) + (a.z + a.w)) + ((b.x + b.y) + (b.z + b.w))) + (((c.x + c.y) + (c.z + c.w)) + ((d.x + d.y) + (d.z + d.w)));
        tab[e] = 1.f / sqrtf(t * (1.f / D) + EPS); }
    __syncthreads();
}
__device__ __forceinline__ void final_norm_phase(const bf16* src, float* out, const float* g, int gw, int NGW, int lane, bool poison, const unsigned* diagp = nullptr) {
    f32x4 gv[4];
#pragma unroll
    for (int j = 0; j < 4; ++j) gv[j] = ((const f32x4*)g)[64 * j + lane];
    const float qnan = __builtin_nanf("");
    for (int m0 = gw; m0 < M; m0 += 4 * NGW) {
        u32x2 w[4][4];
#pragma unroll
        for (int r = 0; r < 4; ++r) { const int m = m0 + r * NGW < M ? m0 + r * NGW : m0; const GAS u32x2* xr = (const GAS u32x2*)(src + (size_t)m * D) + lane;
#pragma unroll
            for (int j = 0; j < 4; ++j) w[r][j] = xr[64 * j]; }
#pragma unroll
        for (int r = 0; r < 4; ++r) { const int m = m0 + r * NGW; if (m < M) {
            f32x4 v[4]; float s = 0.f;
#pragma unroll
            for (int j = 0; j < 4; ++j) { v[j].x = bf_lo(w[r][j].x); v[j].y = bf_hi(w[r][j].x); v[j].z = bf_lo(w[r][j].y); v[j].w = bf_hi(w[r][j].y); s += (v[j].x * v[j].x + v[j].y * v[j].y) + (v[j].z * v[j].z + v[j].w * v[j].w); }
            float rstd = 1.f / sqrtf(wave_sum(s, lane) * (1.f / D) + EPS);
            if (poison) rstd = qnan;
#if DIAG_SEL
            { const unsigned long long* dg = (const unsigned long long*)diagp; const float tot = (float)(dg[0] + dg[1] + dg[2] + dg[3]); rstd *= 1.0f + floorf((float)dg[DIAG_SEL - 1] / tot * 16.0f + 0.5f) * (1.0f / 16.0f); }
#endif
            GAS f32x4* o = (GAS f32x4*)(out + (size_t)m * D) + lane;
#pragma unroll
            for (int j = 0; j < 4; ++j) o[64 * j] = v[j] * rstd * gv[j]; } }
    }
}
__device__ __forceinline__ void prep_phase(const bf16* Z, const float* gkv, bf16* CK, bf16* PO, int gw, int NGW, int lane) {
    {
        const int sub = lane >> 4, ch = lane & 15;
        float gk[8];
#pragma unroll
        for (int e = 0; e < 8; ++e) gk[e] = gkv[8 * ch + e];
        for (int r0 = gw; r0 < M / 4; r0 += 4 * NGW) {
            u32x4 w[4];
#pragma unroll
            for (int q = 0; q < 4; ++q) { const int r4 = r0 + q * NGW < M / 4 ? r0 + q * NGW : r0; w[q] = *(const GAS u32x4*)(Z + ((size_t)r4 * 4 + sub) * ZA + Z_CKV + 8 * ch); }
#pragma unroll
            for (int q = 0; q < 4; ++q) {
                const int r4 = r0 + q * NGW; if (r4 < M / 4) {
                const size_t m = (size_t)r4 * 4 + sub;
                float x[8] = {bf_lo(w[q].x), bf_hi(w[q].x), bf_lo(w[q].y), bf_hi(w[q].y), bf_lo(w[q].z), bf_hi(w[q].z), bf_lo(w[q].w), bf_hi(w[q].w)};
                float s = 0.f;
#pragma unroll
                for (int e = 0; e < 8; ++e) s += x[e] * x[e];
                s += shx(s, 1, lane); s += shx(s, 2, lane); s += shx(s, 4, lane); s += shx(s, 8, lane);
                const float rstd = 1.f / sqrtf(s * (1.f / 128.f) + EPS);
                u32x4 o; o.x = pk_bf16(x[0] * rstd * gk[0], x[1] * rstd * gk[1]); o.y = pk_bf16(x[2] * rstd * gk[2], x[3] * rstd * gk[3]);
                o.z = pk_bf16(x[4] * rstd * gk[4], x[5] * rstd * gk[5]); o.w = pk_bf16(x[6] * rstd * gk[6], x[7] * rstd * gk[7]);
                *(GAS u32x4*)(CK + m * 128 + 8 * ch) = o; }
            }
        }
    }
    {
        const int wdw = 2 << (lane >> 4);
        for (int blk = gw; blk < M / 8; blk += NGW) {
            const int m0 = 8 * blk, t0 = m0 & (T - 1);
            u32x4 xr[23];
#pragma unroll
            for (int i = 0; i < 23; ++i) { int mr = m0 - 15 + i; mr = mr < 0 ? 0 : mr; xr[i] = *(const GAS u32x4*)(Z + (size_t)mr * ZA + Z_PI + 8 * lane); }
#pragma unroll
            for (int r = 0; r < 8; ++r) {
                const int t = t0 + r; const int cnt = (t + 1) < wdw ? (t + 1) : wdw;
                float a[8];
#pragma unroll
                for (int e = 0; e < 8; ++e) a[e] = 0.f;
#pragma unroll
                for (int jj = 0; jj < 16; ++jj) { const float mk = jj < cnt ? 1.f : 0.f; const u32x4 w = xr[15 + r - jj];
                    a[0] = fmaf(bf_lo(w.x), mk, a[0]); a[1] = fmaf(bf_hi(w.x), mk, a[1]); a[2] = fmaf(bf_lo(w.y), mk, a[2]); a[3] = fmaf(bf_hi(w.y), mk, a[3]);
                    a[4] = fmaf(bf_lo(w.z), mk, a[4]); a[5] = fmaf(bf_hi(w.z), mk, a[5]); a[6] = fmaf(bf_lo(w.w), mk, a[6]); a[7] = fmaf(bf_hi(w.w), mk, a[7]); }
                const u32x4 sw = xr[15 + r]; const float inv = 1.f / (float)cnt;
                u32x4 o; o.x = pk_bf16(a[0] * inv - bf_lo(sw.x), a[1] * inv - bf_hi(sw.x)); o.y = pk_bf16(a[2] * inv - bf_lo(sw.y), a[3] * inv - bf_hi(sw.y));
                o.z = pk_bf16(a[4] * inv - bf_lo(sw.z), a[5] * inv - bf_hi(sw.z)); o.w = pk_bf16(a[6] * inv - bf_lo(sw.w), a[7] * inv - bf_hi(sw.w));
                *(GAS u32x4*)(PO + (size_t)(m0 + r) * 512 + 8 * lane) = o;
            }
        }
    }
}

__device__ __forceinline__ bool mix_unit(int i, int vcu, int G, int& b, int& qb) {
    const int U = vcu + i * G; if (U >= BATCH * 64) return false;
    const int ii = U >> 8, r = U & 7; b = (U & 255) >> 3; qb = (ii & 1) ? 16 * (ii >> 1) + 15 - r : 16 * (ii >> 1) + r; return true;
}
__device__ __forceinline__ unsigned fkey(float s) { const unsigned u = __float_as_uint(s); return (u & 0x80000000u) ? ~u : (u | 0x80000000u); }
__device__ __forceinline__ float funkey(unsigned k) { return __uint_as_float((k & 0x80000000u) ? (k & 0x7fffffffu) : ~k); }
__device__ __forceinline__ unsigned half_sum(unsigned v, int hh) {
    v += (unsigned)__builtin_amdgcn_update_dpp(0, (int)v, 0xB1, 0xF, 0xF, false);
    v += (unsigned)__builtin_amdgcn_update_dpp(0, (int)v, 0x4E, 0xF, 0xF, false);
    v += (unsigned)__builtin_amdgcn_update_dpp(0, (int)v, 0x141, 0xF, 0xF, false);
    v += (unsigned)__builtin_amdgcn_update_dpp(0, (int)v, 0x140, 0xF, 0xF, false);
    const unsigned a = __builtin_amdgcn_readlane(v, 0) + __builtin_amdgcn_readlane(v, 16), b = __builtin_amdgcn_readlane(v, 32) + __builtin_amdgcn_readlane(v, 48);
    return hh ? b : a;
}
__device__ __forceinline__ float rl_f(float v, int l) { return __uint_as_float((unsigned)__builtin_amdgcn_readlane((int)__float_as_uint(v), l)); }
__device__ __forceinline__ float half_max(float v, int hh) {
    v = fmaxf(v, __builtin_amdgcn_update_dpp(v, v, 0xB1, 0xF, 0xF, false)); v = fmaxf(v, __builtin_amdgcn_update_dpp(v, v, 0x4E, 0xF, 0xF, false));
    v = fmaxf(v, __builtin_amdgcn_update_dpp(v, v, 0x141, 0xF, 0xF, false)); v = fmaxf(v, __builtin_amdgcn_update_dpp(v, v, 0x140, 0xF, 0xF, false));
    const float a = fmaxf(rl_f(v, 0), rl_f(v, 16)), b = fmaxf(rl_f(v, 32), rl_f(v, 48));
    return hh ? b : a;
}
__device__ __forceinline__ float half_min(float v, int hh) {
    v = fminf(v, __builtin_amdgcn_update_dpp(v, v, 0xB1, 0xF, 0xF, false)); v = fminf(v, __builtin_amdgcn_update_dpp(v, v, 0x4E, 0xF, 0xF, false));
    v = fminf(v, __builtin_amdgcn_update_dpp(v, v, 0x141, 0xF, 0xF, false)); v = fminf(v, __builtin_amdgcn_update_dpp(v, v, 0x140, 0xF, 0xF, false));
    const float a = fminf(rl_f(v, 0), rl_f(v, 16)), b = fminf(rl_f(v, 32), rl_f(v, 48));
    return hh ? b : a;
}
__device__ __forceinline__ float sel_cand(float lo, float hi, float glo, float ghi) {
    float c = lo + (hi - lo) * (glo / (glo - ghi));
    if (!(c > lo && c < hi)) c = funkey((fkey(lo) >> 1) + (fkey(hi) >> 1) + (fkey(lo) & fkey(hi) & 1u));
    return c;
}

#if DIAG_SEL
#define DIAG_T(sec) do { if (blockIdx.x == 0 && wid == 0) { const unsigned long long t_ = __builtin_amdgcn_s_memrealtime(); if (lane_in == 0) atomicAdd((unsigned long long*)diag + (sec), t_ - tprev_); tprev_ = t_; } } while (0)
#else
#define DIAG_T(sec) do { } while (0)
#endif
__device__ __forceinline__ void select_unit(LAS unsigned char* kbuf, const bf16* Z, unsigned* MASK, int b, int qb, int wid, int lane_in, unsigned* diag = nullptr) {
#if DIAG_SEL
    unsigned long long tprev_ = __builtin_amdgcn_s_memrealtime();
#endif
    int lane = lane_in; asm volatile("" : "+v"(lane));
    const int col = lane & 31, hh = lane >> 5;
    const size_t mb = (size_t)b * T + 32 * qb + 4 * wid;
    const int tql_r = 2 * (col >> 4) + ((col >> 2) & 1), j_r = 4 * ((col >> 3) & 1) + (col & 3);
    bf16x8 qa[4];
#pragma unroll
    for (int s = 0; s < 4; ++s) qa[s] = *(const GAS bf16x8*)(Z + (mb + tql_r) * ZA + Z_QI + j_r * 64 + 16 * s + 8 * hh);
    float wA[8], wB[8];
    { const u32x4 a = *(const GAS u32x4*)(Z + (mb + hh) * ZA + Z_WI), c = *(const GAS u32x4*)(Z + (mb + 2 + hh) * ZA + Z_WI);
      wA[0] = bf_lo(a.x) * IDX_SCALE; wA[1] = bf_hi(a.x) * IDX_SCALE; wA[2] = bf_lo(a.y) * IDX_SCALE; wA[3] = bf_hi(a.y) * IDX_SCALE;
      wA[4] = bf_lo(a.z) * IDX_SCALE; wA[5] = bf_hi(a.z) * IDX_SCALE; wA[6] = bf_lo(a.w) * IDX_SCALE; wA[7] = bf_hi(a.w) * IDX_SCALE;
      wB[0] = bf_lo(c.x) * IDX_SCALE; wB[1] = bf_hi(c.x) * IDX_SCALE; wB[2] = bf_lo(c.y) * IDX_SCALE; wB[3] = bf_hi(c.y) * IDX_SCALE;
      wB[4] = bf_lo(c.z) * IDX_SCALE; wB[5] = bf_hi(c.z) * IDX_SCALE; wB[6] = bf_lo(c.w) * IDX_SCALE; wB[7] = bf_hi(c.w) * IDX_SCALE; }
    const int dA = 32 * qb + 4 * wid + hh - col, dB = dA + 2;
    float sA[64], sB[64];
    const bf16* ksrc = Z + ((size_t)b * T + 32 * wid + (lane >> 3)) * ZA + Z_KI + 8 * ((lane & 7) ^ ((lane >> 3) & 7));
#define SEL_DMA_CHUNK(c_) do { _Pragma("unroll") for (int j_ = 0; j_ < 4; ++j_) \
        __builtin_amdgcn_global_load_lds((const unsigned*)(ksrc + ((size_t)(c_) * 256 + 8 * j_) * ZA), (LAS unsigned*)(kbuf + ((c_) & 3) * 32768 + (4 * wid + j_) * 1024), 16, 0, 0); } while (0)
    unsigned kof[4];
#pragma unroll
    for (int s = 0; s < 4; ++s) kof[s] = (unsigned)col * 128u + 16u * ((unsigned)(2 * s + hh) ^ ((unsigned)col & 7u));
    asm volatile("s_waitcnt lgkmcnt(0)" ::: "memory"); __builtin_amdgcn_s_barrier(); asm volatile("" ::: "memory");
    SEL_DMA_CHUNK(0); if (8 <= qb) SEL_DMA_CHUNK(1); if (16 <= qb) SEL_DMA_CHUNK(2);
#if DIAG_SEL
    asm volatile("s_waitcnt vmcnt(0)" ::: "memory");
#endif
    DIAG_T(0);
#pragma unroll
    for (int kt = 0; kt < 64; ++kt) { sA[kt] = -INFINITY; sB[kt] = -INFINITY; }
#pragma unroll
    for (int c8 = 0; c8 < 8; ++c8) {
        if (8 * c8 <= qb) {
            asm volatile("s_waitcnt vmcnt(0) lgkmcnt(0)" ::: "memory"); __builtin_amdgcn_s_barrier(); asm volatile("" ::: "memory");
            if (c8 + 3 < 8 && 8 * (c8 + 3) <= qb) SEL_DMA_CHUNK(c8 + 3);
            const LAS unsigned char* cb = kbuf + (c8 & 3) * 32768;
            bf16x8 kb0[4], kb1[4];
#pragma unroll
            for (int s = 0; s < 4; ++s) kb0[s] = *(const LAS bf16x8*)(cb + kof[s]);
#pragma unroll
            for (int k = 0; k < 8; ++k) {
                const int kt = 8 * c8 + k;
                if (k < 7) {
#pragma unroll
                    for (int s = 0; s < 4; ++s) { const bf16x8 ld = *(const LAS bf16x8*)(cb + (k + 1) * 4096 + kof[s]); if (k & 1) kb0[s] = ld; else kb1[s] = ld; }
                }
                f32x16 acc;
#pragma unroll
                for (int i = 0; i < 16; ++i) acc[i] = 0.f;
#pragma unroll
                for (int s = 0; s < 4; ++s) acc = __builtin_amdgcn_mfma_f32_32x32x16_bf16(qa[s], (k & 1) ? kb1[s] : kb0[s], acc, 0, 0, 0);
                float sa = 0.f, sb = 0.f;
#pragma unroll
                for (int j = 0; j < 8; ++j) {
                    const int ra = __float_as_int(acc[j]), rb = __float_as_int(acc[8 + j]);
                    sa = fmaf(__int_as_float(ra > 0 ? ra : 0), wA[j], sa); sb = fmaf(__int_as_float(rb > 0 ? rb : 0), wB[j], sb); }
                sA[kt] = (32 * kt <= dA) ? sa : -INFINITY; sB[kt] = (32 * kt <= dB) ? sb : -INFINITY;
                __builtin_amdgcn_sched_barrier(0);
            }
        }
    }
#undef SEL_DMA_CHUNK
    DIAG_T(1);
    float thrA = -3.0e38f, thrB = -3.0e38f;
    if (qb >= 8) {
        float mnA = sA[0], mnB = sB[0], mxA = sA[0], mxB = sB[0];
#pragma unroll
        for (int k = 1; k < 8; ++k) { mnA = fminf(mnA, sA[k]); mnB = fminf(mnB, sB[k]); }
#pragma unroll
        for (int c8 = 0; c8 < 8; ++c8) {
            if (8 * c8 <= qb) {
#pragma unroll
                for (int k = 0; k < 8; ++k) { mxA = fmaxf(mxA, sA[8 * c8 + k]); mxB = fmaxf(mxB, sB[8 * c8 + k]); }
            }
        }
        float loA = half_min(mnA, hh), loB = half_min(mnB, hh);
        float hiA = funkey(fkey(half_max(mxA, hh)) + 1u), hiB = funkey(fkey(half_max(mxB, hh)) + 1u);
        const float nv = (float)(32 * qb + 16);
        float gloA = nv - 256.5f, ghiA = -256.5f, gloB = gloA, ghiB = ghiA;
        int sdA = 0, sdB = 0;
        unsigned nloA = 0x40000000u, nhiA = 0u, nloB = 0x40000000u, nhiB = 0u;
        int stA = 0, stB = 0;
        bool dnA = false, dnB = false;
#pragma unroll 1
        for (int it = 0; it < 96; ++it) {
            const float cA = sel_cand(loA, hiA, gloA, ghiA), cB = sel_cand(loB, hiB, gloB, ghiB);
            unsigned nA = 0u, nB = 0u;
#pragma unroll
            for (int c8 = 0; c8 < 8; ++c8) {
                if (8 * c8 <= qb) {
                    unsigned ba = 0u, bb = 0u;
#pragma unroll
                    for (int k = 0; k < 8; ++k) { ba = __builtin_amdgcn_alignbit(ba, __float_as_uint(sA[8 * c8 + k] - cA), 31); bb = __builtin_amdgcn_alignbit(bb, __float_as_uint(sB[8 * c8 + k] - cB), 31); }
                    nA += 8u - (unsigned)__builtin_popcount(ba); nB += 8u - (unsigned)__builtin_popcount(bb);
                }
            }
            nA = half_sum(nA, hh); nB = half_sum(nB, hh);
            if (!dnA) {
                const float g = (float)nA - 256.5f; const unsigned w0_ = nloA - nhiA;
                if (nA == 256u) { loA = cA; dnA = true; }
                else if (nA > 256u) { loA = cA; nloA = nA; gloA = g; if (sdA > 0) ghiA *= 0.5f; sdA = 1; }
                else { hiA = cA; nhiA = nA; ghiA = g; if (sdA < 0) gloA *= 0.5f; sdA = -1; }
                stA = (nloA - nhiA == w0_) ? stA + 1 : 0;
                if (!dnA && fkey(hiA) - fkey(loA) <= 1u) dnA = true;
            }
            if (!dnB) {
                const float g = (float)nB - 256.5f; const unsigned w0_ = nloB - nhiB;
                if (nB == 256u) { loB = cB; dnB = true; }
                else if (nB > 256u) { loB = cB; nloB = nB; gloB = g; if (sdB > 0) ghiB *= 0.5f; sdB = 1; }
                else { hiB = cB; nhiB = nB; ghiB = g; if (sdB < 0) gloB *= 0.5f; sdB = -1; }
                stB = (nloB - nhiB == w0_) ? stB + 1 : 0;
                if (!dnB && fkey(hiB) - fkey(loB) <= 1u) dnB = true;
            }
            if (__all(dnA && dnB)) break;
            if (__any((!dnA && stA >= 2) || (!dnB && stB >= 2))) {
                float mnA_ = INFINITY, mxA_ = -INFINITY, mnB_ = INFINITY, mxB_ = -INFINITY;
#pragma unroll
                for (int c8 = 0; c8 < 8; ++c8) {
                    if (8 * c8 <= qb) {
#pragma unroll
                        for (int k = 0; k < 8; ++k) {
                            const float a = sA[8 * c8 + k], b2 = sB[8 * c8 + k];
                            const bool ia = (a >= loA) && (a < hiA), ib = (b2 >= loB) && (b2 < hiB);
                            mnA_ = ia ? fminf(mnA_, a) : mnA_; mxA_ = ia ? fmaxf(mxA_, a) : mxA_;
                            mnB_ = ib ? fminf(mnB_, b2) : mnB_; mxB_ = ib ? fmaxf(mxB_, b2) : mxB_;
                        }
                    }
                }
                mnA_ = half_min(mnA_, hh); mxA_ = half_max(mxA_, hh); mnB_ = half_min(mnB_, hh); mxB_ = half_max(mxB_, hh);
                if (!dnA && stA >= 2) { if (mnA_ == mxA_) { loA = mnA_; dnA = true; } else { loA = mnA_; hiA = funkey(fkey(mxA_) + 1u); stA = 0; } }
                if (!dnB && stB >= 2) { if (mnB_ == mxB_) { loB = mnB_; dnB = true; } else { loB = mnB_; hiB = funkey(fkey(mxB_) + 1u); stB = 0; } }
                if (__all(dnA && dnB)) break;
            }
        }
        thrA = loA; thrB = loB;
    }
    DIAG_T(2);
    unsigned w0 = 0u, w1 = 0u, w2 = 0u, w3 = 0u;
    int lane2 = lane; asm volatile("" : "+v"(lane2));
#pragma unroll
    for (int c8 = 0; c8 < 8; ++c8) {
        if (8 * c8 <= qb) {
#pragma unroll
            for (int k = 0; k < 8; ++k) { const int kt = 8 * c8 + k;
                const unsigned long long bA = __ballot(sA[kt] >= thrA), bB = __ballot(sB[kt] >= thrB);
                const bool mine = (lane2 == kt);
                w0 = mine ? (unsigned)bA : w0; w1 = mine ? (unsigned)(bA >> 32) : w1; w2 = mine ? (unsigned)bB : w2; w3 = mine ? (unsigned)(bB >> 32) : w3; }
        }
    }
    GAS unsigned* mo = (GAS unsigned*)MASK + mb * 64 + lane;
    mo[0] = w0; mo[64] = w1; mo[128] = w2; mo[192] = w3;
#if DIAG_SEL
    asm volatile("s_waitcnt vmcnt(0)" ::: "memory");
#endif
    DIAG_T(3);
}

__device__ __forceinline__ unsigned off_b(unsigned row, unsigned ch) { return 256u * row + 16u * (ch ^ (((row & 3u) << 2) | ((row >> 2) & 3u))); }
__device__ __forceinline__ s16x4 vtr(const LAS unsigned char* p) { typedef short v4i16_t __attribute__((ext_vector_type(4))); return __builtin_bit_cast(s16x4, __builtin_amdgcn_ds_read_tr16_b64_v4i16((LAS v4i16_t*)p)); }
__device__ __forceinline__ void attn_unit(LAS unsigned char* kbuf, const bf16* Z, const bf16* CK, const unsigned* MASK, bf16* OL, const float* gkv, int b, int qb, int wid, int lane_in) {
    int lane = lane_in; asm volatile("" : "+v"(lane));
    const int r32 = lane & 31, hh = lane >> 5, tql = r32 >> 3, head = r32 & 7;
    const size_t m = (size_t)b * T + 32 * qb + 4 * wid + tql;
    const int lr = lane >> 4;
    const bf16* gsrc0 = CK + ((size_t)b * T + 32 * wid + lr) * 128;
    LAS unsigned char* ldst0 = kbuf + (32 * wid) * 256;
#define ATT_DMA_STAGE(st_) do { _Pragma("unroll") for (int i_ = 0; i_ < 8; ++i_) { const int ch_ = (lane & 15) ^ ((lr << 2) | (i_ & 3)); \
        __builtin_amdgcn_global_load_lds((const unsigned*)(gsrc0 + (size_t)(st_) * 256 * 128 + i_ * 4 * 128 + 8 * ch_), (LAS unsigned*)(ldst0 + ((st_) & 1) * 65536 + i_ * 1024), 16, 0, 0); } } while (0)
    asm volatile("s_waitcnt lgkmcnt(0)" ::: "memory"); __builtin_amdgcn_s_barrier(); asm volatile("" ::: "memory");
    ATT_DMA_STAGE(0);
    bf16x8 qf[8];
#pragma unroll
    for (int s = 0; s < 8; ++s) qf[s] = *(const GAS bf16x8*)(Z + m * ZA + Z_QL + head * 128 + 16 * s + 8 * hh);
    const GAS unsigned* mrow = (const GAS unsigned*)MASK + m * 64;
    float mref;
    { float gm = fmaxf(fabsf(gkv[lane]), fabsf(gkv[lane + 64]));
#pragma unroll
      for (int o = 1; o < 64; o <<= 1) gm = fmaxf(gm, shx(gm, o, lane));
      float qn = 0.f;
#pragma unroll
      for (int s = 0; s < 8; ++s)
#pragma unroll
          for (int e = 0; e < 8; ++e) { const float x = __uint_as_float(((unsigned)(unsigned short)qf[s][e]) << 16); qn += x * x; }
      qn += shx(qn, 32, lane);
      mref = fminf(sqrtf(qn) * gm * (1.02f * 11.313708499f), 60.f); }
    f32x16 zero16;
#pragma unroll
    for (int i = 0; i < 16; ++i) zero16[i] = 0.f;
    f32x16 o[4];
#pragma unroll
    for (int dt = 0; dt < 4; ++dt)
#pragma unroll
        for (int i = 0; i < 16; ++i) o[dt][i] = 0.f;
    float lrun = 0.f;
    const int ns = (qb + 8) >> 3;
    const unsigned q4 = (lane & 15) >> 2, p4 = lane & 3, blk = (lane >> 4) & 1;
    const unsigned fh = (unsigned)r32 & 3u, fl = ((unsigned)r32 >> 2) & 3u;
    const unsigned kl0 = 256u * (unsigned)r32 + 16u * (((unsigned)hh ^ fl) & 3u), kl1 = 256u * (unsigned)r32 + 16u * (((2u + (unsigned)hh) ^ fl) & 3u);
#define ATT_KA(s_) ((((s_) & 1) ? kl1 : kl0) + 64u * ((unsigned)((s_) >> 1) ^ fh))
    const unsigned vb = 256u * (4u * hh + q4) + 8u * (p4 & 1u), cl = 2u * blk + (p4 >> 1);
    const unsigned vlo0 = vb + 16u * ((cl ^ (unsigned)hh) & 3u), vlo1 = vb + 2048u + 16u * ((cl ^ (2u + (unsigned)hh)) & 3u);
    u32x4 mw0 = *(const GAS u32x4*)(mrow), mw1 = *(const GAS u32x4*)(mrow + 4);
    for (int st = 0; st < ns; ++st) {
        asm volatile("s_waitcnt vmcnt(0) lgkmcnt(0)" ::: "memory"); __builtin_amdgcn_s_barrier(); asm volatile("" ::: "memory");
        if (st + 1 < ns) ATT_DMA_STAGE(st + 1);
        const LAS unsigned char* sb = kbuf + (st & 1) * 65536;
#define ATT_QK(S_, k_) do { bf16x8 kf_[2]; \
        _Pragma("unroll") for (int s_ = 0; s_ < 8; s_ += 2) { kf_[0] = *(const LAS bf16x8*)(sb + (k_) * 8192 + ATT_KA(s_)); kf_[1] = *(const LAS bf16x8*)(sb + (k_) * 8192 + ATT_KA(s_ + 1)); \
            S_ = __builtin_amdgcn_mfma_f32_32x32x16_bf16(kf_[0], qf[s_], s_ == 0 ? zero16 : S_, 0, 0, 0); S_ = __builtin_amdgcn_mfma_f32_32x32x16_bf16(kf_[1], qf[s_ + 1], S_, 0, 0, 0); } } while (0)
        f32x16 S;
        ATT_QK(S, 0);
#pragma unroll
        for (int k = 0; k < 8; ++k) {
            const LAS unsigned char* kb = sb + k * 8192;
            const unsigned wsh = (k < 4 ? mw0[k & 3] : mw1[k & 3]) >> (4 * hh);
            float ps = 0.f;
#pragma unroll
            for (int i = 0; i < 16; ++i) { const int pos = (i & 3) + 8 * (i >> 2);
                unsigned sel; asm("v_bfe_i32 %0, %1, %2, 1" : "=v"(sel) : "v"(wsh), "n"(pos));
                S[i] = __uint_as_float(__float_as_uint(__builtin_amdgcn_exp2f(S[i] - mref)) & sel); ps += S[i]; }
            lrun += ps;
            bf16x8 pf[2];
#pragma unroll
            for (int s = 0; s < 2; ++s) { u32x4 pw; pw.x = pk_bf16(S[8 * s + 0], S[8 * s + 1]); pw.y = pk_bf16(S[8 * s + 2], S[8 * s + 3]); pw.z = pk_bf16(S[8 * s + 4], S[8 * s + 5]); pw.w = pk_bf16(S[8 * s + 6], S[8 * s + 7]); pf[s] = __builtin_bit_cast(bf16x8, pw); }
            __builtin_amdgcn_sched_barrier(0);
            if (k < 7) ATT_QK(S, k + 1);
#pragma unroll
            for (int dt = 0; dt < 4; ++dt)
#pragma unroll
                for (int s = 0; s < 2; ++s) {
                    const s16x4 lo = vtr(kb + 4096 * s + vlo0 + 64u * ((unsigned)dt ^ q4));
                    const s16x4 hi = vtr(kb + 4096 * s + vlo1 + 64u * ((unsigned)dt ^ q4));
                    const bf16x8 vt = __builtin_shufflevector(lo, hi, 0, 1, 2, 3, 4, 5, 6, 7);
                    o[dt] = __builtin_amdgcn_mfma_f32_32x32x16_bf16(vt, pf[s], o[dt], 0, 0, 0);
                }
            if (k == 3) mw0 = *(const GAS u32x4*)(mrow + 8 * (st + 1));
            if (k == 7) mw1 = *(const GAS u32x4*)(mrow + 8 * (st + 1) + 4);
            __builtin_amdgcn_sched_barrier(0);
        }
#undef ATT_QK
#undef ATT_KA
    }
#undef ATT_DMA_STAGE
    lrun += shx(lrun, 32, lane);
    const float inv = 1.f / lrun;
    bf16* orow = OL + m * 1024 + head * 128;
#pragma unroll
    for (int dt = 0; dt < 4; ++dt)
#pragma unroll
        for (int gp = 0; gp < 2; ++gp) {
            const int g0 = 2 * gp, g1 = 2 * gp + 1;
            const unsigned a0 = pk_bf16(o[dt][4 * g0] * inv, o[dt][4 * g0 + 1] * inv), a1 = pk_bf16(o[dt][4 * g0 + 2] * inv, o[dt][4 * g0 + 3] * inv);
            const unsigned b0 = pk_bf16(o[dt][4 * g1] * inv, o[dt][4 * g1 + 1] * inv), b1 = pk_bf16(o[dt][4 * g1 + 2] * inv, o[dt][4 * g1 + 3] * inv);
            const auto s0 = __builtin_amdgcn_permlane32_swap(a0, b0, false, false), s1 = __builtin_amdgcn_permlane32_swap(a1, b1, false, false);
            u32x4 w; w.x = s0[0]; w.y = s1[0]; w.z = s0[1]; w.w = s1[1];
            *(GAS u32x4*)(orow + 32 * dt + 8 * (hh ? g1 : g0)) = w;
        }
}

__device__ __forceinline__ cargs_t kargs() { cargs_t p = (cargs_t)__builtin_amdgcn_kernarg_segment_ptr(); asm volatile("" : "+s"(p)); return p; }
__device__ __forceinline__ int lane_id() { unsigned z = 0u; asm volatile("" : "+v"(z)); int v = (int)__builtin_amdgcn_mbcnt_hi(~0u, __builtin_amdgcn_mbcnt_lo(~0u, z)); asm volatile("" : "+v"(v)); return v; }
__global__ void __launch_bounds__(NWAVES * 64, 2) fwd(Args args_unused) {
    extern __shared__ __attribute__((aligned(16))) unsigned char lds[];
    Frame F;
    F.lds = (LAS unsigned char*)lds;
    F.MISC = (volatile LAS unsigned*)(F.lds + MISC_OFF);
    F.wave = __builtin_amdgcn_readfirstlane((int)threadIdx.x >> 6);
    F.G = gridDim.x; { const int bx = blockIdx.x; F.vcu = (F.G % 8 == 0) ? (bx % 8) * (F.G / 8) + bx / 8 : bx; }
    F.ctl = (gu32*)(kargs()->ws + WS_CTL);
    for (int u = threadIdx.x; u < (LDS_BYTES - LDSCTL_OFF) / 4; u += NWAVES * 64) ((LAS unsigned*)(F.lds + LDSCTL_OFF))[u] = 0u;
    __syncthreads();
    XcdBarrier bar = xcd_barrier_post((unsigned*)(F.ctl + CW_BAR), F.MISC + 8, (unsigned)F.wave);
#define GRID_BAR() xcd_barrier(bar)
    const int gw = F.vcu * NWAVES + F.wave, NGW = F.G * NWAVES;
#define WSP(off) (kargs()->ws + (off))

    {
        LAS float* scr = (LAS float*)(F.lds + RING_OFF + F.wave * 16384);
        const cargs_t a = kargs(); const int lane = lane_id();
        for (int rep_ = 0; rep_ < (PROBE_DUP == 1 ? 2 : 1); ++rep_) {
        for (int it = sopq(gw); it < NL * I_LAYER; it += NGW) prologue_item(a, it, scr, lane);
        xr_init_phase(a->in[0], (bf16*)(a->ws + WS_XR), (float*)(a->ws + WS_SSQ), sopq(gw), NGW, lane);
        GRID_BAR(); }
    }
#define GEMM_PHASE(EPI_T, A_, B_, N_, K_, E_) do { const pg8::Gemm g_{(const pg8::bf16_t*)(A_), (const pg8::bf16_t*)(B_), M, (N_), (K_)}; pg8::StaticOrder S_; S_.init(M, (N_), F.G, (int)blockIdx.x); \
        pg8::gemm_phase<EPI_T, pg8::StaticOrder, true, true>(F.lds + RING_OFF, g_, S_, (E_), F.wave); } while (0)

#if PROBE_DUP == 9
    for (int xb_ = 0; xb_ < 16; ++xb_) GRID_BAR();
#endif
#define GEMM_PHASE_RS(EPI_T, A_, B_, N_, K_, SSQ_, ...) do { const pg8::Gemm g_{(const pg8::bf16_t*)(A_), (const pg8::bf16_t*)(B_), M, (N_), (K_)}; pg8::StaticOrder S_; S_.init(M, (N_), F.G, (int)blockIdx.x); \
        rstab_fill(F.lds, S_, (SSQ_), F.wave * 64 + lane_id()); \
        const EPI_T E_{__VA_ARGS__, (const LAS float*)(F.lds + RSTAB_OFF), (const LAS unsigned char*)(F.lds + PMAP_OFF)}; \
        pg8::gemm_phase<EPI_T, pg8::StaticOrder, true, true>(F.lds + RING_OFF, g_, S_, E_, F.wave); } while (0)
    for (int fi = 0; fi < 2 * NL; ++fi) {
        const int l = fi >> 1; const bool second = (fi & 1) != 0;
        const size_t wlo = WS_W + (size_t)l * LW;
        for (int rep_ = 0; rep_ < (PROBE_DUP == 5 ? 2 : 1); ++rep_) { const cargs_t a = kargs(); GEMM_PHASE_RS(pg8::EpiSwiglu, a->ws + WS_XR, a->ws + wlo + (second ? O_WGU2 : O_WGU1), 2 * FF, D, (const float*)(a->ws + WS_SSQ), (pg8::bf16_t*)(a->ws + WS_ZA), FF); GRID_BAR(); }
        { const cargs_t a = kargs(); const pg8::EpiResid<1> E{(pg8::bf16_t*)(a->ws + WS_XR), D, (float*)(a->ws + WS_SSQ)}; GEMM_PHASE(pg8::EpiResid<1>, a->ws + WS_ZA, a->ws + wlo + (second ? O_WD2 : O_WD1), D, FF, E); GRID_BAR(); }
        if (!second) {
            for (int rep_ = 0; rep_ < (PROBE_DUP == 6 ? 2 : 1); ++rep_) { const cargs_t a = kargs(); GEMM_PHASE_RS(pg8::EpiPlainBf16, a->ws + WS_XR, a->ws + wlo + O_WIN, ZN, D, (const float*)(a->ws + WS_SSQ), (pg8::bf16_t*)(a->ws + WS_ZA), ZA, (pg8::bf16_t*)(a->ws + WS_ZG), ZGN, ZA / 256); GRID_BAR(); }
            { const cargs_t a = kargs(); const int lane = lane_id();
              for (int rep_ = 0; rep_ < (PROBE_DUP == 2 ? 2 : 1); ++rep_)
              prep_phase((const bf16*)(a->ws + WS_ZA), a->in[7] + (size_t)l * 128, (bf16*)(a->ws + WS_CK), (bf16*)(a->ws + WS_PO), sopq(gw), NGW, lane);
              for (int rep_ = 0; rep_ < (PROBE_DUP == 4 ? 2 : 1); ++rep_) {
              int b, qb; for (int i = 0; mix_unit(i, F.vcu, F.G, b, qb); ++i) select_unit(F.lds + RING_OFF, (const bf16*)(a->ws + WS_ZA), (unsigned*)(a->ws + WS_MASK), b, qb, F.wave, lane, (unsigned*)(F.ctl + 2048)); }
              asm volatile("s_waitcnt vmcnt(0) lgkmcnt(0)" ::: "memory"); __syncthreads();
              GRID_BAR(); }
            for (int rep_ = 0; rep_ < (PROBE_DUP == 3 ? 2 : 1); ++rep_) { const cargs_t a = kargs(); const int tid = F.wave * 64 + lane_id();
              int b, qb; for (int i = 0; mix_unit(i, F.vcu, F.G, b, qb); ++i) attn_unit(F.lds + RING_OFF, (const bf16*)(a->ws + WS_ZA), (const bf16*)(a->ws + WS_CK), (const unsigned*)(a->ws + WS_MASK), (bf16*)(a->ws + WS_OL), a->in[7] + (size_t)l * 128, b, qb, F.wave, tid & 63);
              asm volatile("s_waitcnt vmcnt(0) lgkmcnt(0)" ::: "memory"); __syncthreads();
              GRID_BAR(); }
            { const cargs_t a = kargs(); const pg8::EpiGate<false> E{(pg8::bf16_t*)(a->ws + WS_ZA), D, (const pg8::bf16_t*)(a->ws + WS_ZG), ZGN}; GEMM_PHASE(pg8::EpiGate<false>, a->ws + WS_OL, a->ws + wlo + O_WA, D, D, E); GRID_BAR(); }
            { const cargs_t a = kargs(); const pg8::EpiGate<true> E{(pg8::bf16_t*)(a->ws + WS_ZA), D, (const pg8::bf16_t*)(a->ws + WS_ZG) + 1024, ZGN}; GEMM_PHASE(pg8::EpiGate<true>, a->ws + WS_PO, a->ws + wlo + O_WP, D, 512, E); GRID_BAR(); }
            { const cargs_t a = kargs(); const pg8::EpiResid<0> E{(pg8::bf16_t*)(a->ws + WS_XR), D, (float*)(a->ws + WS_SSQ)}; GEMM_PHASE(pg8::EpiResid<0>, a->ws + WS_ZA, a->ws + wlo + O_WO, D, D, E); GRID_BAR(); }
        }
    }
    {
        const cargs_t a = kargs();
        const bool poison = __hip_atomic_load((gu32*)(F.ctl + CW_BAR + XB_TMO), RLX_AGENT) != 0u;
        final_norm_phase((const bf16*)(a->ws + WS_XR), a->out, a->in[19], sopq(gw), NGW, lane_id(), poison, (const unsigned*)(F.ctl + 2048));
    }
}

extern "C" void kernel_launch(void* const* d_in, const int* in_sizes, int n_in, void* d_out, int out_size, void* d_ws, size_t ws_size, hipStream_t stream) {
    static int grid = 0;
    if (grid == 0) {
        if (n_in != 20 || in_sizes[0] != M * D || out_size != M * D || ws_size < WS_END) { fprintf(stderr, "kernel_launch: unexpected shapes (n_in %d, in0 %d, out %d, ws %zu); nothing launched\n", n_in, n_in > 0 ? in_sizes[0] : -1, out_size, ws_size); grid = -1; return; }
        int dev = 0, cus = 0, per_cu = 0;
        if (hipGetDevice(&dev) != hipSuccess || hipDeviceGetAttribute(&cus, hipDeviceAttributeMultiprocessorCount, dev) != hipSuccess) { fprintf(stderr, "kernel_launch: device query failed\n"); grid = -1; return; }
        if (hipFuncSetAttribute((const void*)fwd, hipFuncAttributeMaxDynamicSharedMemorySize, LDS_BYTES) != hipSuccess) { fprintf(stderr, "kernel_launch: hipFuncSetAttribute failed\n"); grid = -1; return; }
        if (hipOccupancyMaxActiveBlocksPerMultiprocessor(&per_cu, (const void*)fwd, NWAVES * 64, LDS_BYTES) != hipSuccess || per_cu < 1)
            fprintf(stderr, "kernel_launch: note: occupancy query reports %d workgroups per CU\n", per_cu);
        (void)hipGetLastError();
        grid = cus;
    }
    if (grid < 0) return;
    if (hipMemsetAsync((char*)d_ws + WS_CTL, 0, CTL_ZERO_BYTES, stream) != hipSuccess) { fprintf(stderr, "kernel_launch: hipMemsetAsync failed\n"); return; }
    Args a{};
    for (int i = 0; i < 20; ++i) a.in[i] = (const float*)d_in[i];
    a.out = (float*)d_out; a.ws = (unsigned char*)d_ws;
    hipLaunchKernelGGL(fwd, dim3(grid), dim3(NWAVES * 64), LDS_BYTES, stream, a);
    const hipError_t le = hipPeekAtLastError();
    if (le != hipSuccess) fprintf(stderr, "kernel_launch: launch failed: %s\n", hipGetErrorName(le));
}
```

```cpp
#include <hip/hip_runtime.h>
#include <cstdio>
#include <cstdint>
#include <cmath>
namespace pg8 {
#define PG8_LAS __attribute__((address_space(3)))
typedef unsigned short bf16_t;
typedef short bf16x8 __attribute__((ext_vector_type(8)));
typedef float f32x4 __attribute__((ext_vector_type(4)));
typedef unsigned u32x4 __attribute__((ext_vector_type(4)));
constexpr int BM = 256, BK = 64, HALF = 128, HTB = HALF * BK * 2  , STAGE_BYTES = 8 * HTB, NXCD = 8, WGM = 8;

__host__ __device__ __forceinline__ int lds_byte(int r, int c) { const int st = (r >> 4) * 2 + (c >> 5), rr = r & 15, cc = c & 31, ob = rr * 64 + cc * 2; return st * 1024 + (ob ^ (((ob >> 9) & 1) << 5)); }
__host__ __device__ __forceinline__ void stage_rc(int b, int& R, int& C) { const int st = b / 1024, sb = b % 1024, swz = sb ^ (((sb >> 9) & 1) << 5); R = (st >> 1) * 16 + swz / 64; C = (st & 1) * 32 + (swz % 64) / 2; }
__host__ __device__ __forceinline__ int perm32(int rho) { const int n = rho >> 4, i = rho & 15; return 8 * (i >> 2) + 4 * n + (i & 3); }

struct Unit { int pm, pn; };
struct Gemm { const bf16_t* A; const bf16_t* Bt; int M, N, K, lda; };

struct StaticOrder {
    int nM, nN, nwg, G, c;
    __host__ __device__ void init(int M, int N, int G_, int c_) { nM = M / BM; nN = N / BM; nwg = nM * nN; G = G_; c = c_; }
    __host__ __device__ bool next(int i, Unit& u) const {
        const long L = (long)i * G + c; if (L >= nwg) return false;
        int wgid = (int)L; { const int q = nwg / NXCD, r = nwg % NXCD, xcd = wgid % NXCD, off = wgid / NXCD; wgid = (xcd < r ? xcd * (q + 1) : r * (q + 1) + (xcd - r) * q) + off; }
        const int nig = WGM * nN, gid = wgid / nig, fm = gid * WGM, gsz = (nM - fm) < WGM ? (nM - fm) : WGM;
        u.pm = fm + ((wgid % nig) % gsz); u.pn = (wgid % nig) / gsz; return true;
    }
    __device__ __forceinline__ void a_ready(const Unit&) const {}
    __device__ __forceinline__ void done(const Unit&) const {}
};

__device__ __forceinline__ unsigned cvt_pk_bf16(float lo, float hi) { unsigned r; asm volatile("v_cvt_pk_bf16_f32 %0, %1, %2" : "=v"(r) : "v"(lo), "v"(hi)); return r; }
typedef float f32x2 __attribute__((ext_vector_type(2)));
typedef __bf16 bf16x2_t __attribute__((ext_vector_type(2)));
__device__ __forceinline__ unsigned pk_bf16(float lo, float hi) { f32x2 v = {lo, hi}; bf16x2_t b = __builtin_convertvector(v, bf16x2_t); return __builtin_bit_cast(unsigned, b); }
__device__ __forceinline__ float sigm(float g) { return __builtin_amdgcn_rcpf(1.0f + __builtin_amdgcn_exp2f(-1.4426950408889634f * g)); }
__device__ __forceinline__ float bf_lo(unsigned w) { return __uint_as_float(w << 16); }
__device__ __forceinline__ float bf_hi(unsigned w) { return __uint_as_float(w & 0xffff0000u); }

__device__ __forceinline__ float xlane(float v, int m, int lane) { return __int_as_float(__builtin_amdgcn_ds_bpermute((lane ^ m) << 2, __float_as_int(v))); }
struct EpiPlainBf16 {
    static constexpr bool PERM = true, AFTER_DRAIN = false;
    bf16_t* O1; int ld1; bf16_t* O2; int ld2; int nsplit; const PG8_LAS float* rstab; const PG8_LAS unsigned char* pmap;
    __device__ __forceinline__ void operator()(const f32x4 (&acc)[2][2][4][2], const Unit& u, int wr, int wc, int fr, int fq) const {
        const PG8_LAS float* rs = rstab + 256 * (int)pmap[u.pm] + wr * 64 + fr;
        const bool first = u.pn < nsplit; bf16_t* O = first ? O1 : O2; const int ldc = first ? ld1 : ld2;
        const int row0 = u.pm * BM + wr * 64 + fr, col0 = (first ? u.pn : u.pn - nsplit) * BM + wc * 32 + 8 * fq;
#pragma unroll
        for (int ai = 0; ai < 2; ++ai)
#pragma unroll
            for (int m = 0; m < 4; ++m) { bf16_t* rowp = O + (size_t)(row0 + ai * HALF + m * 16) * ldc + col0;
                const float rr = rs[ai * HALF + m * 16];
#pragma unroll
                for (int bj = 0; bj < 2; ++bj) { const f32x4 v0 = acc[ai][bj][m][0] * rr, v1 = acc[ai][bj][m][1] * rr;
                    u32x4 w; w.x = pk_bf16(v0[0], v0[1]); w.y = pk_bf16(v0[2], v0[3]); w.z = pk_bf16(v1[0], v1[1]); w.w = pk_bf16(v1[2], v1[3]);
                    *(u32x4*)(rowp + bj * HALF) = w; } }
    }
};
struct EpiSwiglu {
    static constexpr bool PERM = true, AFTER_DRAIN = false;
    bf16_t* O; int ldc; const PG8_LAS float* rstab; const PG8_LAS unsigned char* pmap;
    __device__ __forceinline__ void operator()(const f32x4 (&acc)[2][2][4][2], const Unit& u, int wr, int wc, int fr, int fq) const {
        const PG8_LAS float* rs = rstab + 256 * (int)pmap[u.pm] + wr * 64 + fr;
        const int row0 = u.pm * BM + wr * 64 + fr, col0 = u.pn * HALF + wc * 32 + 8 * fq;
#pragma unroll
        for (int ai = 0; ai < 2; ++ai)
#pragma unroll
            for (int m = 0; m < 4; ++m) { bf16_t* rowp = O + (size_t)(row0 + ai * HALF + m * 16) * ldc + col0;
                const float rr = rs[ai * HALF + m * 16], kk = -1.4426950408889634f * rr, ir2 = __builtin_amdgcn_rcpf(rr * rr);
                f32x4 h0, h1;
#pragma unroll
                for (int j = 0; j < 4; ++j) { const float a0 = acc[ai][0][m][0][j], a1 = acc[ai][0][m][1][j];
                    h0[j] = (a0 * acc[ai][1][m][0][j]) * __builtin_amdgcn_rcpf(fmaf(__builtin_amdgcn_exp2f(a0 * kk), ir2, ir2));
                    h1[j] = (a1 * acc[ai][1][m][1][j]) * __builtin_amdgcn_rcpf(fmaf(__builtin_amdgcn_exp2f(a1 * kk), ir2, ir2)); }
                u32x4 w; w.x = pk_bf16(h0[0], h0[1]); w.y = pk_bf16(h0[2], h0[3]); w.z = pk_bf16(h1[0], h1[1]); w.w = pk_bf16(h1[2], h1[3]);
                *(u32x4*)rowp = w; }
    }
};
template <int HALFSTEP> struct EpiResid {
    static constexpr bool PERM = true, AFTER_DRAIN = false;
    bf16_t* X; int ldc; float* ssq;
    __device__ __forceinline__ void operator()(const f32x4 (&acc)[2][2][4][2], const Unit& u, int wr, int wc, int fr, int fq) const {
        const int lane = fr + 16 * fq;
        char* Xu = (char*)(X + (size_t)(u.pm * BM + wr * 64) * ldc + u.pn * BM + wc * 32);
        const unsigned lo = (unsigned)(fr * ldc + 8 * fq) * 2u;
        u32x4 b2[2][4][2];
#pragma unroll
        for (int ai = 0; ai < 2; ++ai)
#pragma unroll
            for (int m = 0; m < 4; ++m)
#pragma unroll
                for (int bj = 0; bj < 2; ++bj) b2[ai][m][bj] = *(const u32x4*)(Xu + (size_t)((ai * HALF + m * 16) * ldc + bj * HALF) * 2 + lo);
        char* Su = (char*)(ssq + (size_t)(u.pm * BM + wr * 64) * 16 + 4 * u.pn + wc);
        const unsigned so = (unsigned)fr * 64u;
#pragma unroll
        for (int ai = 0; ai < 2; ++ai) {
#pragma unroll
            for (int m = 0; m < 4; ++m) { float ss = 0.f;
#pragma unroll
                for (int bj = 0; bj < 2; ++bj) { const f32x4 a0 = acc[ai][bj][m][0] * (HALFSTEP ? 0.5f : 1.0f), a1 = acc[ai][bj][m][1] * (HALFSTEP ? 0.5f : 1.0f); const u32x4 bb = b2[ai][m][bj];
                    const float x0 = bf_lo(bb.x) + a0[0], x1 = bf_hi(bb.x) + a0[1], x2 = bf_lo(bb.y) + a0[2], x3 = bf_hi(bb.y) + a0[3];
                    const float x4 = bf_lo(bb.z) + a1[0], x5 = bf_hi(bb.z) + a1[1], x6 = bf_lo(bb.w) + a1[2], x7 = bf_hi(bb.w) + a1[3];
                    u32x4 w; w.x = pk_bf16(x0, x1); w.y = pk_bf16(x2, x3); w.z = pk_bf16(x4, x5); w.w = pk_bf16(x6, x7);
                    *(u32x4*)(Xu + (size_t)((ai * HALF + m * 16) * ldc + bj * HALF) * 2 + lo) = w;
                    ss += ((x0 * x0 + x1 * x1) + (x2 * x2 + x3 * x3)) + ((x4 * x4 + x5 * x5) + (x6 * x6 + x7 * x7)); }
                ss += xlane(ss, 16, lane); ss += xlane(ss, 32, lane);
                if (fq == 0) *(float*)(Su + (size_t)(ai * HALF + m * 16) * 64 + so) = ss; }
            __builtin_amdgcn_sched_barrier(0);
        }
    }
};
template <bool ADD> struct EpiGate {
    static constexpr bool PERM = true, AFTER_DRAIN = false;
    bf16_t* O; int ldc; const bf16_t* G; int ldg;
    __device__ __forceinline__ void operator()(const f32x4 (&acc)[2][2][4][2], const Unit& u, int wr, int wc, int fr, int fq) const {
        const char* Gu = (const char*)(G + (size_t)(u.pm * BM + wr * 64) * ldg + u.pn * BM + wc * 32); const unsigned go = (unsigned)(fr * ldg + 8 * fq) * 2u;
        char* Ou = (char*)(O + (size_t)(u.pm * BM + wr * 64) * ldc + u.pn * BM + wc * 32); const unsigned oo = (unsigned)(fr * ldc + 8 * fq) * 2u;
        u32x4 gq2[2][4][2];
        if (!ADD) {
#pragma unroll
            for (int ai = 0; ai < 2; ++ai)
#pragma unroll
                for (int m = 0; m < 4; ++m)
#pragma unroll
                    for (int bj = 0; bj < 2; ++bj) gq2[ai][m][bj] = *(const u32x4*)(Gu + (size_t)((ai * HALF + m * 16) * ldg + bj * HALF) * 2 + go); }
#pragma unroll
        for (int ai = 0; ai < 2; ++ai) {
            u32x4 oq[4][2];
            if (ADD) {
#pragma unroll
                for (int m = 0; m < 4; ++m)
#pragma unroll
                    for (int bj = 0; bj < 2; ++bj) { gq2[ai][m][bj] = *(const u32x4*)(Gu + (size_t)((ai * HALF + m * 16) * ldg + bj * HALF) * 2 + go);
                        oq[m][bj] = *(const u32x4*)(Ou + (size_t)((ai * HALF + m * 16) * ldc + bj * HALF) * 2 + oo); } }
#pragma unroll
            for (int m = 0; m < 4; ++m) {
#pragma unroll
                for (int bj = 0; bj < 2; ++bj) { const f32x4 v0 = acc[ai][bj][m][0], v1 = acc[ai][bj][m][1]; const u32x4 g = gq2[ai][m][bj];
                    float r0 = sigm(bf_lo(g.x)) * v0[0], r1 = sigm(bf_hi(g.x)) * v0[1], r2 = sigm(bf_lo(g.y)) * v0[2], r3 = sigm(bf_hi(g.y)) * v0[3];
                    float r4 = sigm(bf_lo(g.z)) * v1[0], r5 = sigm(bf_hi(g.z)) * v1[1], r6 = sigm(bf_lo(g.w)) * v1[2], r7 = sigm(bf_hi(g.w)) * v1[3];
                    if (ADD) { const u32x4 o = oq[m][bj]; r0 += bf_lo(o.x); r1 += bf_hi(o.x); r2 += bf_lo(o.y); r3 += bf_hi(o.y); r4 += bf_lo(o.z); r5 += bf_hi(o.z); r6 += bf_lo(o.w); r7 += bf_hi(o.w); }
                    u32x4 w; w.x = pk_bf16(r0, r1); w.y = pk_bf16(r2, r3); w.z = pk_bf16(r4, r5); w.w = pk_bf16(r6, r7);
                    *(u32x4*)(Ou + (size_t)((ai * HALF + m * 16) * ldc + bj * HALF) * 2 + oo) = w; } }
            __builtin_amdgcn_sched_barrier(0);
        }
    }
};
template <class Epi, class Sched, bool ALIGN_EPI = false, bool SP2 = false>
__device__ __forceinline__ void gemm_phase(PG8_LAS unsigned char* lds, const Gemm g, const Sched S, const Epi E, const int wave_id) {
    unsigned z_o = 0u; asm volatile("" : "+v"(z_o)); int tid_o = wave_id * 64 + (int)__builtin_amdgcn_mbcnt_hi(~0u, __builtin_amdgcn_mbcnt_lo(~0u, z_o)); asm volatile("" : "+v"(tid_o));
    const int tid = tid_o, wid = __builtin_amdgcn_readfirstlane(tid >> 6), lane = tid & 63, wr = wid >> 2, wc = wid & 3, fr = lane & 15, fq = lane >> 4;
    const int K = g.K, nt = K / BK;
    unsigned voffA[2], voffB[2];
#pragma unroll
    for (int i = 0; i < 2; ++i) { int R, C; stage_rc(tid * 16 + i * 8192, R, C); const int Rb = Epi::PERM ? ((R & ~31) + perm32(R & 31)) : R;
        voffA[i] = (unsigned)(R * g.lda + C) * 2u; voffB[i] = (unsigned)(Rb * K + C) * 2u; }
    const size_t kstep = (size_t)(BK * 2);
    const size_t hstepA = (size_t)HALF * g.lda * 2, hstepB = (size_t)HALF * K * 2;
    const size_t tstepA = 2 * hstepA, tstepB = 2 * hstepB;
    const unsigned ldsw = (unsigned)wid * 1024u;
    const int aoff = lds_byte(wr * 64 + fr, fq * 8), boff = lds_byte(wc * 32 + fr, fq * 8);
#define PG8_SA(b, h) (((b) * 2 + (h)) * HTB)
#define PG8_SB(b, h) ((4 + (b) * 2 + (h)) * HTB)
#define PG8_STAGE(bufoff, gbase, voff) do { _Pragma("unroll") for (int _i = 0; _i < 2; ++_i) \
        __builtin_amdgcn_global_load_lds((const unsigned*)((const char*)(gbase) + (voff)[_i]), (PG8_LAS unsigned*)(lds + (bufoff) + ldsw + _i * 8192), 16, 0, 0); } while (0)
#define PG8_LDA(dst, b, h) do { _Pragma("unroll") for (int m = 0; m < 4; ++m) _Pragma("unroll") for (int k = 0; k < 2; ++k) dst[m][k] = *(const PG8_LAS bf16x8*)(lds + PG8_SA(b, h) + aoff + m * 2048 + k * 1024); } while (0)
#define PG8_LDB(dst, b, h) do { _Pragma("unroll") for (int n = 0; n < 2; ++n) _Pragma("unroll") for (int k = 0; k < 2; ++k) dst[n][k] = *(const PG8_LAS bf16x8*)(lds + PG8_SB(b, h) + boff + n * 2048 + k * 1024); } while (0)
#define PG8_MMA(ai, bj, At, Bt) do { __builtin_amdgcn_s_setprio(1); _Pragma("unroll") for (int m = 0; m < 4; ++m) _Pragma("unroll") for (int n = 0; n < 2; ++n) _Pragma("unroll") for (int k = 0; k < 2; ++k) \
        acc[ai][bj][m][n] = __builtin_amdgcn_mfma_f32_16x16x32_bf16(Bt[n][k], At[m][k], acc[ai][bj][m][n], 0, 0, 0); __builtin_amdgcn_s_setprio(0); } while (0)
#define PG8_WAIT_V(n) asm volatile("s_waitcnt vmcnt(" #n ")" ::: "memory")
#define PG8_WAIT_L(n) asm volatile("s_waitcnt lgkmcnt(" #n ")" ::: "memory")
#define PG8_BAR __builtin_amdgcn_s_barrier()
#define PG8_SCHED __builtin_amdgcn_sched_barrier(0)
    Unit cur, nxt; int ui = 0;
    if (!S.next(0, cur)) return;
    f32x4 acc[2][2][4][2];
#pragma unroll
    for (int a = 0; a < 2; ++a)
#pragma unroll
        for (int b = 0; b < 2; ++b)
#pragma unroll
            for (int m = 0; m < 4; ++m)
#pragma unroll
                for (int n = 0; n < 2; ++n) acc[a][b][m][n] = (f32x4){0.f, 0.f, 0.f, 0.f};
    bf16x8 At[4][2], B0[2][2], B1[2][2];
    const char* cA = (const char*)g.A + (size_t)cur.pm * tstepA; const char* cB = (const char*)g.Bt + (size_t)cur.pn * tstepB;
    S.a_ready(cur);
    if constexpr (SP2) {
        PG8_STAGE(PG8_SB(0, 0), cB, voffB); PG8_STAGE(PG8_SB(0, 1), cB + hstepB, voffB); PG8_STAGE(PG8_SA(0, 0), cA, voffA); PG8_STAGE(PG8_SA(0, 1), cA + hstepA, voffA);
        if (wr == 1) PG8_BAR;
        PG8_WAIT_V(2); PG8_BAR;
        PG8_STAGE(PG8_SB(1, 0), cB + kstep, voffB); PG8_STAGE(PG8_SA(1, 0), cA + kstep, voffA); PG8_STAGE(PG8_SB(1, 1), cB + hstepB + kstep, voffB);
        PG8_WAIT_V(6); PG8_BAR;
    } else {
        PG8_STAGE(PG8_SB(0, 0), cB, voffB); PG8_STAGE(PG8_SA(0, 0), cA, voffA); PG8_STAGE(PG8_SB(0, 1), cB + hstepB, voffB); PG8_STAGE(PG8_SA(0, 1), cA + hstepA, voffA);
        if (wr == 1) PG8_BAR;
        PG8_WAIT_V(4); PG8_BAR;
        PG8_STAGE(PG8_SB(1, 0), cB + kstep, voffB); PG8_STAGE(PG8_SA(1, 0), cA + kstep, voffA); PG8_STAGE(PG8_SB(1, 1), cB + hstepB + kstep, voffB);
        PG8_WAIT_V(6); PG8_BAR;
    }
    for (;;) {
        const bool has_next = S.next(ui + 1, nxt);
        const char* nA = has_next ? (const char*)g.A + (size_t)nxt.pm * tstepA : cA; const char* nB = has_next ? (const char*)g.Bt + (size_t)nxt.pn * tstepB : cB;
        for (int t = 0; t < nt; t += 2) {
            const bool last = (t == nt - 2);
            const char* a1 = cA + (size_t)(t + 1) * kstep;
            const char* a2 = last ? nA : cA + (size_t)(t + 2) * kstep; const char* b2 = last ? nB : cB + (size_t)(t + 2) * kstep;
            const char* a3 = a2 + kstep; const char* b3 = b2 + kstep;
            if (last && has_next) S.a_ready(nxt);
            if constexpr (SP2) {
            PG8_LDB(B0, 0, 0); PG8_LDB(B1, 0, 1); PG8_SCHED; PG8_LDA(At, 0, 0); PG8_STAGE(PG8_SA(1, 1), a1 + hstepA, voffA);
            PG8_WAIT_V(8); PG8_WAIT_L(0); PG8_BAR; PG8_MMA(0, 0, At, B0); PG8_MMA(0, 1, At, B1); PG8_BAR; PG8_SCHED;
            PG8_LDA(At, 0, 1); PG8_STAGE(PG8_SB(0, 0), b2, voffB); PG8_STAGE(PG8_SB(0, 1), b2 + hstepB, voffB); PG8_STAGE(PG8_SA(0, 0), a2, voffA);
            PG8_WAIT_V(8); PG8_WAIT_L(0); PG8_BAR; PG8_MMA(1, 0, At, B0); PG8_MMA(1, 1, At, B1); PG8_BAR; PG8_SCHED;
            PG8_LDB(B0, 1, 0); PG8_LDB(B1, 1, 1); PG8_SCHED; PG8_LDA(At, 1, 0); PG8_STAGE(PG8_SA(0, 1), a2 + hstepA, voffA);
            PG8_WAIT_V(8); PG8_WAIT_L(0); PG8_BAR; PG8_MMA(0, 0, At, B0); PG8_MMA(0, 1, At, B1); PG8_BAR; PG8_SCHED;
            PG8_LDA(At, 1, 1); PG8_STAGE(PG8_SB(1, 0), b3, voffB); PG8_STAGE(PG8_SB(1, 1), b3 + hstepB, voffB); PG8_STAGE(PG8_SA(1, 0), a3, voffA);
            PG8_WAIT_V(8); PG8_WAIT_L(0); PG8_BAR; PG8_MMA(1, 0, At, B0); PG8_MMA(1, 1, At, B1); PG8_BAR; PG8_SCHED;
            } else {
            PG8_LDB(B0, 0, 0); PG8_SCHED; PG8_LDA(At, 0, 0); PG8_STAGE(PG8_SA(1, 1), a1 + hstepA, voffA);
            PG8_WAIT_L(8); PG8_BAR; PG8_WAIT_L(0); PG8_MMA(0, 0, At, B0); PG8_BAR; PG8_SCHED;
            PG8_LDB(B1, 0, 1); PG8_STAGE(PG8_SB(0, 0), b2, voffB);
            PG8_BAR; PG8_WAIT_L(0); PG8_MMA(0, 1, At, B1); PG8_BAR;
            PG8_LDA(At, 0, 1); PG8_STAGE(PG8_SA(0, 0), a2, voffA);
            PG8_BAR; PG8_WAIT_L(0); PG8_MMA(1, 0, At, B0); PG8_BAR; PG8_SCHED;
            PG8_STAGE(PG8_SB(0, 1), b2 + hstepB, voffB);
            PG8_WAIT_V(6); PG8_BAR; PG8_MMA(1, 1, At, B1); PG8_BAR;
            PG8_LDB(B0, 1, 0); PG8_SCHED; PG8_LDA(At, 1, 0); PG8_STAGE(PG8_SA(0, 1), a2 + hstepA, voffA);
            PG8_WAIT_L(8); PG8_BAR; PG8_WAIT_L(0); PG8_MMA(0, 0, At, B0); PG8_BAR; PG8_SCHED;
            PG8_LDB(B1, 1, 1); PG8_STAGE(PG8_SB(1, 0), b3, voffB);
            PG8_BAR; PG8_WAIT_L(0); PG8_MMA(0, 1, At, B1); PG8_BAR;
            PG8_LDA(At, 1, 1); PG8_STAGE(PG8_SA(1, 0), a3, voffA);
            PG8_BAR; PG8_WAIT_L(0); PG8_MMA(1, 0, At, B0); PG8_BAR; PG8_SCHED;
            PG8_STAGE(PG8_SB(1, 1), b3 + hstepB, voffB);
            PG8_WAIT_V(6); PG8_BAR; PG8_MMA(1, 1, At, B1); PG8_BAR;
            }
        }
        if constexpr (ALIGN_EPI) { if (wr == 0) PG8_BAR; }
        if constexpr (!Epi::AFTER_DRAIN) { E(acc, cur, wr, wc, fr, fq); S.done(cur); }
        if (!has_next) break;
#pragma unroll
        for (int a = 0; a < 2; ++a)
#pragma unroll
            for (int b = 0; b < 2; ++b)
#pragma unroll
                for (int m = 0; m < 4; ++m)
#pragma unroll
                    for (int n = 0; n < 2; ++n) acc[a][b][m][n] = (f32x4){0.f, 0.f, 0.f, 0.f};
        cur = nxt; cA = nA; cB = nB; ++ui;
        if constexpr (ALIGN_EPI) { if (wr == 1) PG8_BAR; }
    }
    PG8_WAIT_V(0);
    if constexpr (!ALIGN_EPI) { if (wr == 0) PG8_BAR; }
    PG8_BAR;
    if constexpr (Epi::AFTER_DRAIN) { E.fused(acc, cur, wr, wc, fr, fq, lds, wid, lane); S.done(cur); }
#undef PG8_SA
#undef PG8_SB
#undef PG8_STAGE
#undef PG8_LDA
#undef PG8_LDB
#undef PG8_MMA
#undef PG8_WAIT_V
#undef PG8_WAIT_L
#undef PG8_BAR
#undef PG8_SCHED
}
}
#define GAS __attribute__((address_space(1)))
#define LAS __attribute__((address_space(3)))
typedef unsigned short bf16;
typedef unsigned v4u __attribute__((ext_vector_type(4)));
typedef float f32x4 __attribute__((ext_vector_type(4)));
typedef short bf16x8 __attribute__((ext_vector_type(8)));
typedef GAS unsigned gu32;
typedef GAS unsigned long long gu64;
#define RLX_AGENT __ATOMIC_RELAXED, __HIP_MEMORY_SCOPE_AGENT
#define LDS_WAIT() asm volatile("s_waitcnt lgkmcnt(0)" ::: "memory")
#define VM_WAIT() asm volatile("s_waitcnt vmcnt(0)" ::: "memory")
__device__ __forceinline__ unsigned long long rt() { return __builtin_amdgcn_s_memrealtime(); }
__device__ __forceinline__ unsigned f2bf(float f) { unsigned u = __builtin_bit_cast(unsigned, f); return (u + 0x7fffu + ((u >> 16) & 1u)) >> 16; }
__device__ __forceinline__ unsigned pk2(float lo, float hi) { return f2bf(lo) | (f2bf(hi) << 16); }

#define XB_TMO      128
#define XB_XCNT(j)  (256  + 64 * (j))
#define XB_XSUB(j)  (1280 + 64 * (j))
#define XB_XGEN(j)  (2304 + 64 * (j))
#define XB_TOP      3328
#define XB_TOPGEN   3392
#define XCD_BAR_WORDS 3456
#define XB_SPIN_CAP (1u << 18)

__device__ __forceinline__ unsigned xb_ld(unsigned* p)              { return __hip_atomic_load(p, __ATOMIC_RELAXED, __HIP_MEMORY_SCOPE_AGENT); }
__device__ __forceinline__ unsigned xb_add(unsigned* p, unsigned v) { return __hip_atomic_fetch_add(p, v, __ATOMIC_RELAXED, __HIP_MEMORY_SCOPE_AGENT); }
__device__ __forceinline__ unsigned xb_xcc_id() { return (unsigned)__builtin_amdgcn_s_getreg((3 << 11) | 20) & 0xFu; }
#define XB_SPIN(cond, bar) do { unsigned _sp = 0; while (cond) { __builtin_amdgcn_s_sleep(1); \
    if ((++_sp & 255u) == 0u) { if (xb_ld(&(bar)[XB_TMO])) break; if (_sp > XB_SPIN_CAP) { atomicAdd(&(bar)[XB_TMO], 1u); break; } } } } while (0)

struct XcdBarrier {
    unsigned wv;
    unsigned* bar; unsigned x;
    volatile LAS unsigned* st;
};

__device__ __forceinline__ bool xb_thread0(unsigned wv) { unsigned z = 0u; asm volatile("" : "+v"(z)); return wv == 0u && __builtin_amdgcn_mbcnt_hi(~0u, __builtin_amdgcn_mbcnt_lo(~0u, z)) == 0u; }
__device__ __forceinline__ XcdBarrier xcd_barrier_post(unsigned* bar, volatile LAS unsigned* st, unsigned wv) {
    XcdBarrier b; b.wv = wv; b.bar = bar; b.x = (unsigned)__builtin_amdgcn_readfirstlane((int)xb_xcc_id());     b.st = st;
    if (xb_thread0(wv)) (void)xb_add(&bar[XB_XCNT(b.x)], 1u);
    return b;
}
__device__ __forceinline__ void xcd_barrier_complete(unsigned* bar, unsigned x, unsigned& nloc, unsigned& nx) {
    const unsigned G = gridDim.x * gridDim.y * gridDim.z;
    unsigned sum, cnt, mine, sp = 0u;
    for (;;) {
        sum = 0u; cnt = 0u; mine = 0u;
#pragma unroll
        for (unsigned j = 0; j < 16; ++j) { const unsigned c = xb_ld(&bar[XB_XCNT(j)]); sum += c; cnt += (c > 0u) ? 1u : 0u; mine = (j == x) ? c : mine; }
        if (sum == G) break;
        __builtin_amdgcn_s_sleep(1);
        if ((++sp & 255u) == 0u) { if (xb_ld(&bar[XB_TMO])) break; if (sp > XB_SPIN_CAP) { atomicAdd(&bar[XB_TMO], 1u); break; } }
    }
    nloc = mine > 0u ? mine : 1u; nx = cnt > 0u ? cnt : 1u;
}

__device__ __forceinline__ void xcd_barrier(const XcdBarrier& b) {
    asm volatile("s_waitcnt vmcnt(0)" ::: "memory");
    __syncthreads();
    if (xb_thread0(b.wv)) {
        unsigned* bar = b.bar;
        __builtin_amdgcn_s_waitcnt(0);
        unsigned nloc = b.st[0], nx = b.st[1];
        if (nloc == 0u) { xcd_barrier_complete(bar, b.x, nloc, nx); b.st[0] = nloc; b.st[1] = nx; }
        const unsigned old = xb_add(&bar[XB_XSUB(b.x)], 1u);
        const unsigned gen = old / nloc;
        if (old + 1u == (gen + 1u) * nloc) {
            __builtin_amdgcn_fence(__ATOMIC_RELEASE, "agent");
            asm volatile("s_waitcnt vmcnt(0)" ::: "memory");
            const unsigned og = xb_add(&bar[XB_TOP], 1u);
            const unsigned tg = og / nx;
            if (og + 1u == (tg + 1u) * nx) xb_add(&bar[XB_TOPGEN], 1u);
            else XB_SPIN(xb_ld(&bar[XB_TOPGEN]) == tg, bar);
            __builtin_amdgcn_fence(__ATOMIC_ACQUIRE, "agent");
            xb_add(&bar[XB_XGEN(b.x)], 1u);
            asm volatile("s_waitcnt vmcnt(0)" ::: "memory");
        } else {
            XB_SPIN(xb_ld(&bar[XB_XGEN(b.x)]) == gen, bar);
            __builtin_amdgcn_fence(__ATOMIC_ACQUIRE, "agent");
            asm volatile("s_waitcnt vmcnt(0)" ::: "memory");
        }
    }
    __syncthreads();
}

#define GB_XCNT(j, g) (64 * ((j) * 8 + (g)))
#define GB_XSUB(j, g) (8192 + 64 * ((j) * 8 + (g)))
#define GB_XGEN(j, g) (16384 + 64 * ((j) * 8 + (g)))
#define GB_TOP(g)     (24576 + 64 * (g))
#define GB_TOPGEN(g)  (25088 + 64 * (g))
#define GRP_BAR_WORDS 25600
struct GrpBarrier { unsigned wv; unsigned* bar; unsigned* gb; unsigned x, g, gsize; volatile LAS unsigned* st; };
__device__ __forceinline__ GrpBarrier grp_barrier_post(unsigned* bar, unsigned* gb, volatile LAS unsigned* st, unsigned wv, unsigned g, unsigned gsize) {
    GrpBarrier b; b.wv = wv; b.bar = bar; b.gb = gb; b.x = (unsigned)__builtin_amdgcn_readfirstlane((int)xb_xcc_id()); b.g = g; b.gsize = gsize; b.st = st;
    if (xb_thread0(wv)) (void)xb_add(&gb[GB_XCNT(b.x, g)], 1u);
    return b;
}
__device__ __forceinline__ void grp_barrier_complete(const GrpBarrier& b, unsigned& nloc, unsigned& nx) {
    unsigned sum, cnt, mine, sp = 0u;
    for (;;) {
        sum = 0u; cnt = 0u; mine = 0u;
#pragma unroll
        for (unsigned j = 0; j < 16; ++j) { const unsigned c = xb_ld(&b.gb[GB_XCNT(j, b.g)]); sum += c; cnt += (c > 0u) ? 1u : 0u; mine = (j == b.x) ? c : mine; }
        if (sum == b.gsize) break;
        __builtin_amdgcn_s_sleep(1);
        if ((++sp & 255u) == 0u) { if (xb_ld(&b.bar[XB_TMO])) break; if (sp > XB_SPIN_CAP) { atomicAdd(&b.bar[XB_TMO], 1u); break; } }
    }
    nloc = mine > 0u ? mine : 1u; nx = cnt > 0u ? cnt : 1u;
}
__device__ __forceinline__ void grp_barrier(const GrpBarrier& b) {
    asm volatile("s_waitcnt vmcnt(0)" ::: "memory");
    __syncthreads();
    if (xb_thread0(b.wv)) {
        unsigned* gb = b.gb; unsigned* bar = b.bar;
        __builtin_amdgcn_s_waitcnt(0);
        unsigned nloc = b.st[0], nx = b.st[1];
        if (nloc == 0u) { grp_barrier_complete(b, nloc, nx); b.st[0] = nloc; b.st[1] = nx; }
        const unsigned old = xb_add(&gb[GB_XSUB(b.x, b.g)], 1u);
        const unsigned gen = old / nloc;
        if (old + 1u == (gen + 1u) * nloc) {
            __builtin_amdgcn_fence(__ATOMIC_RELEASE, "agent");
            asm volatile("s_waitcnt vmcnt(0)" ::: "memory");
            const unsigned og = xb_add(&gb[GB_TOP(b.g)], 1u);
            const unsigned tg = og / nx;
            if (og + 1u == (tg + 1u) * nx) xb_add(&gb[GB_TOPGEN(b.g)], 1u);
            else XB_SPIN(xb_ld(&gb[GB_TOPGEN(b.g)]) == tg, bar);
            __builtin_amdgcn_fence(__ATOMIC_ACQUIRE, "agent");
            xb_add(&gb[GB_XGEN(b.x, b.g)], 1u);
            asm volatile("s_waitcnt vmcnt(0)" ::: "memory");
        } else {
            XB_SPIN(xb_ld(&gb[GB_XGEN(b.x, b.g)]) == gen, bar);
            __builtin_amdgcn_fence(__ATOMIC_ACQUIRE, "agent");
            asm volatile("s_waitcnt vmcnt(0)" ::: "memory");
        }
    }
    __syncthreads();
}
constexpr int NWAVES = 8;
constexpr int BATCH = 32, T = 2048, D = 1024, FF = 2816, NL = 2;
constexpr int M = BATCH * T;
constexpr int DIN = 3784;
constexpr int ZN = 3840;
constexpr int ZP = ZN;
constexpr int ZA = 1792, ZGN = 2048;
constexpr int Z_Q = 0, Z_QI = 512, Z_PI = 1024, Z_CKV = 1536, Z_KI = 1664, Z_WI = 1728;
constexpr int R_GA = 1792, R_GB = 2816;
constexpr int S_Q = 0, S_CKV = 512, S_QI = 640, S_KI = 1152, S_WI = 1216, S_PI = 1224, S_GA = 1736, S_GB = 2760;
constexpr float EPS = 1e-6f;
constexpr float IDX_SCALE = 0.044194173824159216f;
constexpr float QSCALE = 0.125f * 1.4426950408889634f;

constexpr size_t MiB = 1u << 20;
constexpr size_t WS_CTL = 0, CTL_ZERO_BYTES = 1 * MiB;
constexpr size_t WS_W = 1 * MiB, LW = 46 * MiB + MiB / 2;
constexpr size_t O_WGU1 = 0, O_WD1 = 11 * MiB, O_WIN = 16 * MiB + MiB / 2, O_WUK = 24 * MiB  , O_WUV = 24 * MiB + MiB / 4, O_WA = 25 * MiB, O_WP = 27 * MiB, O_WO = 28 * MiB, O_WGU2 = 30 * MiB, O_WD2 = 41 * MiB;
constexpr size_t WS_XR = 96 * MiB;
constexpr size_t WS_ZA = 224 * MiB;
constexpr size_t WS_OL = 768 * MiB;
constexpr size_t WS_PO = 896 * MiB;
constexpr size_t WS_CK = 960 * MiB;
constexpr size_t WS_MASK = 976 * MiB;
constexpr size_t WS_SSQ = 992 * MiB;
constexpr size_t WS_END = 996 * MiB;
static_assert(WS_W + NL * LW <= WS_XR && WS_XR + (size_t)M * D * 2 <= WS_ZA && WS_ZA + (size_t)M * ZP * 2 <= WS_OL && FF <= ZP && ZA + ZGN == ZP, "d_ws map");
static_assert(O_WD2 + (size_t)D * FF * 2 <= LW && O_WIN + (size_t)ZN * D * 2 <= O_WUK, "weight map");
constexpr int CW_TMO = 0, CW_CODE = 1, CW_BAR = 4096, CW_GBAR = 8192;

constexpr int RING_OFF = 0, RING_BYTES = 131072;
constexpr int LDSCTL_OFF = RING_BYTES, MISC_OFF = LDSCTL_OFF + 320;
constexpr int RSTAB_OFF = LDSCTL_OFF + 512, RSTAB_SLOTS = 8, PMAP_OFF = RSTAB_OFF + RSTAB_SLOTS * 1024, PLIST_OFF = PMAP_OFF + 256;
constexpr int LDS_BYTES = 147456;

struct Args { const float* in[20]; float* out; unsigned char* ws; };
typedef const Args __attribute__((address_space(4)))* cargs_t;
struct Frame {
    LAS unsigned char* lds;
    volatile LAS unsigned* MISC;
    gu32* ctl;
    int wave;
    int vcu, G;
};

typedef unsigned u32x4 __attribute__((ext_vector_type(4)));
typedef unsigned u32x2 __attribute__((ext_vector_type(2)));
typedef float f32x16 __attribute__((ext_vector_type(16)));
typedef short s16x4 __attribute__((ext_vector_type(4)));
using pg8::pk_bf16; using pg8::bf_lo; using pg8::bf_hi;

__device__ __forceinline__ float shx(float v, int m, int lane) { return __int_as_float(__builtin_amdgcn_ds_bpermute((lane ^ m) << 2, __float_as_int(v))); }
__device__ __forceinline__ float wave_sum(float v, int lane) {
#pragma unroll
    for (int o = 1; o < 64; o <<= 1) v += shx(v, o, lane);
    return v;
}
__device__ __forceinline__ int sopq(int v) { asm volatile("" : "+s"(v)); return v; }

__device__ __forceinline__ void tr_item(const float* W, int ldw, int c0, int k0, bf16* WT, int Kd, int drow0, LAS float* scr, int lane, const float* gk = nullptr) {
    const int kr = lane >> 3, c4 = 4 * (lane & 7);
    f32x4 t[16]; float gg[16];
#pragma unroll
    for (int i = 0; i < 16; ++i) t[i] = *(const GAS f32x4*)(W + (size_t)(k0 + 8 * i + kr) * ldw + c0 + c4);
#pragma unroll
    for (int i = 0; i < 16; ++i) gg[i] = gk ? gk[k0 + 8 * i + kr] : 1.0f;
#pragma unroll
    for (int h = 0; h < 2; ++h) {
#pragma unroll
        for (int i = 0; i < 8; ++i) { LAS float* d = scr + (8 * i + kr) * 33 + c4; const f32x4 v = t[8 * h + i]; const float g = gg[8 * h + i]; d[0] = v.x * g; d[1] = v.y * g; d[2] = v.z * g; d[3] = v.w * g; }
        LDS_WAIT(); asm volatile("" ::: "memory");
        const int c = lane & 7;
#pragma unroll
        for (int j = 0; j < 4; ++j) { const int n = (lane >> 3) + 8 * j; const LAS float* sp = scr + (8 * c) * 33 + n;
            v4u o; o.x = pk_bf16(sp[0 * 33], sp[1 * 33]); o.y = pk_bf16(sp[2 * 33], sp[3 * 33]); o.z = pk_bf16(sp[4 * 33], sp[5 * 33]); o.w = pk_bf16(sp[6 * 33], sp[7 * 33]);
            *(GAS v4u*)(WT + (size_t)(drow0 + n) * Kd + k0 + 64 * h + 8 * c) = o; }
        LDS_WAIT(); asm volatile("" ::: "memory");
    }
}
constexpr int I_GU = 8 * 88, I_DN = 22 * 32, I_WO = 8 * 32, I_WIN = 8 * 119, I_ZERO = 1, I_QL = 128  , I_WA = 4 * 32   + 128  , I_WP = 1024;
constexpr int I_LAYER = 6 * I_GU + I_WO + I_WIN + I_ZERO + I_QL + I_WA + I_WP;
static_assert(I_GU == I_DN, "item counts");

__device__ __forceinline__ void prologue_item(cargs_t ka, int it, LAS float* scr, int lane) {
    const float* const __attribute__((address_space(4)))* in = ka->in; unsigned char* ws = ka->ws;
    int l, r;
    if (it < NL * I_WP) { l = it / I_WP; r = I_WA + (it - l * I_WP); }
    else { const int it2 = it - NL * I_WP; l = it2 / (I_LAYER - I_WP); r = it2 - l * (I_LAYER - I_WP); if (r >= I_WA) r += I_WP; }
    unsigned char* wl = ws + WS_W + (size_t)l * LW;
    if (r < I_WA) {
        if (r < 128) { const int kb = r / 32, nb = r % 32; tr_item(in[12] + (size_t)l * 512 * 1024, 1024, 32 * nb, 128 * kb, (bf16*)(wl + O_WA), 512, 32 * nb, scr, lane); return; }
        { const int q = r - 128, head = q >> 4, rt = (q >> 3) & 1, ks = q & 7, rr = lane & 31, h = lane >> 5;
          const float* wuv = in[9] + (size_t)l * 128 * 8 * 64 + (size_t)head * 64 + 32 * rt + rr;
          float v[8];
#pragma unroll
          for (int jj = 0; jj < 8; ++jj) v[jj] = wuv[(size_t)(16 * ks + 8 * h + jj) * 8 * 64];
          v4u o; o.x = pk_bf16(v[0], v[1]); o.y = pk_bf16(v[2], v[3]); o.z = pk_bf16(v[4], v[5]); o.w = pk_bf16(v[6], v[7]);
          *(GAS v4u*)((bf16*)(wl + O_WUV) + ((((size_t)(head * 2 + rt) * 8 + ks) * 32 + rr) * 2 + h) * 8) = o; } return; }
    r -= I_WA;
    if (r < I_WP) {
        const int g = r >> 8, cb = (r >> 4) & 15, ib = r & 15, n = 64 * ib + lane;
        const float* pw = in[10] + (size_t)l * 4 * 128 * 128; const float* ps = in[11] + (size_t)l * 512; const float* wbp = in[13] + (size_t)l * 512 * 1024;
        float a[8];
#pragma unroll
        for (int j = 0; j < 8; ++j) a[j] = 0.f;
#pragma unroll 32
        for (int d = 0; d < 128; ++d) { const float wv = wbp[(size_t)(g * 128 + d) * 1024 + n] * ps[g * 128 + d];
#pragma unroll
            for (int j = 0; j < 8; ++j) a[j] += pw[(size_t)(g * 128 + 8 * cb + j) * 128 + d] * wv; }
        v4u o; o.x = pk_bf16(a[0], a[1]); o.y = pk_bf16(a[2], a[3]); o.z = pk_bf16(a[4], a[5]); o.w = pk_bf16(a[6], a[7]);
        *(GAS v4u*)((bf16*)(wl + O_WP) + (size_t)n * 512 + g * 128 + 8 * cb) = o; return; }
    r -= I_WP;
    if (r < I_QL) {
        const int hh = r >> 4, c = 8 * (r & 15) + (lane >> 3), d0 = 8 * (lane & 7);
        const f32x4* src = (const f32x4*)(in[8] + (size_t)l * 128 * 8 * 64 + (size_t)(c * 8 + hh) * 64 + d0); const f32x4 x = src[0], y = src[1];
        v4u o; o.x = pk_bf16(x.x * QSCALE, x.y * QSCALE); o.y = pk_bf16(x.z * QSCALE, x.w * QSCALE); o.z = pk_bf16(y.x * QSCALE, y.y * QSCALE); o.w = pk_bf16(y.z * QSCALE, y.w * QSCALE);
        *(GAS v4u*)((bf16*)(wl + O_WUK) + ((size_t)hh * 128 + c) * 64 + d0) = o; return; }
    r -= I_QL;
    if (r < I_GU) { const int kb = r / 88, nb = r % 88, n0 = 32 * nb; tr_item(in[2] + (size_t)l * D * FF, FF, n0, 128 * kb, (bf16*)(wl + O_WGU1), D, 256 * (n0 >> 7) + (n0 & 127), scr, lane, in[1] + (size_t)l * D); return; }
    r -= I_GU;
    if (r < I_GU) { const int kb = r / 88, nb = r % 88, n0 = 32 * nb; tr_item(in[3] + (size_t)l * D * FF, FF, n0, 128 * kb, (bf16*)(wl + O_WGU1), D, 256 * (n0 >> 7) + 128 + (n0 & 127), scr, lane, in[1] + (size_t)l * D); return; }
    r -= I_GU;
    if (r < I_DN) { const int kb = r / 32, nb = r % 32; tr_item(in[4] + (size_t)l * FF * D, D, 32 * nb, 128 * kb, (bf16*)(wl + O_WD1), FF, 32 * nb, scr, lane); return; }
    r -= I_DN;
    if (r < I_GU) { const int kb = r / 88, nb = r % 88, n0 = 32 * nb; tr_item(in[16] + (size_t)l * D * FF, FF, n0, 128 * kb, (bf16*)(wl + O_WGU2), D, 256 * (n0 >> 7) + (n0 & 127), scr, lane, in[15] + (size_t)l * D); return; }
    r -= I_GU;
    if (r < I_GU) { const int kb = r / 88, nb = r % 88, n0 = 32 * nb; tr_item(in[17] + (size_t)l * D * FF, FF, n0, 128 * kb, (bf16*)(wl + O_WGU2), D, 256 * (n0 >> 7) + 128 + (n0 & 127), scr, lane, in[15] + (size_t)l * D); return; }
    r -= I_GU;
    if (r < I_DN) { const int kb = r / 32, nb = r % 32; tr_item(in[18] + (size_t)l * FF * D, D, 32 * nb, 128 * kb, (bf16*)(wl + O_WD2), FF, 32 * nb, scr, lane); return; }
    r -= I_DN;
    if (r < I_WO) { const int kb = r / 32, nb = r % 32; tr_item(in[14] + (size_t)l * D * D, D, 32 * nb, 128 * kb, (bf16*)(wl + O_WO), D, 32 * nb, scr, lane); return; }
    r -= I_WO;
    if (r < I_WIN) {
        const int kb = r / 119, v = 32 * (r % 119); int c0, d0;
        if (v < 512) { c0 = S_Q + v; d0 = Z_Q + v; }
        else if (v < 1024) { c0 = S_QI + (v - 512); d0 = Z_QI + (v - 512); }
        else if (v < 1536) { c0 = S_PI + (v - 1024); d0 = Z_PI + (v - 1024); }
        else if (v < 2560) { c0 = S_GA + (v - 1536); d0 = R_GA + (v - 1536); }
        else if (v < 3584) { c0 = S_GB + (v - 2560); d0 = R_GB + (v - 2560); }
        else if (v < 3712) { c0 = S_CKV + (v - 3584); d0 = Z_CKV + (v - 3584); }
        else { c0 = S_KI + (v - 3712); d0 = Z_KI + (v - 3712); }
        tr_item(in[6] + (size_t)l * D * DIN, DIN, c0, 128 * kb, (bf16*)(wl + O_WIN), D, d0, scr, lane, in[5] + (size_t)l * D); return; }
    r -= I_WIN;
    {
        v4u z; z.x = 0u; z.y = 0u; z.z = 0u; z.w = 0u; GAS v4u* p = (GAS v4u*)((bf16*)(wl + O_WIN) + (size_t)(Z_KI + 96) * D);
        for (int i = lane; i < 32 * D / 8; i += 64) p[i] = z; }
}

__device__ __forceinline__ void xr_init_phase(const float* src, bf16* xr_out, float* ssq, int gw, int NGW, int lane) {
    for (int m0 = gw; m0 < M; m0 += 2 * NGW) {
        f32x4 v[2][4]; float s[2];
#pragma unroll
        for (int r = 0; r < 2; ++r) { const int m = m0 + r * NGW < M ? m0 + r * NGW : m0; const GAS f32x4* xr = (const GAS f32x4*)(src + (size_t)m * D) + lane; s[r] = 0.f;
#pragma unroll
            for (int j = 0; j < 4; ++j) { v[r][j] = xr[64 * j]; s[r] += (v[r][j].x * v[r][j].x + v[r][j].y * v[r][j].y) + (v[r][j].z * v[r][j].z + v[r][j].w * v[r][j].w); } }
#pragma unroll
        for (int r = 0; r < 2; ++r) { const int m = m0 + r * NGW; if (m < M) {
            const float tot = wave_sum(s[r], lane);
            GAS u32x2* x8 = (GAS u32x2*)(xr_out + (size_t)m * D) + lane;
#pragma unroll
            for (int j = 0; j < 4; ++j) { u32x2 q; q.x = pk_bf16(v[r][j].x, v[r][j].y); q.y = pk_bf16(v[r][j].z, v[r][j].w); x8[64 * j] = q; }
            if (lane < 16) ssq[(size_t)m * 16 + lane] = lane == 0 ? tot : 0.f; } }
    }
}
template <class Sched> __device__ __forceinline__ void rstab_fill(LAS unsigned char* lds, const Sched& S, const float* ssq, int tid) {
    LAS unsigned char* pmap = lds + PMAP_OFF; LAS int* plist = (LAS int*)(lds + PLIST_OFF); LAS float* tab = (LAS float*)(lds + RSTAB_OFF);
    if (tid < 256) pmap[tid] = 0xff;
    __syncthreads();
    if (tid == 0) { int np = 0; pg8::Unit u;
        for (int i = 0; S.next(i, u); ++i) if (pmap[u.pm] == 0xff && np < RSTAB_SLOTS) { pmap[u.pm] = (unsigned char)np; plist[np] = u.pm; ++np; }
        plist[RSTAB_SLOTS] = np; }
    __syncthreads();
    const int np = plist[RSTAB_SLOTS + (tid >> 16)];
    for (int e = tid; e < np * 256; e += NWAVES * 64) { const int slot = e >> 8, row = e & 255; const size_t m = (size_t)plist[slot] * 256 + row;
        const GAS f32x4* p = (const GAS f32x4*)(ssq + m * 16); const f32x4 a = p[0], b = p[1], c = p[2], d = p[3];
        const float t = (((a.x + a.y) + (a.z + a.w)) + ((b.x + b.y) + (b.z + b.w))) + (((c.x + c.y) + (c.z + c.w)) + ((d.x + d.y) + (d.z + d.w)));
        tab[e] = 1.f / sqrtf(t * (1.f / D) + EPS); }
    __syncthreads();
}
__device__ __forceinline__ void final_norm_phase(const bf16* src, float* out, const float* g, int rbase, int rcnt, int gw, int NGW, int lane, bool poison) {
    f32x4 gv[4];
#pragma unroll
    for (int j = 0; j < 4; ++j) gv[j] = ((const f32x4*)g)[64 * j + lane];
    const float qnan = __builtin_nanf("");
    const int m_end = rbase + rcnt;
    for (int m0 = rbase + gw; m0 < m_end; m0 += 4 * NGW) {
        u32x2 w[4][4];
#pragma unroll
        for (int r = 0; r < 4; ++r) { const int m = m0 + r * NGW < m_end ? m0 + r * NGW : m0; const GAS u32x2* xr = (const GAS u32x2*)(src + (size_t)m * D) + lane;
#pragma unroll
            for (int j = 0; j < 4; ++j) w[r][j] = xr[64 * j]; }
#pragma unroll
        for (int r = 0; r < 4; ++r) { const int m = m0 + r * NGW; if (m < m_end) {
            f32x4 v[4]; float s = 0.f;
#pragma unroll
            for (int j = 0; j < 4; ++j) { v[j].x = bf_lo(w[r][j].x); v[j].y = bf_hi(w[r][j].x); v[j].z = bf_lo(w[r][j].y); v[j].w = bf_hi(w[r][j].y); s += (v[j].x * v[j].x + v[j].y * v[j].y) + (v[j].z * v[j].z + v[j].w * v[j].w); }
            float rstd = 1.f / sqrtf(wave_sum(s, lane) * (1.f / D) + EPS);
            if (poison) rstd = qnan;
            GAS f32x4* o = (GAS f32x4*)(out + (size_t)m * D) + lane;
#pragma unroll
            for (int j = 0; j < 4; ++j) o[64 * j] = v[j] * rstd * gv[j]; } }
    }
}
__device__ __forceinline__ void prep_phase(const bf16* Z, const float* gkv, bf16* CK, bf16* PO, int rbase, int rcnt, int gw, int NGW, int lane) {
    {
        const int sub = lane >> 4, ch = lane & 15;
        float gk[8];
#pragma unroll
        for (int e = 0; e < 8; ++e) gk[e] = gkv[8 * ch + e];
        const int q_end = (rbase + rcnt) / 4;
        for (int r0 = rbase / 4 + gw; r0 < q_end; r0 += 4 * NGW) {
            u32x4 w[4];
#pragma unroll
            for (int q = 0; q < 4; ++q) { const int r4 = r0 + q * NGW < q_end ? r0 + q * NGW : r0; w[q] = *(const GAS u32x4*)(Z + ((size_t)r4 * 4 + sub) * ZP + Z_CKV + 8 * ch); }
#pragma unroll
            for (int q = 0; q < 4; ++q) {
                const int r4 = r0 + q * NGW; if (r4 < q_end) {
                const size_t m = (size_t)r4 * 4 + sub;
                float x[8] = {bf_lo(w[q].x), bf_hi(w[q].x), bf_lo(w[q].y), bf_hi(w[q].y), bf_lo(w[q].z), bf_hi(w[q].z), bf_lo(w[q].w), bf_hi(w[q].w)};
                float s = 0.f;
#pragma unroll
                for (int e = 0; e < 8; ++e) s += x[e] * x[e];
                s += shx(s, 1, lane); s += shx(s, 2, lane); s += shx(s, 4, lane); s += shx(s, 8, lane);
                const float rstd = 1.f / sqrtf(s * (1.f / 128.f) + EPS);
                u32x2 o0, o1; o0.x = pk_bf16(x[0] * rstd * gk[0], x[1] * rstd * gk[1]); o0.y = pk_bf16(x[2] * rstd * gk[2], x[3] * rstd * gk[3]);
                o1.x = pk_bf16(x[4] * rstd * gk[4], x[5] * rstd * gk[5]); o1.y = pk_bf16(x[6] * rstd * gk[6], x[7] * rstd * gk[7]);
                const int pbase = 16 * (ch >> 1) + 4 * (ch & 1);
                *(GAS u32x2*)(CK + m * 128 + pbase) = o0; *(GAS u32x2*)(CK + m * 128 + pbase + 8) = o1; }
            }
        }
    }
    {
        const int wdw = 2 << (lane >> 4);
        for (int blk = rbase / 8 + gw; blk < (rbase + rcnt) / 8; blk += NGW) {
            const int m0 = 8 * blk, t0 = m0 & (T - 1);
            u32x4 xr[23];
#pragma unroll
            for (int i = 0; i < 23; ++i) { int mr = m0 - 15 + i; mr = mr < m0 - t0 ? m0 - t0 : mr;     xr[i] = *(const GAS u32x4*)(Z + (size_t)mr * ZP + Z_PI + 8 * lane); }
#pragma unroll
            for (int r = 0; r < 8; ++r) {
                const int t = t0 + r; const int cnt = (t + 1) < wdw ? (t + 1) : wdw;
                float a[8];
#pragma unroll
                for (int e = 0; e < 8; ++e) a[e] = 0.f;
#pragma unroll
                for (int jj = 0; jj < 16; ++jj) { const float mk = jj < cnt ? 1.f : 0.f; const u32x4 w = xr[15 + r - jj];
                    a[0] = fmaf(bf_lo(w.x), mk, a[0]); a[1] = fmaf(bf_hi(w.x), mk, a[1]); a[2] = fmaf(bf_lo(w.y), mk, a[2]); a[3] = fmaf(bf_hi(w.y), mk, a[3]);
                    a[4] = fmaf(bf_lo(w.z), mk, a[4]); a[5] = fmaf(bf_hi(w.z), mk, a[5]); a[6] = fmaf(bf_lo(w.w), mk, a[6]); a[7] = fmaf(bf_hi(w.w), mk, a[7]); }
                const u32x4 sw = xr[15 + r]; const float inv = 1.f / (float)cnt;
                u32x4 o; o.x = pk_bf16(a[0] * inv - bf_lo(sw.x), a[1] * inv - bf_hi(sw.x)); o.y = pk_bf16(a[2] * inv - bf_lo(sw.y), a[3] * inv - bf_hi(sw.y));
                o.z = pk_bf16(a[4] * inv - bf_lo(sw.z), a[5] * inv - bf_hi(sw.z)); o.w = pk_bf16(a[6] * inv - bf_lo(sw.w), a[7] * inv - bf_hi(sw.w));
                *(GAS u32x4*)(PO + (size_t)(m0 + r) * 512 + 8 * lane) = o;
            }
        }
    }
}

__device__ __forceinline__ bool mix_unit(int i, int vcu, int G, int& b, int& qb) {
    const int U = vcu + i * G; if (U >= BATCH * 64) return false;
    const int ii = U >> 8, r = U & 7; b = (U & 255) >> 3; qb = (ii & 1) ? 16 * (ii >> 1) + 15 - r : 16 * (ii >> 1) + r; return true;
}
__device__ __forceinline__ unsigned fkey(float s) { const unsigned u = __float_as_uint(s); return (u & 0x80000000u) ? ~u : (u | 0x80000000u); }
__device__ __forceinline__ float funkey(unsigned k) { return __uint_as_float((k & 0x80000000u) ? (k & 0x7fffffffu) : ~k); }
__device__ __forceinline__ unsigned half_sum(unsigned v, int hh) {
    v += (unsigned)__builtin_amdgcn_update_dpp(0, (int)v, 0xB1, 0xF, 0xF, false);
    v += (unsigned)__builtin_amdgcn_update_dpp(0, (int)v, 0x4E, 0xF, 0xF, false);
    v += (unsigned)__builtin_amdgcn_update_dpp(0, (int)v, 0x141, 0xF, 0xF, false);
    v += (unsigned)__builtin_amdgcn_update_dpp(0, (int)v, 0x140, 0xF, 0xF, false);
    const unsigned a = __builtin_amdgcn_readlane(v, 0) + __builtin_amdgcn_readlane(v, 16), b = __builtin_amdgcn_readlane(v, 32) + __builtin_amdgcn_readlane(v, 48);
    return hh ? b : a;
}
__device__ __forceinline__ float half_fsum(float v, int hh);
__device__ __forceinline__ float rl_f(float v, int l) { return __uint_as_float((unsigned)__builtin_amdgcn_readlane((int)__float_as_uint(v), l)); }
__device__ __forceinline__ float half_max(float v, int hh) {
    v = fmaxf(v, __builtin_amdgcn_update_dpp(v, v, 0xB1, 0xF, 0xF, false)); v = fmaxf(v, __builtin_amdgcn_update_dpp(v, v, 0x4E, 0xF, 0xF, false));
    v = fmaxf(v, __builtin_amdgcn_update_dpp(v, v, 0x141, 0xF, 0xF, false)); v = fmaxf(v, __builtin_amdgcn_update_dpp(v, v, 0x140, 0xF, 0xF, false));
    const float a = fmaxf(rl_f(v, 0), rl_f(v, 16)), b = fmaxf(rl_f(v, 32), rl_f(v, 48));
    return hh ? b : a;
}
__device__ __forceinline__ float half_fsum(float v, int hh) {
    v += __builtin_amdgcn_update_dpp(0.f, v, 0xB1, 0xF, 0xF, false); v += __builtin_amdgcn_update_dpp(0.f, v, 0x4E, 0xF, 0xF, false);
    v += __builtin_amdgcn_update_dpp(0.f, v, 0x141, 0xF, 0xF, false); v += __builtin_amdgcn_update_dpp(0.f, v, 0x140, 0xF, 0xF, false);
    const float a = rl_f(v, 0) + rl_f(v, 16), b = rl_f(v, 32) + rl_f(v, 48);
    return hh ? b : a;
}
__device__ __forceinline__ float half_min(float v, int hh) {
    v = fminf(v, __builtin_amdgcn_update_dpp(v, v, 0xB1, 0xF, 0xF, false)); v = fminf(v, __builtin_amdgcn_update_dpp(v, v, 0x4E, 0xF, 0xF, false));
    v = fminf(v, __builtin_amdgcn_update_dpp(v, v, 0x141, 0xF, 0xF, false)); v = fminf(v, __builtin_amdgcn_update_dpp(v, v, 0x140, 0xF, 0xF, false));
    const float a = fminf(rl_f(v, 0), rl_f(v, 16)), b = fminf(rl_f(v, 32), rl_f(v, 48));
    return hh ? b : a;
}
constexpr int SEL_STALL = 8;
__device__ __forceinline__ float sel_cand(float lo, float hi, float glo, float ghi) {
    float c = lo + (hi - lo) * (glo * __builtin_amdgcn_rcpf(glo - ghi));
    if (!(c > lo && c < hi)) c = funkey((fkey(lo) >> 1) + (fkey(hi) >> 1) + (fkey(lo) & fkey(hi) & 1u));
    return c;
}

__device__ __forceinline__ void select_unit(LAS unsigned char* kbuf, const bf16* Z, unsigned* MASK, int b, int qb, int wid, int lane_in) {
    int lane = lane_in; asm volatile("" : "+v"(lane));
    const int col = lane & 31, hh = lane >> 5;
    const size_t mb = (size_t)b * T + 32 * qb + 4 * wid;
    const int tql_r = 2 * (col >> 4) + ((col >> 2) & 1), j_r = 4 * ((col >> 3) & 1) + (col & 3);
    bf16x8 qa[4];
#pragma unroll
    for (int s = 0; s < 4; ++s) qa[s] = *(const GAS bf16x8*)(Z + (mb + tql_r) * ZP + Z_QI + j_r * 64 + 16 * s + 8 * hh);
    float wA[8], wB[8];
    { const u32x4 a = *(const GAS u32x4*)(Z + (mb + hh) * ZP + Z_WI), c = *(const GAS u32x4*)(Z + (mb + 2 + hh) * ZP + Z_WI);
      wA[0] = bf_lo(a.x) * IDX_SCALE; wA[1] = bf_hi(a.x) * IDX_SCALE; wA[2] = bf_lo(a.y) * IDX_SCALE; wA[3] = bf_hi(a.y) * IDX_SCALE;
      wA[4] = bf_lo(a.z) * IDX_SCALE; wA[5] = bf_hi(a.z) * IDX_SCALE; wA[6] = bf_lo(a.w) * IDX_SCALE; wA[7] = bf_hi(a.w) * IDX_SCALE;
      wB[0] = bf_lo(c.x) * IDX_SCALE; wB[1] = bf_hi(c.x) * IDX_SCALE; wB[2] = bf_lo(c.y) * IDX_SCALE; wB[3] = bf_hi(c.y) * IDX_SCALE;
      wB[4] = bf_lo(c.z) * IDX_SCALE; wB[5] = bf_hi(c.z) * IDX_SCALE; wB[6] = bf_lo(c.w) * IDX_SCALE; wB[7] = bf_hi(c.w) * IDX_SCALE; }
    const int dA = 32 * qb + 4 * wid + hh - col, dB = dA + 2;
    float sA[64], sB[64];
    const bf16* ksrc = Z + ((size_t)b * T + 32 * wid + (lane >> 3)) * ZP + Z_KI;
#define SEL_DMA_CHUNK(c_) do { _Pragma("unroll") for (int j_ = 0; j_ < 4; ++j_) \
        __builtin_amdgcn_global_load_lds((const unsigned*)(ksrc + ((size_t)(c_) * 256 + 8 * j_) * ZP + 8 * ((lane & 7) ^ ((4 * j_ + (lane >> 4)) & 7))), (LAS unsigned*)(kbuf + ((c_) & 3) * 32768 + (4 * wid + j_) * 1024), 16, 0, 0); } while (0)
    unsigned kof[4];
#pragma unroll
    for (int s = 0; s < 4; ++s) kof[s] = (unsigned)col * 128u + 16u * ((unsigned)(2 * s + hh) ^ (((unsigned)col >> 1) & 7u));
    asm volatile("s_waitcnt lgkmcnt(0)" ::: "memory"); __builtin_amdgcn_s_barrier(); asm volatile("" ::: "memory");
    SEL_DMA_CHUNK(0); if (8 <= qb) SEL_DMA_CHUNK(1); if (16 <= qb) SEL_DMA_CHUNK(2);
#pragma unroll
    for (int kt = 0; kt < 64; ++kt) { sA[kt] = -INFINITY; sB[kt] = -INFINITY; }
#pragma unroll
    for (int c8 = 0; c8 < 8; ++c8) {
        if (8 * c8 <= qb) {
            asm volatile("s_waitcnt vmcnt(0) lgkmcnt(0)" ::: "memory"); __builtin_amdgcn_s_barrier(); asm volatile("" ::: "memory");
            if (c8 + 3 < 8 && 8 * (c8 + 3) <= qb) SEL_DMA_CHUNK(c8 + 3);
            const LAS unsigned char* cb = kbuf + (c8 & 3) * 32768;
            bf16x8 kb[2][4]; f32x16 acc[2];
#pragma unroll
            for (int s = 0; s < 4; ++s) { kb[0][s] = *(const LAS bf16x8*)(cb + kof[s]); kb[1][s] = *(const LAS bf16x8*)(cb + 4096 + kof[s]); }
#pragma unroll
            for (int i = 0; i < 16; ++i) acc[0][i] = 0.f;
#pragma unroll
            for (int s = 0; s < 4; ++s) acc[0] = __builtin_amdgcn_mfma_f32_32x32x16_bf16(qa[s], kb[0][s], acc[0], 0, 0, 0);
            __builtin_amdgcn_sched_barrier(0);
#pragma unroll
            for (int k = 0; k < 8; ++k) {
                const int kt = 8 * c8 + k;
                if (k + 2 < 8) {
#pragma unroll
                    for (int s = 0; s < 4; ++s) kb[k & 1][s] = *(const LAS bf16x8*)(cb + (k + 2) * 4096 + kof[s]);
                }
                if (k + 1 < 8) {
#pragma unroll
                    for (int i = 0; i < 16; ++i) acc[(k + 1) & 1][i] = 0.f;
#pragma unroll
                    for (int s = 0; s < 4; ++s) acc[(k + 1) & 1] = __builtin_amdgcn_mfma_f32_32x32x16_bf16(qa[s], kb[(k + 1) & 1][s], acc[(k + 1) & 1], 0, 0, 0);
                }
                __builtin_amdgcn_sched_barrier(0);
                float sa = 0.f, sb = 0.f, sa1 = 0.f, sb1 = 0.f;
#pragma unroll
                for (int j = 0; j < 4; ++j) {
                    const int ra = __float_as_int(acc[k & 1][j]), rb = __float_as_int(acc[k & 1][8 + j]), rc = __float_as_int(acc[k & 1][4 + j]), rd = __float_as_int(acc[k & 1][12 + j]);
                    const float fa = __int_as_float(ra > 0 ? ra : 0), fb = __int_as_float(rb > 0 ? rb : 0), fc = __int_as_float(rc > 0 ? rc : 0), fd = __int_as_float(rd > 0 ? rd : 0);
                    asm("v_fmac_f32 %0, %1, %2" : "+v"(sa) : "v"(fa), "v"(wA[j]));
                    asm("v_fmac_f32 %0, %1, %2" : "+v"(sb) : "v"(fb), "v"(wB[j]));
                    asm("v_fmac_f32 %0, %1, %2" : "+v"(sa1) : "v"(fc), "v"(wA[4 + j]));
                    asm("v_fmac_f32 %0, %1, %2" : "+v"(sb1) : "v"(fd), "v"(wB[4 + j])); }
                sa += sa1; sb += sb1;
                sA[kt] = (32 * kt <= dA) ? sa : -INFINITY; sB[kt] = (32 * kt <= dB) ? sb : -INFINITY;
                __builtin_amdgcn_sched_barrier(0);
            }
        }
    }
#undef SEL_DMA_CHUNK
    float thrA = -3.0e38f, thrB = -3.0e38f;
    if (qb >= 8) {
        float mnA = sA[0], mnB = sB[0], mxA = sA[0], mxB = sB[0];
#pragma unroll
        for (int k = 1; k < 8; ++k) { mnA = fminf(mnA, sA[k]); mnB = fminf(mnB, sB[k]); }
#pragma unroll
        for (int c8 = 0; c8 < 8; ++c8) {
            if (8 * c8 <= qb) {
#pragma unroll
                for (int k = 0; k < 8; ++k) { mxA = fmaxf(mxA, sA[8 * c8 + k]); mxB = fmaxf(mxB, sB[8 * c8 + k]); }
            }
        }
        float loA = half_min(mnA, hh), loB = half_min(mnB, hh);
        float hiA = funkey(fkey(half_max(mxA, hh)) + 1u), hiB = funkey(fkey(half_max(mxB, hh)) + 1u);
        const float nv = (float)(32 * qb + 16);
        float gloA = nv - 256.5f, ghiA = -256.5f, gloB = gloA, ghiB = ghiA;
        int sdA = 0, sdB = 0;
        unsigned nloA = 0x40000000u, nhiA = 0u, nloB = 0x40000000u, nhiB = 0u;
        int stA = 0, stB = 0;
        bool dnA = false, dnB = false, spA = false, spB = false; float mxsA = 0.f, mxsB = 0.f;
        float c0A, c0B;
        { float s1a = 0.f, s2a = 0.f, s1b = 0.f, s2b = 0.f;
#pragma unroll
          for (int c8 = 0; c8 < 7; ++c8) {
              if (c8 < (qb >> 3)) {
#pragma unroll
                  for (int k = 0; k < 8; k += 4) { const float a = sA[8 * c8 + k], b2 = sB[8 * c8 + k]; s1a += a; s2a = fmaf(a, a, s2a); s1b += b2; s2b = fmaf(b2, b2, s2b); }
              }
          }
          s1a = half_fsum(s1a, hh); s2a = half_fsum(s2a, hh); s1b = half_fsum(s1b, hh); s2b = half_fsum(s2b, hh);
          const float rn = __builtin_amdgcn_rcpf((float)(64 * (qb >> 3)));
          const float muA = s1a * rn, muB = s1b * rn, sdA_ = __builtin_amdgcn_sqrtf(fmaxf(s2a * rn - muA * muA, 0.f)), sdB_ = __builtin_amdgcn_sqrtf(fmaxf(s2b * rn - muB * muB, 0.f));
          const float nA_ = (float)(32 * qb + 4 * wid + hh + 1), nB_ = nA_ + 2.f;
          const float zA = 0.4159f * __builtin_amdgcn_logf((nA_ - 256.f) * (1.f / 256.f)), zB = 0.4159f * __builtin_amdgcn_logf((nB_ - 256.f) * (1.f / 256.f));
          c0A = fmaf(zA, sdA_, muA); c0B = fmaf(zB, sdB_, muB); }
#pragma unroll 1
        for (int it = 0; it < 96; ++it) {
            float cA = sel_cand(loA, hiA, gloA, ghiA), cB = sel_cand(loB, hiB, gloB, ghiB);
            if (it == 0) { cA = (c0A > loA && c0A < hiA) ? c0A : cA; cB = (c0B > loB && c0B < hiB) ? c0B : cB; }
            cA = spA ? mxsA : cA; cB = spB ? mxsB : cB;
            unsigned pA = 0u, pB = 0u;
#pragma unroll
            for (int c8 = 0; c8 < 8; ++c8) {
                if (8 * c8 <= qb) {
                    unsigned ba = 0u, bb = 0u, ba2 = 0u, bb2 = 0u;
#pragma unroll
                    for (int k = 0; k < 8; k += 2) { float t0_, t1_, t2_, t3_;
                        asm("v_sub_f32 %4, %8, %12\n\tv_sub_f32 %5, %9, %13\n\tv_sub_f32 %6, %10, %12\n\tv_sub_f32 %7, %11, %13\n\t"
                            "v_alignbit_b32 %0, %0, %4, 31\n\tv_alignbit_b32 %1, %1, %5, 31\n\tv_alignbit_b32 %2, %2, %6, 31\n\tv_alignbit_b32 %3, %3, %7, 31"
                            : "+v"(ba), "+v"(bb), "+v"(ba2), "+v"(bb2), "=&v"(t0_), "=&v"(t1_), "=&v"(t2_), "=&v"(t3_)
                            : "v"(sA[8 * c8 + k]), "v"(sB[8 * c8 + k]), "v"(sA[8 * c8 + k + 1]), "v"(sB[8 * c8 + k + 1]), "v"(cA), "v"(cB)); }
                    pA += (unsigned)__builtin_popcount(ba) + (unsigned)__builtin_popcount(ba2); pB += (unsigned)__builtin_popcount(bb) + (unsigned)__builtin_popcount(bb2);
                }
            }
            const unsigned pk_ = half_sum(pA | (pB << 16), hh), tot_ = 256u * (unsigned)((qb >> 3) + 1);
            const unsigned nA = tot_ - (pk_ & 0xffffu), nB = tot_ - (pk_ >> 16);
            if (!dnA) {
                const float g = (float)nA - 256.5f; const unsigned w0_ = nloA - nhiA;
                if (nA == 256u || (spA && nA > 256u)) { loA = cA; dnA = true; }
                else if (nA > 256u) { loA = cA; nloA = nA; gloA = g; if (sdA > 0) ghiA *= 0.5f; sdA = 1; }
                else { hiA = cA; nhiA = nA; ghiA = g; if (sdA < 0) gloA *= 0.5f; sdA = -1; }
                stA = (nloA - nhiA == w0_) ? stA + 1 : 0;
                if (!dnA && fkey(hiA) - fkey(loA) <= 1u) dnA = true;
            }
            if (!dnB) {
                const float g = (float)nB - 256.5f; const unsigned w0_ = nloB - nhiB;
                if (nB == 256u || (spB && nB > 256u)) { loB = cB; dnB = true; }
                else if (nB > 256u) { loB = cB; nloB = nB; gloB = g; if (sdB > 0) ghiB *= 0.5f; sdB = 1; }
                else { hiB = cB; nhiB = nB; ghiB = g; if (sdB < 0) gloB *= 0.5f; sdB = -1; }
                stB = (nloB - nhiB == w0_) ? stB + 1 : 0;
                if (!dnB && fkey(hiB) - fkey(loB) <= 1u) dnB = true;
            }
            if (__all(dnA && dnB)) break;
            spA = false; spB = false;
            if (__any(!dnA && (stA >= SEL_STALL || nhiA >= 254u))) {
                float m = -INFINITY;
#pragma unroll
                for (int c8 = 0; c8 < 8; ++c8) {
                    if (8 * c8 <= qb) {
#pragma unroll
                        for (int k = 0; k < 8; ++k) { const float a = sA[8 * c8 + k]; m = fmaxf(m, a < hiA ? a : -INFINITY); }
                    }
                }
                mxsA = half_max(m, hh); spA = !dnA && (stA >= SEL_STALL || nhiA >= 254u); stA = spA ? 0 : stA;
            }
            if (__any(!dnB && (stB >= SEL_STALL || nhiB >= 254u))) {
                float m = -INFINITY;
#pragma unroll
                for (int c8 = 0; c8 < 8; ++c8) {
                    if (8 * c8 <= qb) {
#pragma unroll
                        for (int k = 0; k < 8; ++k) { const float a = sB[8 * c8 + k]; m = fmaxf(m, a < hiB ? a : -INFINITY); }
                    }
                }
                mxsB = half_max(m, hh); spB = !dnB && (stB >= SEL_STALL || nhiB >= 254u); stB = spB ? 0 : stB;
            }
        }
        thrA = loA; thrB = loB;
    }
    unsigned w0 = 0u, w1 = 0u, w2 = 0u, w3 = 0u;
    int lane2 = lane; asm volatile("" : "+v"(lane2));
#pragma unroll
    for (int c8 = 0; c8 < 8; ++c8) {
        if (8 * c8 <= qb) {
#pragma unroll
            for (int k = 0; k < 8; ++k) { const int kt = 8 * c8 + k;
                const unsigned long long bA = __ballot(sA[kt] >= thrA), bB = __ballot(sB[kt] >= thrB);
                const bool mine = (lane2 == kt);
                w0 = mine ? (unsigned)bA : w0; w1 = mine ? (unsigned)(bA >> 32) : w1; w2 = mine ? (unsigned)bB : w2; w3 = mine ? (unsigned)(bB >> 32) : w3; }
        }
    }
    GAS unsigned* mo = (GAS unsigned*)MASK + mb * 64 + lane;
    mo[0] = w0; mo[64] = w1; mo[128] = w2; mo[192] = w3;
}

__device__ __forceinline__ unsigned off_b(unsigned row, unsigned ch) { return 256u * row + 16u * (ch ^ (((row & 3u) << 2) | ((row >> 2) & 3u))); }
__device__ __forceinline__ s16x4 vtr(const LAS unsigned char* p) { typedef short v4i16_t __attribute__((ext_vector_type(4))); return __builtin_bit_cast(s16x4, __builtin_amdgcn_ds_read_tr16_b64_v4i16((LAS v4i16_t*)p)); }
template <int LAG  > __device__ __forceinline__ void attn_unit(LAS unsigned char* kbuf, const bf16* Z, const bf16* CK, const bf16* WUK, const bf16* WUV, const unsigned* MASK, bf16* OL, const float* gkv, int b, int qb, int wid, int lane_in) {
    int lane = lane_in; asm volatile("" : "+v"(lane));
    const int r32 = lane & 31, hh = lane >> 5, head = wid;
    const size_t m = (size_t)b * T + 32 * qb + r32;
    const int lr = lane >> 4;
    const bf16* gsrc0 = CK + ((size_t)b * T + 32 * wid + lr) * 128;
    LAS unsigned char* ldst0 = kbuf + (32 * wid) * 256;
#define ATT_DMA_STAGE(st_) do { _Pragma("unroll") for (int i_ = 0; i_ < 8; ++i_) { const int ch_ = (lane & 15) ^ ((lr << 2) | (i_ & 3)); \
        __builtin_amdgcn_global_load_lds((const unsigned*)(gsrc0 + (size_t)(st_) * 256 * 128 + i_ * 4 * 128 + 8 * ch_), (LAS unsigned*)(ldst0 + ((st_) & 1) * 65536 + i_ * 1024), 16, 0, 0); } } while (0)
    asm volatile("s_waitcnt lgkmcnt(0)" ::: "memory"); __builtin_amdgcn_s_barrier(); asm volatile("" ::: "memory");
    ATT_DMA_STAGE(0);
    bf16x8 qf[8];
    { bf16x8 qb_[4];
#pragma unroll
      for (int s = 0; s < 4; ++s) qb_[s] = *(const GAS bf16x8*)(Z + m * ZP + Z_Q + head * 64 + 16 * s + 8 * hh);
      const bf16* wk = WUK + ((size_t)head * 128 + r32) * 64 + 8 * hh;
#pragma unroll
      for (int rt = 0; rt < 4; ++rt) { f32x16 qa_;
#pragma unroll
          for (int i = 0; i < 16; ++i) qa_[i] = 0.f;
#pragma unroll
          for (int s = 0; s < 4; ++s) { const bf16x8 wa = *(const GAS bf16x8*)(wk + (size_t)rt * 32 * 64 + 16 * s); qa_ = __builtin_amdgcn_mfma_f32_32x32x16_bf16(wa, qb_[s], qa_, 0, 0, 0); }
#pragma unroll
          for (int s2 = 0; s2 < 2; ++s2) { u32x4 pw; pw.x = pk_bf16(qa_[8 * s2 + 0], qa_[8 * s2 + 1]); pw.y = pk_bf16(qa_[8 * s2 + 2], qa_[8 * s2 + 3]); pw.z = pk_bf16(qa_[8 * s2 + 4], qa_[8 * s2 + 5]); pw.w = pk_bf16(qa_[8 * s2 + 6], qa_[8 * s2 + 7]);
              qf[2 * rt + s2] = __builtin_bit_cast(bf16x8, pw); } } }
    const GAS unsigned* mrow = (const GAS unsigned*)MASK + m * 64;
    float mref;
    { float gm = fmaxf(fabsf(gkv[lane]), fabsf(gkv[lane + 64]));
#pragma unroll
      for (int o = 1; o < 64; o <<= 1) gm = fmaxf(gm, shx(gm, o, lane));
      float qn = 0.f;
#pragma unroll
      for (int s = 0; s < 8; ++s)
#pragma unroll
          for (int e = 0; e < 8; ++e) { const float x = __uint_as_float(((unsigned)(unsigned short)qf[s][e]) << 16); qn += x * x; }
      qn += shx(qn, 32, lane);
      mref = fminf(sqrtf(qn) * gm * (1.02f * 11.313708499f), 60.f); }
    const unsigned negm_bits = __float_as_uint(-mref);
    f32x16 zero16;
#pragma unroll
    for (int i = 0; i < 16; ++i) zero16[i] = 0.f;
    f32x16 o[4];
#pragma unroll
    for (int dt = 0; dt < 4; ++dt)
#pragma unroll
        for (int i = 0; i < 16; ++i) o[dt][i] = 0.f;
    float lrun = 0.f;
    const int ns = (qb + 8) >> 3;
    const unsigned q4 = (lane & 15) >> 2, p4 = lane & 3, blk = (lane >> 4) & 1;
    const unsigned fh = (unsigned)r32 & 3u, fl = ((unsigned)r32 >> 2) & 3u;
    const unsigned kl0 = 256u * (unsigned)r32 + 16u * (((unsigned)hh ^ fl) & 3u), kl1 = 256u * (unsigned)r32 + 16u * (((2u + (unsigned)hh) ^ fl) & 3u);
#define ATT_KA(s_) ((((s_) & 1) ? kl1 : kl0) + 64u * ((unsigned)((s_) >> 1) ^ fh))
    const unsigned vb = 256u * (4u * hh + q4) + 8u * (p4 & 1u), cl = 2u * blk + (p4 >> 1);
    const unsigned vlo0 = vb + 16u * ((cl ^ (unsigned)hh) & 3u), vlo1 = vb + 2048u + 16u * ((cl ^ (2u + (unsigned)hh)) & 3u);
    u32x4 mw0 = *(const GAS u32x4*)(mrow), mw1 = *(const GAS u32x4*)(mrow + 4);
    if (LAG) __builtin_amdgcn_s_setprio(1);
    for (int st = 0; st < ns; ++st) {
        asm volatile("s_waitcnt vmcnt(0) lgkmcnt(0)" ::: "memory"); __builtin_amdgcn_s_barrier(); asm volatile("" ::: "memory");
        if (st + 1 < ns) ATT_DMA_STAGE(st + 1);
        const LAS unsigned char* sb = kbuf + (st & 1) * 65536;
        const int klim = (st + 1 < ns) ? 8 : (qb & 7) + 1;
#define ATT_QK(S_, k_) do { bf16x8 kf_[2]; \
        _Pragma("unroll") for (int s_ = 0; s_ < 8; s_ += 2) { kf_[0] = *(const LAS bf16x8*)(sb + (k_) * 8192 + ATT_KA(s_)); kf_[1] = *(const LAS bf16x8*)(sb + (k_) * 8192 + ATT_KA(s_ + 1)); \
            S_ = __builtin_amdgcn_mfma_f32_32x32x16_bf16(kf_[0], qf[s_], S_, 0, 0, 0); S_ = __builtin_amdgcn_mfma_f32_32x32x16_bf16(kf_[1], qf[s_ + 1], S_, 0, 0, 0); } } while (0)
#define ATT_BIAS(S_, w_) do { const unsigned wsh_ = (w_) >> (4 * hh); _Pragma("unroll") for (int i_ = 0; i_ < 16; ++i_) { const int pos_ = (i_ & 3) + 8 * (i_ >> 2); \
            unsigned r_; asm("v_bfe_i32 %0, %1, %4, 1\n\tv_bfi_b32 %0, %0, %2, %3" : "=&v"(r_) : "v"(wsh_), "v"(negm_bits), "s"(0xf149f2cau), "n"(pos_)); S_[i_] = __uint_as_float(r_); } } while (0)
#define ATT_BAR_CORE() do { __builtin_amdgcn_sched_barrier(0); __builtin_amdgcn_s_barrier(); __builtin_amdgcn_sched_barrier(0); } while (0)
#define ATT_PIN_M() asm volatile("" : "+v"(S[0]), "+v"(S[1]), "+v"(o[0]), "+v"(o[1]), "+v"(o[2]), "+v"(o[3]) :: "memory")
#define ATT_PIN_V() asm volatile("" : "+v"(pf[0]), "+v"(pf[1]), "+v"(lrun) :: "memory")
#define ATT_SEG_BAR() do { asm volatile("" ::: "memory"); ATT_BAR_CORE(); asm volatile("" ::: "memory"); } while (0)
#define ATT_WORD(j_) ((j_) < 4 ? mw0[(j_) & 3] : mw1[(j_) & 3])
        if (LAG) ATT_SEG_BAR();
        f32x16 S[2];
        ATT_BIAS(S[0], mw0[0]); ATT_BIAS(S[1], mw0[1]);
        ATT_QK(S[0], 0);
        ATT_PIN_M(); ATT_BAR_CORE(); ATT_PIN_M();
#pragma unroll
        for (int k = 0; k < 8; ++k) {
            if (k >= klim) break;
            const LAS unsigned char* kb = sb + k * 8192;
            const int cur = k & 1, nxt = cur ^ 1;
            float ps = 0.f;
#pragma unroll
            for (int i = 0; i < 16; ++i) { S[cur][i] = __builtin_amdgcn_exp2f(S[cur][i]); ps += S[cur][i]; }
            lrun += ps;
            bf16x8 pf[2];
#pragma unroll
            for (int s = 0; s < 2; ++s) { u32x4 pw; pw.x = pk_bf16(S[cur][8 * s + 0], S[cur][8 * s + 1]); pw.y = pk_bf16(S[cur][8 * s + 2], S[cur][8 * s + 3]); pw.z = pk_bf16(S[cur][8 * s + 4], S[cur][8 * s + 5]); pw.w = pk_bf16(S[cur][8 * s + 6], S[cur][8 * s + 7]); pf[s] = __builtin_bit_cast(bf16x8, pw); }
            const unsigned wsh2 = (k + 2 < 8) ? (ATT_WORD(k + 2) >> (4 * hh)) : 0u;
            if (k == 3) mw0 = *(const GAS u32x4*)(mrow + 8 * (st + 1));
            if (k == 7) mw1 = *(const GAS u32x4*)(mrow + 8 * (st + 1) + 4);
            { bf16x8 ob[16];
              const int QN = (k < 7) ? 8 : 0, NOP = QN + 8; constexpr int AH = 4;
#define ATT_LD(i_) do { if ((i_) < QN) { ob[i_] = *(const LAS bf16x8*)(sb + (k + 1) * 8192 + ATT_KA(i_)); } \
                else { const unsigned j_ = (unsigned)((i_) - QN); \
                    const s16x4 lo_ = vtr(kb + 4096 * (j_ & 1u) + vlo0 + 64u * ((j_ >> 1) ^ q4)); const s16x4 hi_ = vtr(kb + 4096 * (j_ & 1u) + vlo1 + 64u * ((j_ >> 1) ^ q4)); \
                    ob[i_] = __builtin_shufflevector(lo_, hi_, 0, 1, 2, 3, 4, 5, 6, 7); } } while (0)
#define ATT_MM(i_) do { if ((i_) < QN) { S[nxt] = __builtin_amdgcn_mfma_f32_32x32x16_bf16(ob[i_], qf[(i_) < QN ? (i_) : 0], S[nxt], 0, 0, 0); } \
                else { const int j_ = (i_) - QN; o[j_ >> 1] = __builtin_amdgcn_mfma_f32_32x32x16_bf16(ob[i_], pf[j_ & 1], o[j_ >> 1], 0, 0, 0); } } while (0)
#define ATT_BIAS1(i_) do { const int pos_ = ((i_) & 3) + 8 * ((i_) >> 2); unsigned r_; \
                asm("v_bfe_i32 %0, %1, %4, 1\n\tv_bfi_b32 %0, %0, %2, %3" : "=&v"(r_) : "v"(wsh2), "v"(negm_bits), "s"(0xf149f2cau), "n"(pos_)); S[cur][i_] = __uint_as_float(r_); } while (0)
#pragma unroll
              for (int i = 0; i < AH; ++i) ATT_LD(i);
              ATT_PIN_V(); ATT_BAR_CORE(); ATT_PIN_V();
#pragma unroll
              for (int i = 0; i < NOP; ++i) { __builtin_amdgcn_sched_barrier(0); if (i + AH < NOP) ATT_LD(i + AH); ATT_MM(i); if (k + 2 < 8) ATT_BIAS1(i); }
#undef ATT_LD
#undef ATT_MM
#undef ATT_BIAS1
            }
            ATT_PIN_M(); ATT_BAR_CORE(); ATT_PIN_M();
        }
        if (!LAG) ATT_SEG_BAR();
#undef ATT_SEG_BAR
#undef ATT_BAR_CORE
#undef ATT_PIN_M
#undef ATT_WORD
#undef ATT_PIN_V
#undef ATT_QK
#undef ATT_BIAS
#undef ATT_KA
    }
#undef ATT_DMA_STAGE
    if (LAG) __builtin_amdgcn_s_setprio(0);
    lrun += shx(lrun, 32, lane);
    const float inv = 1.f / lrun;
    bf16x8 po[8];
#pragma unroll
    for (int dt = 0; dt < 4; ++dt)
#pragma unroll
        for (int s2 = 0; s2 < 2; ++s2) { u32x4 pw; pw.x = pk_bf16(o[dt][8 * s2 + 0] * inv, o[dt][8 * s2 + 1] * inv); pw.y = pk_bf16(o[dt][8 * s2 + 2] * inv, o[dt][8 * s2 + 3] * inv);
            pw.z = pk_bf16(o[dt][8 * s2 + 4] * inv, o[dt][8 * s2 + 5] * inv); pw.w = pk_bf16(o[dt][8 * s2 + 6] * inv, o[dt][8 * s2 + 7] * inv); po[2 * dt + s2] = __builtin_bit_cast(bf16x8, pw); }
    const bf16* wv = WUV + (((size_t)head * 2 * 8 * 32 + r32) * 2 + hh) * 8;
    bf16* orow = OL + m * 512 + head * 64;
#pragma unroll
    for (int rt = 0; rt < 2; ++rt) { f32x16 at;
#pragma unroll
        for (int i = 0; i < 16; ++i) at[i] = 0.f;
#pragma unroll
        for (int ks = 0; ks < 8; ++ks) { const bf16x8 wa = *(const GAS bf16x8*)(wv + (size_t)(rt * 8 + ks) * 32 * 2 * 8); at = __builtin_amdgcn_mfma_f32_32x32x16_bf16(wa, po[ks], at, 0, 0, 0); }
#pragma unroll
        for (int gp = 0; gp < 2; ++gp) { const int g0 = 2 * gp, g1 = 2 * gp + 1;
            const unsigned a0 = pk_bf16(at[4 * g0], at[4 * g0 + 1]), a1 = pk_bf16(at[4 * g0 + 2], at[4 * g0 + 3]), b0 = pk_bf16(at[4 * g1], at[4 * g1 + 1]), b1 = pk_bf16(at[4 * g1 + 2], at[4 * g1 + 3]);
            const auto s0 = __builtin_amdgcn_permlane32_swap(a0, b0, false, false), s1 = __builtin_amdgcn_permlane32_swap(a1, b1, false, false);
            u32x4 w; w.x = s0[0]; w.y = s1[0]; w.z = s0[1]; w.w = s1[1];
            *(GAS u32x4*)(orow + 32 * rt + 8 * (hh ? g1 : g0)) = w; } }
}

__device__ __forceinline__ cargs_t kargs() { cargs_t p = (cargs_t)__builtin_amdgcn_kernarg_segment_ptr(); asm volatile("" : "+s"(p)); return p; }
__device__ __forceinline__ int lane_id() { unsigned z = 0u; asm volatile("" : "+v"(z)); int v = (int)__builtin_amdgcn_mbcnt_hi(~0u, __builtin_amdgcn_mbcnt_lo(~0u, z)); asm volatile("" : "+v"(v)); return v; }
__global__ void __launch_bounds__(NWAVES * 64, 2) fwd(Args args_unused) {
    extern __shared__ __attribute__((aligned(16))) unsigned char lds[];
    Frame F;
    F.lds = (LAS unsigned char*)lds;
    F.MISC = (volatile LAS unsigned*)(F.lds + MISC_OFF);
    F.wave = __builtin_amdgcn_readfirstlane((int)threadIdx.x >> 6);
    F.G = gridDim.x; { const int bx = blockIdx.x; F.vcu = (F.G % 8 == 0) ? (bx % 8) * (F.G / 8) + bx / 8 : bx; }
    F.ctl = (gu32*)(kargs()->ws + WS_CTL);
    for (int u = threadIdx.x; u < (LDS_BYTES - LDSCTL_OFF) / 4; u += NWAVES * 64) ((LAS unsigned*)(F.lds + LDSCTL_OFF))[u] = 0u;
    __syncthreads();
    XcdBarrier bar = xcd_barrier_post((unsigned*)(F.ctl + CW_BAR), F.MISC + 8, (unsigned)F.wave);
#define GRID_BAR() xcd_barrier(bar)
    const bool grp_ok = (F.G == 256);
    { const unsigned g_ = (unsigned)blockIdx.x & 7u; (void)grp_barrier_post((unsigned*)(F.ctl + CW_BAR), (unsigned*)(F.ctl + CW_GBAR), F.MISC + 10, (unsigned)F.wave, g_, ((unsigned)F.G - g_ + 7u) >> 3); }
#define GROUP_BAR() do { if (grp_ok) { const unsigned g_ = (unsigned)blockIdx.x & 7u; GrpBarrier gb_; gb_.wv = (unsigned)F.wave; gb_.bar = (unsigned*)(F.ctl + CW_BAR); gb_.gb = (unsigned*)(F.ctl + CW_GBAR); \
        gb_.x = (unsigned)__builtin_amdgcn_readfirstlane((int)xb_xcc_id()); gb_.g = g_; gb_.gsize = ((unsigned)F.G - g_ + 7u) >> 3; gb_.st = F.MISC + 10; grp_barrier(gb_); } else xcd_barrier(bar); } while (0)
    const int gw = F.vcu * NWAVES + F.wave, NGW = F.G * NWAVES;
    const int g_rbase = grp_ok ? ((int)blockIdx.x & 7) * (M / 8) : 0, g_rcnt = grp_ok ? M / 8 : M, g_gw = grp_ok ? ((int)blockIdx.x >> 3) * NWAVES + F.wave : gw, g_ngw = grp_ok ? (F.G >> 3) * NWAVES : NGW;
#define WSP(off) (kargs()->ws + (off))

    {
        LAS float* scr = (LAS float*)(F.lds + RING_OFF + F.wave * 16384);
        const cargs_t a = kargs(); const int lane = lane_id();
        {
        for (int it = sopq(gw); it < NL * I_LAYER; it += NGW) { int ln = lane; asm volatile("" : "+v"(ln)); prologue_item(a, it, scr, ln); }
        xr_init_phase(a->in[0], (bf16*)(a->ws + WS_XR), (float*)(a->ws + WS_SSQ), sopq(gw), NGW, lane_id());
        GRID_BAR(); }
    }
#define GEMM_PHASE(EPI_T, A_, B_, N_, K_, E_) GEMM_PHASE_L(EPI_T, A_, (K_), B_, N_, K_, E_)
#define GEMM_PHASE_L(EPI_T, A_, LDA_, B_, N_, K_, E_) do { const pg8::Gemm g_{(const pg8::bf16_t*)(A_), (const pg8::bf16_t*)(B_), M, (N_), (K_), (LDA_)}; pg8::StaticOrder S_; S_.init(M, (N_), F.G, (int)blockIdx.x); \
        pg8::gemm_phase<EPI_T, pg8::StaticOrder, true, true>(F.lds + RING_OFF, g_, S_, (E_), F.wave); } while (0)

#define GEMM_PHASE_RS(EPI_T, A_, B_, N_, K_, SSQ_, ...) do { const pg8::Gemm g_{(const pg8::bf16_t*)(A_), (const pg8::bf16_t*)(B_), M, (N_), (K_), (K_)}; pg8::StaticOrder S_; S_.init(M, (N_), F.G, (int)blockIdx.x); \
        rstab_fill(F.lds, S_, (SSQ_), F.wave * 64 + lane_id()); \
        const EPI_T E_{__VA_ARGS__, (const LAS float*)(F.lds + RSTAB_OFF), (const LAS unsigned char*)(F.lds + PMAP_OFF)}; \
        pg8::gemm_phase<EPI_T, pg8::StaticOrder, true, true>(F.lds + RING_OFF, g_, S_, E_, F.wave); } while (0)
    for (int fi = 0; fi < 2 * NL; ++fi) {
        const int l = fi >> 1; const bool second = (fi & 1) != 0;
        const size_t wlo = WS_W + (size_t)l * LW;
        { const cargs_t a = kargs(); GEMM_PHASE_RS(pg8::EpiSwiglu, a->ws + WS_XR, a->ws + wlo + (second ? O_WGU2 : O_WGU1), 2 * FF, D, (const float*)(a->ws + WS_SSQ), (pg8::bf16_t*)(a->ws + WS_ZA), ZP); GROUP_BAR(); }
        { const cargs_t a = kargs(); const pg8::EpiResid<1> E{(pg8::bf16_t*)(a->ws + WS_XR), D, (float*)(a->ws + WS_SSQ)}; GEMM_PHASE_L(pg8::EpiResid<1>, a->ws + WS_ZA, ZP, a->ws + wlo + (second ? O_WD2 : O_WD1), D, FF, E); GROUP_BAR(); }
        if (!second) {
            { const cargs_t a = kargs(); GEMM_PHASE_RS(pg8::EpiPlainBf16, a->ws + WS_XR, a->ws + wlo + O_WIN, ZN, D, (const float*)(a->ws + WS_SSQ), (pg8::bf16_t*)(a->ws + WS_ZA), ZP, (pg8::bf16_t*)(a->ws + WS_ZA) + ZA, ZP, ZA / 256); GROUP_BAR(); }
            { const cargs_t a = kargs(); const int lane = lane_id();
              prep_phase((const bf16*)(a->ws + WS_ZA), a->in[7] + (size_t)l * 128, (bf16*)(a->ws + WS_CK), (bf16*)(a->ws + WS_PO), sopq(g_rbase), sopq(g_rcnt), sopq(g_gw), sopq(g_ngw), lane);
              {
              int b, qb; for (int i = 0; mix_unit(i, F.vcu, F.G, b, qb); ++i) select_unit(F.lds + RING_OFF, (const bf16*)(a->ws + WS_ZA), (unsigned*)(a->ws + WS_MASK), b, qb, F.wave, lane); }
              asm volatile("s_waitcnt vmcnt(0) lgkmcnt(0)" ::: "memory"); __syncthreads();
              GROUP_BAR(); }
            { const cargs_t a = kargs(); const int tid = F.wave * 64 + lane_id();
              if (F.wave >= 4) { int b, qb; for (int i = 0; mix_unit(i, F.vcu, F.G, b, qb); ++i) attn_unit<1>(F.lds + RING_OFF, (const bf16*)(a->ws + WS_ZA), (const bf16*)(a->ws + WS_CK), (const bf16*)(a->ws + wlo + O_WUK), (const bf16*)(a->ws + wlo + O_WUV), (const unsigned*)(a->ws + WS_MASK), (bf16*)(a->ws + WS_OL), a->in[7] + (size_t)l * 128, b, qb, F.wave, tid & 63); }
              else { int b, qb; for (int i = 0; mix_unit(i, F.vcu, F.G, b, qb); ++i) attn_unit<0>(F.lds + RING_OFF, (const bf16*)(a->ws + WS_ZA), (const bf16*)(a->ws + WS_CK), (const bf16*)(a->ws + wlo + O_WUK), (const bf16*)(a->ws + wlo + O_WUV), (const unsigned*)(a->ws + WS_MASK), (bf16*)(a->ws + WS_OL), a->in[7] + (size_t)l * 128, b, qb, F.wave, tid & 63); }
              asm volatile("s_waitcnt vmcnt(0) lgkmcnt(0)" ::: "memory"); __syncthreads();
              GROUP_BAR(); }
            { const cargs_t a = kargs(); const pg8::EpiGate<false> E{(pg8::bf16_t*)(a->ws + WS_ZA), ZP, (const pg8::bf16_t*)(a->ws + WS_ZA) + ZA, ZP}; GEMM_PHASE(pg8::EpiGate<false>, a->ws + WS_OL, a->ws + wlo + O_WA, D, 512, E); }
            { const cargs_t a = kargs(); const pg8::EpiGate<true> E{(pg8::bf16_t*)(a->ws + WS_ZA), ZP, (const pg8::bf16_t*)(a->ws + WS_ZA) + ZA + 1024, ZP}; GEMM_PHASE(pg8::EpiGate<true>, a->ws + WS_PO, a->ws + wlo + O_WP, D, 512, E); GROUP_BAR(); }
            { const cargs_t a = kargs(); const pg8::EpiResid<0> E{(pg8::bf16_t*)(a->ws + WS_XR), D, (float*)(a->ws + WS_SSQ)}; GEMM_PHASE_L(pg8::EpiResid<0>, a->ws + WS_ZA, ZP, a->ws + wlo + O_WO, D, D, E); GROUP_BAR(); }
        }
    }
    {
        const cargs_t a = kargs();
        const bool poison = __hip_atomic_load((gu32*)(F.ctl + CW_BAR + XB_TMO), RLX_AGENT) != 0u;
        final_norm_phase((const bf16*)(a->ws + WS_XR), a->out, a->in[19], sopq(g_rbase), sopq(g_rcnt), sopq(g_gw), sopq(g_ngw), lane_id(), poison);
    }
}

extern "C" void kernel_launch(void* const* d_in, const int* in_sizes, int n_in, void* d_out, int out_size, void* d_ws, size_t ws_size, hipStream_t stream) {
    static int grid = 0;
    if (grid == 0) {
        if (n_in != 20 || in_sizes[0] != M * D || out_size != M * D || ws_size < WS_END) { fprintf(stderr, "kernel_launch: unexpected shapes (n_in %d, in0 %d, out %d, ws %zu); nothing launched\n", n_in, n_in > 0 ? in_sizes[0] : -1, out_size, ws_size); grid = -1; return; }
        int dev = 0, cus = 0, per_cu = 0;
        if (hipGetDevice(&dev) != hipSuccess || hipDeviceGetAttribute(&cus, hipDeviceAttributeMultiprocessorCount, dev) != hipSuccess) { fprintf(stderr, "kernel_launch: device query failed\n"); grid = -1; return; }
        if (hipFuncSetAttribute((const void*)fwd, hipFuncAttributeMaxDynamicSharedMemorySize, LDS_BYTES) != hipSuccess) { fprintf(stderr, "kernel_launch: hipFuncSetAttribute failed\n"); grid = -1; return; }
        if (hipOccupancyMaxActiveBlocksPerMultiprocessor(&per_cu, (const void*)fwd, NWAVES * 64, LDS_BYTES) != hipSuccess || per_cu < 1)
            fprintf(stderr, "kernel_launch: note: occupancy query reports %d workgroups per CU\n", per_cu);
        (void)hipGetLastError();
        grid = cus;
    }
    if (grid < 0) return;
    if (hipMemsetAsync((char*)d_ws + WS_CTL, 0, CTL_ZERO_BYTES, stream) != hipSuccess) { fprintf(stderr, "kernel_launch: hipMemsetAsync failed\n"); return; }
    Args a{};
    for (int i = 0; i < 20; ++i) a.in[i] = (const float*)d_in[i];
    a.out = (float*)d_out; a.ws = (unsigned char*)d_ws;
    hipLaunchKernelGGL(fwd, dim3(grid), dim3(NWAVES * 64), LDS_BYTES, stream, a);
    const hipError_t le = hipPeekAtLastError();
    if (le != hipSuccess) fprintf(stderr, "kernel_launch: launch failed: %s\n", hipGetErrorName(le));
}
```

```cpp
#include <hip/hip_runtime.h>
#include <cstdio>
#include <cstdint>
#include <cmath>
namespace pg8 {
#define PG8_LAS __attribute__((address_space(3)))
typedef unsigned short bf16_t;
typedef short bf16x8 __attribute__((ext_vector_type(8)));
typedef float f32x4 __attribute__((ext_vector_type(4)));
typedef unsigned u32x4 __attribute__((ext_vector_type(4)));
constexpr int BM = 256, BK = 64, HALF = 128, HTB = HALF * BK * 2  , STAGE_BYTES = 8 * HTB, NXCD = 8, WGM = 8;

__host__ __device__ __forceinline__ int lds_byte(int r, int c) { const int st = (r >> 4) * 2 + (c >> 5), rr = r & 15, cc = c & 31, ob = rr * 64 + cc * 2; return st * 1024 + (ob ^ (((ob >> 9) & 1) << 5)); }
__host__ __device__ __forceinline__ void stage_rc(int b, int& R, int& C) { const int st = b / 1024, sb = b % 1024, swz = sb ^ (((sb >> 9) & 1) << 5); R = (st >> 1) * 16 + swz / 64; C = (st & 1) * 32 + (swz % 64) / 2; }
__host__ __device__ __forceinline__ int perm32(int rho) { const int n = rho >> 4, i = rho & 15; return 8 * (i >> 2) + 4 * n + (i & 3); }

struct Unit { int pm, pn; };
struct Gemm { const bf16_t* A; const bf16_t* Bt; int M, N, K, lda; };

struct StaticOrder {
    int nM, nN, nwg, G, c;
    __host__ __device__ void init(int M, int N, int G_, int c_) { nM = M / BM; nN = N / BM; nwg = nM * nN; G = G_; c = c_; }
    __host__ __device__ bool next(int i, Unit& u) const {
        const long L = (long)i * G + c; if (L >= nwg) return false;
        int wgid = (int)L; { const int q = nwg / NXCD, r = nwg % NXCD, xcd = wgid % NXCD, off = wgid / NXCD; wgid = (xcd < r ? xcd * (q + 1) : r * (q + 1) + (xcd - r) * q) + off; }
        const int nig = WGM * nN, gid = wgid / nig, fm = gid * WGM, gsz = (nM - fm) < WGM ? (nM - fm) : WGM;
        u.pm = fm + ((wgid % nig) % gsz); u.pn = (wgid % nig) / gsz; return true;
    }
    __device__ __forceinline__ void a_ready(const Unit&) const {}
    __device__ __forceinline__ void done(const Unit&) const {}
};

__device__ __forceinline__ unsigned cvt_pk_bf16(float lo, float hi) { unsigned r; asm volatile("v_cvt_pk_bf16_f32 %0, %1, %2" : "=v"(r) : "v"(lo), "v"(hi)); return r; }
typedef float f32x2 __attribute__((ext_vector_type(2)));
typedef __bf16 bf16x2_t __attribute__((ext_vector_type(2)));
__device__ __forceinline__ unsigned pk_bf16(float lo, float hi) { f32x2 v = {lo, hi}; bf16x2_t b = __builtin_convertvector(v, bf16x2_t); return __builtin_bit_cast(unsigned, b); }
__device__ __forceinline__ float sigm(float g) { return __builtin_amdgcn_rcpf(1.0f + __builtin_amdgcn_exp2f(-1.4426950408889634f * g)); }
__device__ __forceinline__ float bf_lo(unsigned w) { return __uint_as_float(w << 16); }
__device__ __forceinline__ float bf_hi(unsigned w) { return __uint_as_float(w & 0xffff0000u); }

__device__ __forceinline__ float xlane(float v, int m, int lane) { return __int_as_float(__builtin_amdgcn_ds_bpermute((lane ^ m) << 2, __float_as_int(v))); }
struct EpiPlainBf16 {
    static constexpr bool PERM = true, AFTER_DRAIN = false;
    bf16_t* O1; int ld1; bf16_t* O2; int ld2; int nsplit; const PG8_LAS float* rstab; const PG8_LAS unsigned char* pmap;
    __device__ __forceinline__ void operator()(const f32x4 (&acc)[2][2][4][2], const Unit& u, int wr, int wc, int fr, int fq) const {
        const PG8_LAS float* rs = rstab + 256 * (int)pmap[u.pm] + wr * 64 + fr;
        const bool first = u.pn < nsplit; bf16_t* O = first ? O1 : O2; const int ldc = first ? ld1 : ld2;
        const int row0 = u.pm * BM + wr * 64 + fr, col0 = (first ? u.pn : u.pn - nsplit) * BM + wc * 32 + 8 * fq;
#pragma unroll
        for (int ai = 0; ai < 2; ++ai)
#pragma unroll
            for (int m = 0; m < 4; ++m) { bf16_t* rowp = O + (size_t)(row0 + ai * HALF + m * 16) * ldc + col0;
                const float rr = rs[ai * HALF + m * 16];
#pragma unroll
                for (int bj = 0; bj < 2; ++bj) { const f32x4 v0 = acc[ai][bj][m][0] * rr, v1 = acc[ai][bj][m][1] * rr;
                    u32x4 w; w.x = pk_bf16(v0[0], v0[1]); w.y = pk_bf16(v0[2], v0[3]); w.z = pk_bf16(v1[0], v1[1]); w.w = pk_bf16(v1[2], v1[3]);
                    *(u32x4*)(rowp + bj * HALF) = w; } }
    }
};
struct EpiSwiglu {
    static constexpr bool PERM = true, AFTER_DRAIN = false;
    bf16_t* O; int ldc; const PG8_LAS float* rstab; const PG8_LAS unsigned char* pmap;
    __device__ __forceinline__ void operator()(const f32x4 (&acc)[2][2][4][2], const Unit& u, int wr, int wc, int fr, int fq) const {
        const PG8_LAS float* rs = rstab + 256 * (int)pmap[u.pm] + wr * 64 + fr;
        const int row0 = u.pm * BM + wr * 64 + fr, col0 = u.pn * HALF + wc * 32 + 8 * fq;
#pragma unroll
        for (int ai = 0; ai < 2; ++ai)
#pragma unroll
            for (int m = 0; m < 4; ++m) { bf16_t* rowp = O + (size_t)(row0 + ai * HALF + m * 16) * ldc + col0;
                const float rr = rs[ai * HALF + m * 16], kk = -1.4426950408889634f * rr, ir2 = __builtin_amdgcn_rcpf(rr * rr);
                f32x4 h0, h1;
#pragma unroll
                for (int j = 0; j < 4; ++j) { const float a0 = acc[ai][0][m][0][j], a1 = acc[ai][0][m][1][j];
                    h0[j] = (a0 * acc[ai][1][m][0][j]) * __builtin_amdgcn_rcpf(fmaf(__builtin_amdgcn_exp2f(a0 * kk), ir2, ir2));
                    h1[j] = (a1 * acc[ai][1][m][1][j]) * __builtin_amdgcn_rcpf(fmaf(__builtin_amdgcn_exp2f(a1 * kk), ir2, ir2)); }
                u32x4 w; w.x = pk_bf16(h0[0], h0[1]); w.y = pk_bf16(h0[2], h0[3]); w.z = pk_bf16(h1[0], h1[1]); w.w = pk_bf16(h1[2], h1[3]);
                *(u32x4*)rowp = w; }
    }
};
template <int HALFSTEP> struct EpiResid {
    static constexpr bool PERM = true, AFTER_DRAIN = false;
    bf16_t* X; int ldc; float* ssq;
    __device__ __forceinline__ void operator()(const f32x4 (&acc)[2][2][4][2], const Unit& u, int wr, int wc, int fr, int fq) const {
        const int lane = fr + 16 * fq;
        char* Xu = (char*)(X + (size_t)(u.pm * BM + wr * 64) * ldc + u.pn * BM + wc * 32);
        const unsigned lo = (unsigned)(fr * ldc + 8 * fq) * 2u;
        u32x4 b2[2][4][2];
#pragma unroll
        for (int ai = 0; ai < 2; ++ai)
#pragma unroll
            for (int m = 0; m < 4; ++m)
#pragma unroll
                for (int bj = 0; bj < 2; ++bj) b2[ai][m][bj] = *(const u32x4*)(Xu + (size_t)((ai * HALF + m * 16) * ldc + bj * HALF) * 2 + lo);
        char* Su = (char*)(ssq + (size_t)(u.pm * BM + wr * 64) * 16 + 4 * u.pn + wc);
        const unsigned so = (unsigned)fr * 64u;
#pragma unroll
        for (int ai = 0; ai < 2; ++ai) {
#pragma unroll
            for (int m = 0; m < 4; ++m) { float ss = 0.f;
#pragma unroll
                for (int bj = 0; bj < 2; ++bj) { const f32x4 a0 = acc[ai][bj][m][0] * (HALFSTEP ? 0.5f : 1.0f), a1 = acc[ai][bj][m][1] * (HALFSTEP ? 0.5f : 1.0f); const u32x4 bb = b2[ai][m][bj];
                    const float x0 = bf_lo(bb.x) + a0[0], x1 = bf_hi(bb.x) + a0[1], x2 = bf_lo(bb.y) + a0[2], x3 = bf_hi(bb.y) + a0[3];
                    const float x4 = bf_lo(bb.z) + a1[0], x5 = bf_hi(bb.z) + a1[1], x6 = bf_lo(bb.w) + a1[2], x7 = bf_hi(bb.w) + a1[3];
                    u32x4 w; w.x = pk_bf16(x0, x1); w.y = pk_bf16(x2, x3); w.z = pk_bf16(x4, x5); w.w = pk_bf16(x6, x7);
                    *(u32x4*)(Xu + (size_t)((ai * HALF + m * 16) * ldc + bj * HALF) * 2 + lo) = w;
                    ss += ((x0 * x0 + x1 * x1) + (x2 * x2 + x3 * x3)) + ((x4 * x4 + x5 * x5) + (x6 * x6 + x7 * x7)); }
                ss += xlane(ss, 16, lane); ss += xlane(ss, 32, lane);
                if (fq == 0) *(float*)(Su + (size_t)(ai * HALF + m * 16) * 64 + so) = ss; }
            __builtin_amdgcn_sched_barrier(0);
        }
    }
};
template <bool ADD> struct EpiGate {
    static constexpr bool PERM = true, AFTER_DRAIN = false;
    bf16_t* O; int ldc; const bf16_t* G; int ldg;
    __device__ __forceinline__ void operator()(const f32x4 (&acc)[2][2][4][2], const Unit& u, int wr, int wc, int fr, int fq) const {
        const char* Gu = (const char*)(G + (size_t)(u.pm * BM + wr * 64) * ldg + u.pn * BM + wc * 32); const unsigned go = (unsigned)(fr * ldg + 8 * fq) * 2u;
        char* Ou = (char*)(O + (size_t)(u.pm * BM + wr * 64) * ldc + u.pn * BM + wc * 32); const unsigned oo = (unsigned)(fr * ldc + 8 * fq) * 2u;
        u32x4 gq2[2][4][2];
        if (!ADD) {
#pragma unroll
            for (int ai = 0; ai < 2; ++ai)
#pragma unroll
                for (int m = 0; m < 4; ++m)
#pragma unroll
                    for (int bj = 0; bj < 2; ++bj) gq2[ai][m][bj] = *(const u32x4*)(Gu + (size_t)((ai * HALF + m * 16) * ldg + bj * HALF) * 2 + go); }
#pragma unroll
        for (int ai = 0; ai < 2; ++ai) {
            u32x4 oq[4][2];
            if (ADD) {
#pragma unroll
                for (int m = 0; m < 4; ++m)
#pragma unroll
                    for (int bj = 0; bj < 2; ++bj) { gq2[ai][m][bj] = *(const u32x4*)(Gu + (size_t)((ai * HALF + m * 16) * ldg + bj * HALF) * 2 + go);
                        oq[m][bj] = *(const u32x4*)(Ou + (size_t)((ai * HALF + m * 16) * ldc + bj * HALF) * 2 + oo); } }
#pragma unroll
            for (int m = 0; m < 4; ++m) {
#pragma unroll
                for (int bj = 0; bj < 2; ++bj) { const f32x4 v0 = acc[ai][bj][m][0], v1 = acc[ai][bj][m][1]; const u32x4 g = gq2[ai][m][bj];
                    float r0 = sigm(bf_lo(g.x)) * v0[0], r1 = sigm(bf_hi(g.x)) * v0[1], r2 = sigm(bf_lo(g.y)) * v0[2], r3 = sigm(bf_hi(g.y)) * v0[3];
                    float r4 = sigm(bf_lo(g.z)) * v1[0], r5 = sigm(bf_hi(g.z)) * v1[1], r6 = sigm(bf_lo(g.w)) * v1[2], r7 = sigm(bf_hi(g.w)) * v1[3];
                    if (ADD) { const u32x4 o = oq[m][bj]; r0 += bf_lo(o.x); r1 += bf_hi(o.x); r2 += bf_lo(o.y); r3 += bf_hi(o.y); r4 += bf_lo(o.z); r5 += bf_hi(o.z); r6 += bf_lo(o.w); r7 += bf_hi(o.w); }
                    u32x4 w; w.x = pk_bf16(r0, r1); w.y = pk_bf16(r2, r3); w.z = pk_bf16(r4, r5); w.w = pk_bf16(r6, r7);
                    *(u32x4*)(Ou + (size_t)((ai * HALF + m * 16) * ldc + bj * HALF) * 2 + oo) = w; } }
            __builtin_amdgcn_sched_barrier(0);
        }
    }
};
template <class Epi, class Sched, bool ALIGN_EPI = false, bool SP2 = false>
__device__ __forceinline__ void gemm_phase(PG8_LAS unsigned char* lds, const Gemm g, const Sched S, const Epi E, const int wave_id) {
    unsigned z_o = 0u; asm volatile("" : "+v"(z_o)); int tid_o = wave_id * 64 + (int)__builtin_amdgcn_mbcnt_hi(~0u, __builtin_amdgcn_mbcnt_lo(~0u, z_o)); asm volatile("" : "+v"(tid_o));
    const int tid = tid_o, wid = __builtin_amdgcn_readfirstlane(tid >> 6), lane = tid & 63, wr = wid >> 2, wc = wid & 3, fr = lane & 15, fq = lane >> 4;
    const int K = g.K, nt = K / BK;
    unsigned voffA[2], voffB[2];
#pragma unroll
    for (int i = 0; i < 2; ++i) { int R, C; stage_rc(tid * 16 + i * 8192, R, C); const int Rb = Epi::PERM ? ((R & ~31) + perm32(R & 31)) : R;
        voffA[i] = (unsigned)(R * g.lda + C) * 2u; voffB[i] = (unsigned)(Rb * K + C) * 2u; }
    const size_t kstep = (size_t)(BK * 2);
    const size_t hstepA = (size_t)HALF * g.lda * 2, hstepB = (size_t)HALF * K * 2;
    const size_t tstepA = 2 * hstepA, tstepB = 2 * hstepB;
    const unsigned ldsw = (unsigned)wid * 1024u;
    const int aoff = lds_byte(wr * 64 + fr, fq * 8), boff = lds_byte(wc * 32 + fr, fq * 8);
#define PG8_SA(b, h) (((b) * 2 + (h)) * HTB)
#define PG8_SB(b, h) ((4 + (b) * 2 + (h)) * HTB)
#define PG8_STAGE(bufoff, gbase, voff) do { _Pragma("unroll") for (int _i = 0; _i < 2; ++_i) \
        __builtin_amdgcn_global_load_lds((const unsigned*)((const char*)(gbase) + (voff)[_i]), (PG8_LAS unsigned*)(lds + (bufoff) + ldsw + _i * 8192), 16, 0, 0); } while (0)
#define PG8_LDA(dst, b, h) do { _Pragma("unroll") for (int m = 0; m < 4; ++m) _Pragma("unroll") for (int k = 0; k < 2; ++k) dst[m][k] = *(const PG8_LAS bf16x8*)(lds + PG8_SA(b, h) + aoff + m * 2048 + k * 1024); } while (0)
#define PG8_LDB(dst, b, h) do { _Pragma("unroll") for (int n = 0; n < 2; ++n) _Pragma("unroll") for (int k = 0; k < 2; ++k) dst[n][k] = *(const PG8_LAS bf16x8*)(lds + PG8_SB(b, h) + boff + n * 2048 + k * 1024); } while (0)
#define PG8_MMA(ai, bj, At, Bt) do { __builtin_amdgcn_s_setprio(1); _Pragma("unroll") for (int m = 0; m < 4; ++m) _Pragma("unroll") for (int n = 0; n < 2; ++n) _Pragma("unroll") for (int k = 0; k < 2; ++k) \
        acc[ai][bj][m][n] = __builtin_amdgcn_mfma_f32_16x16x32_bf16(Bt[n][k], At[m][k], acc[ai][bj][m][n], 0, 0, 0); __builtin_amdgcn_s_setprio(0); } while (0)
#define PG8_WAIT_V(n) asm volatile("s_waitcnt vmcnt(" #n ")" ::: "memory")
#define PG8_WAIT_L(n) asm volatile("s_waitcnt lgkmcnt(" #n ")" ::: "memory")
#define PG8_BAR __builtin_amdgcn_s_barrier()
#define PG8_SCHED __builtin_amdgcn_sched_barrier(0)
    Unit cur, nxt; int ui = 0;
    if (!S.next(0, cur)) return;
    f32x4 acc[2][2][4][2];
#pragma unroll
    for (int a = 0; a < 2; ++a)
#pragma unroll
        for (int b = 0; b < 2; ++b)
#pragma unroll
            for (int m = 0; m < 4; ++m)
#pragma unroll
                for (int n = 0; n < 2; ++n) acc[a][b][m][n] = (f32x4){0.f, 0.f, 0.f, 0.f};
    bf16x8 At[4][2], B0[2][2], B1[2][2];
    const char* cA = (const char*)g.A + (size_t)cur.pm * tstepA; const char* cB = (const char*)g.Bt + (size_t)cur.pn * tstepB;
    S.a_ready(cur);
    if constexpr (SP2) {
        PG8_STAGE(PG8_SB(0, 0), cB, voffB); PG8_STAGE(PG8_SB(0, 1), cB + hstepB, voffB); PG8_STAGE(PG8_SA(0, 0), cA, voffA); PG8_STAGE(PG8_SA(0, 1), cA + hstepA, voffA);
        if (wr == 1) PG8_BAR;
        PG8_WAIT_V(2); PG8_BAR;
        PG8_STAGE(PG8_SB(1, 0), cB + kstep, voffB); PG8_STAGE(PG8_SA(1, 0), cA + kstep, voffA); PG8_STAGE(PG8_SB(1, 1), cB + hstepB + kstep, voffB);
        PG8_WAIT_V(6); PG8_BAR;
    } else {
        PG8_STAGE(PG8_SB(0, 0), cB, voffB); PG8_STAGE(PG8_SA(0, 0), cA, voffA); PG8_STAGE(PG8_SB(0, 1), cB + hstepB, voffB); PG8_STAGE(PG8_SA(0, 1), cA + hstepA, voffA);
        if (wr == 1) PG8_BAR;
        PG8_WAIT_V(4); PG8_BAR;
        PG8_STAGE(PG8_SB(1, 0), cB + kstep, voffB); PG8_STAGE(PG8_SA(1, 0), cA + kstep, voffA); PG8_STAGE(PG8_SB(1, 1), cB + hstepB + kstep, voffB);
        PG8_WAIT_V(6); PG8_BAR;
    }
    for (;;) {
        const bool has_next = S.next(ui + 1, nxt);
        const char* nA = has_next ? (const char*)g.A + (size_t)nxt.pm * tstepA : cA; const char* nB = has_next ? (const char*)g.Bt + (size_t)nxt.pn * tstepB : cB;
        for (int t = 0; t < nt; t += 2) {
            const bool last = (t == nt - 2);
            const char* a1 = cA + (size_t)(t + 1) * kstep;
            const char* a2 = last ? nA : cA + (size_t)(t + 2) * kstep; const char* b2 = last ? nB : cB + (size_t)(t + 2) * kstep;
            const char* a3 = a2 + kstep; const char* b3 = b2 + kstep;
            if (last && has_next) S.a_ready(nxt);
            if constexpr (SP2) {
            PG8_LDB(B0, 0, 0); PG8_LDB(B1, 0, 1); PG8_SCHED; PG8_LDA(At, 0, 0); PG8_STAGE(PG8_SA(1, 1), a1 + hstepA, voffA);
            PG8_WAIT_V(8); PG8_WAIT_L(0); PG8_BAR; PG8_MMA(0, 0, At, B0); PG8_MMA(0, 1, At, B1); PG8_BAR; PG8_SCHED;
            PG8_LDA(At, 0, 1); PG8_STAGE(PG8_SB(0, 0), b2, voffB); PG8_STAGE(PG8_SB(0, 1), b2 + hstepB, voffB); PG8_STAGE(PG8_SA(0, 0), a2, voffA);
            PG8_WAIT_V(8); PG8_WAIT_L(0); PG8_BAR; PG8_MMA(1, 0, At, B0); PG8_MMA(1, 1, At, B1); PG8_BAR; PG8_SCHED;
            PG8_LDB(B0, 1, 0); PG8_LDB(B1, 1, 1); PG8_SCHED; PG8_LDA(At, 1, 0); PG8_STAGE(PG8_SA(0, 1), a2 + hstepA, voffA);
            PG8_WAIT_V(8); PG8_WAIT_L(0); PG8_BAR; PG8_MMA(0, 0, At, B0); PG8_MMA(0, 1, At, B1); PG8_BAR; PG8_SCHED;
            PG8_LDA(At, 1, 1); PG8_STAGE(PG8_SB(1, 0), b3, voffB); PG8_STAGE(PG8_SB(1, 1), b3 + hstepB, voffB); PG8_STAGE(PG8_SA(1, 0), a3, voffA);
            PG8_WAIT_V(8); PG8_WAIT_L(0); PG8_BAR; PG8_MMA(1, 0, At, B0); PG8_MMA(1, 1, At, B1); PG8_BAR; PG8_SCHED;
            } else {
            PG8_LDB(B0, 0, 0); PG8_SCHED; PG8_LDA(At, 0, 0); PG8_STAGE(PG8_SA(1, 1), a1 + hstepA, voffA);
            PG8_WAIT_L(8); PG8_BAR; PG8_WAIT_L(0); PG8_MMA(0, 0, At, B0); PG8_BAR; PG8_SCHED;
            PG8_LDB(B1, 0, 1); PG8_STAGE(PG8_SB(0, 0), b2, voffB);
            PG8_BAR; PG8_WAIT_L(0); PG8_MMA(0, 1, At, B1); PG8_BAR;
            PG8_LDA(At, 0, 1); PG8_STAGE(PG8_SA(0, 0), a2, voffA);
            PG8_BAR; PG8_WAIT_L(0); PG8_MMA(1, 0, At, B0); PG8_BAR; PG8_SCHED;
            PG8_STAGE(PG8_SB(0, 1), b2 + hstepB, voffB);
            PG8_WAIT_V(6); PG8_BAR; PG8_MMA(1, 1, At, B1); PG8_BAR;
            PG8_LDB(B0, 1, 0); PG8_SCHED; PG8_LDA(At, 1, 0); PG8_STAGE(PG8_SA(0, 1), a2 + hstepA, voffA);
            PG8_WAIT_L(8); PG8_BAR; PG8_WAIT_L(0); PG8_MMA(0, 0, At, B0); PG8_BAR; PG8_SCHED;
            PG8_LDB(B1, 1, 1); PG8_STAGE(PG8_SB(1, 0), b3, voffB);
            PG8_BAR; PG8_WAIT_L(0); PG8_MMA(0, 1, At, B1); PG8_BAR;
            PG8_LDA(At, 1, 1); PG8_STAGE(PG8_SA(1, 0), a3, voffA);
            PG8_BAR; PG8_WAIT_L(0); PG8_MMA(1, 0, At, B0); PG8_BAR; PG8_SCHED;
            PG8_STAGE(PG8_SB(1, 1), b3 + hstepB, voffB);
            PG8_WAIT_V(6); PG8_BAR; PG8_MMA(1, 1, At, B1); PG8_BAR;
            }
        }
        if constexpr (ALIGN_EPI) { if (wr == 0) PG8_BAR; }
        if constexpr (!Epi::AFTER_DRAIN) { E(acc, cur, wr, wc, fr, fq); S.done(cur); }
        if (!has_next) break;
#pragma unroll
        for (int a = 0; a < 2; ++a)
#pragma unroll
            for (int b = 0; b < 2; ++b)
#pragma unroll
                for (int m = 0; m < 4; ++m)
#pragma unroll
                    for (int n = 0; n < 2; ++n) acc[a][b][m][n] = (f32x4){0.f, 0.f, 0.f, 0.f};
        cur = nxt; cA = nA; cB = nB; ++ui;
        if constexpr (ALIGN_EPI) { if (wr == 1) PG8_BAR; }
    }
    PG8_WAIT_V(0);
    if constexpr (!ALIGN_EPI) { if (wr == 0) PG8_BAR; }
    PG8_BAR;
    if constexpr (Epi::AFTER_DRAIN) { E.fused(acc, cur, wr, wc, fr, fq, lds, wid, lane); S.done(cur); }
#undef PG8_SA
#undef PG8_SB
#undef PG8_STAGE
#undef PG8_LDA
#undef PG8_LDB
#undef PG8_MMA
#undef PG8_WAIT_V
#undef PG8_WAIT_L
#undef PG8_BAR
#undef PG8_SCHED
}
}
#define GAS __attribute__((address_space(1)))
#define LAS __attribute__((address_space(3)))
typedef unsigned short bf16;
typedef unsigned v4u __attribute__((ext_vector_type(4)));
typedef float f32x4 __attribute__((ext_vector_type(4)));
typedef short bf16x8 __attribute__((ext_vector_type(8)));
typedef GAS unsigned gu32;
typedef GAS unsigned long long gu64;
#define RLX_AGENT __ATOMIC_RELAXED, __HIP_MEMORY_SCOPE_AGENT
#define LDS_WAIT() asm volatile("s_waitcnt lgkmcnt(0)" ::: "memory")
#define VM_WAIT() asm volatile("s_waitcnt vmcnt(0)" ::: "memory")
__device__ __forceinline__ unsigned long long rt() { return __builtin_amdgcn_s_memrealtime(); }
__device__ __forceinline__ unsigned f2bf(float f) { unsigned u = __builtin_bit_cast(unsigned, f); return (u + 0x7fffu + ((u >> 16) & 1u)) >> 16; }
__device__ __forceinline__ unsigned pk2(float lo, float hi) { return f2bf(lo) | (f2bf(hi) << 16); }

#define XB_TMO      128
#define XB_XCNT(j)  (256  + 64 * (j))
#define XB_XSUB(j)  (1280 + 64 * (j))
#define XB_XGEN(j)  (2304 + 64 * (j))
#define XB_TOP      3328
#define XB_TOPGEN   3392
#define XCD_BAR_WORDS 3456
#define XB_SPIN_CAP (1u << 18)

__device__ __forceinline__ unsigned xb_ld(unsigned* p)              { return __hip_atomic_load(p, __ATOMIC_RELAXED, __HIP_MEMORY_SCOPE_AGENT); }
__device__ __forceinline__ unsigned xb_add(unsigned* p, unsigned v) { return __hip_atomic_fetch_add(p, v, __ATOMIC_RELAXED, __HIP_MEMORY_SCOPE_AGENT); }
__device__ __forceinline__ unsigned xb_xcc_id() { return (unsigned)__builtin_amdgcn_s_getreg((3 << 11) | 20) & 0xFu; }
#define XB_SPIN(cond, bar) do { unsigned _sp = 0; while (cond) { __builtin_amdgcn_s_sleep(1); \
    if ((++_sp & 255u) == 0u) { if (xb_ld(&(bar)[XB_TMO])) break; if (_sp > XB_SPIN_CAP) { atomicAdd(&(bar)[XB_TMO], 1u); break; } } } } while (0)

struct XcdBarrier {
    unsigned wv;
    unsigned* bar; unsigned x;
    volatile LAS unsigned* st;
};

__device__ __forceinline__ bool xb_thread0(unsigned wv) { unsigned z = 0u; asm volatile("" : "+v"(z)); return wv == 0u && __builtin_amdgcn_mbcnt_hi(~0u, __builtin_amdgcn_mbcnt_lo(~0u, z)) == 0u; }
__device__ __forceinline__ XcdBarrier xcd_barrier_post(unsigned* bar, volatile LAS unsigned* st, unsigned wv) {
    XcdBarrier b; b.wv = wv; b.bar = bar; b.x = (unsigned)__builtin_amdgcn_readfirstlane((int)xb_xcc_id());     b.st = st;
    if (xb_thread0(wv)) (void)xb_add(&bar[XB_XCNT(b.x)], 1u);
    return b;
}
__device__ __forceinline__ void xcd_barrier_complete(unsigned* bar, unsigned x, unsigned& nloc, unsigned& nx) {
    const unsigned G = gridDim.x * gridDim.y * gridDim.z;
    unsigned sum, cnt, mine, sp = 0u;
    for (;;) {
        sum = 0u; cnt = 0u; mine = 0u;
#pragma unroll
        for (unsigned j = 0; j < 16; ++j) { const unsigned c = xb_ld(&bar[XB_XCNT(j)]); sum += c; cnt += (c > 0u) ? 1u : 0u; mine = (j == x) ? c : mine; }
        if (sum == G) break;
        __builtin_amdgcn_s_sleep(1);
        if ((++sp & 255u) == 0u) { if (xb_ld(&bar[XB_TMO])) break; if (sp > XB_SPIN_CAP) { atomicAdd(&bar[XB_TMO], 1u); break; } }
    }
    nloc = mine > 0u ? mine : 1u; nx = cnt > 0u ? cnt : 1u;
}

__device__ __forceinline__ void xcd_barrier(const XcdBarrier& b) {
    asm volatile("s_waitcnt vmcnt(0)" ::: "memory");
    __syncthreads();
    if (xb_thread0(b.wv)) {
        unsigned* bar = b.bar;
        __builtin_amdgcn_s_waitcnt(0);
        unsigned nloc = b.st[0], nx = b.st[1];
        if (nloc == 0u) { xcd_barrier_complete(bar, b.x, nloc, nx); b.st[0] = nloc; b.st[1] = nx; }
        const unsigned old = xb_add(&bar[XB_XSUB(b.x)], 1u);
        const unsigned gen = old / nloc;
        if (old + 1u == (gen + 1u) * nloc) {
            __builtin_amdgcn_fence(__ATOMIC_RELEASE, "agent");
            asm volatile("s_waitcnt vmcnt(0)" ::: "memory");
            const unsigned og = xb_add(&bar[XB_TOP], 1u);
            const unsigned tg = og / nx;
            if (og + 1u == (tg + 1u) * nx) xb_add(&bar[XB_TOPGEN], 1u);
            else XB_SPIN(xb_ld(&bar[XB_TOPGEN]) == tg, bar);
            __builtin_amdgcn_fence(__ATOMIC_ACQUIRE, "agent");
            xb_add(&bar[XB_XGEN(b.x)], 1u);
            asm volatile("s_waitcnt vmcnt(0)" ::: "memory");
        } else {
            XB_SPIN(xb_ld(&bar[XB_XGEN(b.x)]) == gen, bar);
            __builtin_amdgcn_fence(__ATOMIC_ACQUIRE, "agent");
            asm volatile("s_waitcnt vmcnt(0)" ::: "memory");
        }
    }
    __syncthreads();
}

#define GB_XCNT(j, g) (64 * ((j) * 8 + (g)))
#define GB_XSUB(j, g) (8192 + 64 * ((j) * 8 + (g)))
#define GB_XGEN(j, g) (16384 + 64 * ((j) * 8 + (g)))
#define GB_TOP(g)     (24576 + 64 * (g))
#define GB_TOPGEN(g)  (25088 + 64 * (g))
#define GRP_BAR_WORDS 25600
struct GrpBarrier { unsigned wv; unsigned* bar; unsigned* gb; unsigned x, g, gsize; volatile LAS unsigned* st; };
__device__ __forceinline__ GrpBarrier grp_barrier_post(unsigned* bar, unsigned* gb, volatile LAS unsigned* st, unsigned wv, unsigned g, unsigned gsize) {
    GrpBarrier b; b.wv = wv; b.bar = bar; b.gb = gb; b.x = (unsigned)__builtin_amdgcn_readfirstlane((int)xb_xcc_id()); b.g = g; b.gsize = gsize; b.st = st;
    if (xb_thread0(wv)) (void)xb_add(&gb[GB_XCNT(b.x, g)], 1u);
    return b;
}
__device__ __forceinline__ void grp_barrier_complete(const GrpBarrier& b, unsigned& nloc, unsigned& nx) {
    unsigned sum, cnt, mine, sp = 0u;
    for (;;) {
        sum = 0u; cnt = 0u; mine = 0u;
#pragma unroll
        for (unsigned j = 0; j < 16; ++j) { const unsigned c = xb_ld(&b.gb[GB_XCNT(j, b.g)]); sum += c; cnt += (c > 0u) ? 1u : 0u; mine = (j == b.x) ? c : mine; }
        if (sum == b.gsize) break;
        __builtin_amdgcn_s_sleep(1);
        if ((++sp & 255u) == 0u) { if (xb_ld(&b.bar[XB_TMO])) break; if (sp > XB_SPIN_CAP) { atomicAdd(&b.bar[XB_TMO], 1u); break; } }
    }
    nloc = mine > 0u ? mine : 1u; nx = cnt > 0u ? cnt : 1u;
}
__device__ __forceinline__ void grp_barrier(const GrpBarrier& b) {
    asm volatile("s_waitcnt vmcnt(0)" ::: "memory");
    __syncthreads();
    if (xb_thread0(b.wv)) {
        unsigned* gb = b.gb; unsigned* bar = b.bar;
        __builtin_amdgcn_s_waitcnt(0);
        unsigned nloc = b.st[0], nx = b.st[1];
        if (nloc == 0u) { grp_barrier_complete(b, nloc, nx); b.st[0] = nloc; b.st[1] = nx; }
        const unsigned old = xb_add(&gb[GB_XSUB(b.x, b.g)], 1u);
        const unsigned gen = old / nloc;
        if (old + 1u == (gen + 1u) * nloc) {
            __builtin_amdgcn_fence(__ATOMIC_RELEASE, "agent");
            asm volatile("s_waitcnt vmcnt(0)" ::: "memory");
            if (nx > 1u) {
                const unsigned og = xb_add(&gb[GB_TOP(b.g)], 1u);
                const unsigned tg = og / nx;
                if (og + 1u == (tg + 1u) * nx) xb_add(&gb[GB_TOPGEN(b.g)], 1u);
                else XB_SPIN(xb_ld(&gb[GB_TOPGEN(b.g)]) == tg, bar);
            }
            __builtin_amdgcn_fence(__ATOMIC_ACQUIRE, "agent");
            xb_add(&gb[GB_XGEN(b.x, b.g)], 1u);
            asm volatile("s_waitcnt vmcnt(0)" ::: "memory");
        } else {
            XB_SPIN(xb_ld(&gb[GB_XGEN(b.x, b.g)]) == gen, bar);
            __builtin_amdgcn_fence(__ATOMIC_ACQUIRE, "agent");
            asm volatile("s_waitcnt vmcnt(0)" ::: "memory");
        }
    }
    __syncthreads();
}
constexpr int NWAVES = 8;
constexpr int BATCH = 32, T = 2048, D = 1024, FF = 2816, NL = 2;
constexpr int M = BATCH * T;
constexpr int DIN = 3784;
constexpr int ZN = 3840;
constexpr int ZP = ZN;
constexpr int ZA = 1792, ZGN = 2048;
constexpr int Z_Q = 0, Z_QI = 512, Z_PI = 1024, Z_CKV = 1536, Z_KI = 1664, Z_WI = 1728;
constexpr int R_GA = 1792, R_GB = 2816;
constexpr int S_Q = 0, S_CKV = 512, S_QI = 640, S_KI = 1152, S_WI = 1216, S_PI = 1224, S_GA = 1736, S_GB = 2760;
constexpr float EPS = 1e-6f;
constexpr float IDX_SCALE = 0.044194173824159216f;
constexpr float QSCALE = 0.125f * 1.4426950408889634f;

constexpr size_t MiB = 1u << 20;
constexpr size_t WS_CTL = 0, CTL_ZERO_BYTES = 1 * MiB;
constexpr size_t WS_W = 1 * MiB, LW = 46 * MiB + MiB / 2;
constexpr size_t O_WGU1 = 0, O_WD1 = 11 * MiB, O_WIN = 16 * MiB + MiB / 2, O_WUK = 24 * MiB  , O_WUV = 24 * MiB + MiB / 4, O_WA = 25 * MiB, O_WP = 27 * MiB, O_WO = 28 * MiB, O_WGU2 = 30 * MiB, O_WD2 = 41 * MiB;
constexpr size_t WS_XR = 96 * MiB;
constexpr size_t WS_ZA = 224 * MiB;
constexpr size_t WS_OL = 768 * MiB;
constexpr size_t WS_PO = 896 * MiB;
constexpr size_t WS_CK = 960 * MiB;
constexpr size_t WS_MASK = 976 * MiB;
constexpr size_t WS_SSQ = 992 * MiB;
constexpr size_t WS_END = 996 * MiB;
static_assert(WS_W + NL * LW <= WS_XR && WS_XR + (size_t)M * D * 2 <= WS_ZA && WS_ZA + (size_t)M * ZP * 2 <= WS_OL && FF <= ZP && ZA + ZGN == ZP, "d_ws map");
static_assert(O_WD2 + (size_t)D * FF * 2 <= LW && O_WIN + (size_t)ZN * D * 2 <= O_WUK, "weight map");
constexpr int CW_TMO = 0, CW_CODE = 1, CW_BAR = 4096, CW_GBAR = 8192, CW_FIN = 40960;

constexpr int RING_OFF = 0, RING_BYTES = 131072;
constexpr int LDSCTL_OFF = RING_BYTES, MISC_OFF = LDSCTL_OFF + 320;
constexpr int RSTAB_OFF = LDSCTL_OFF + 512, RSTAB_SLOTS = 8, PMAP_OFF = RSTAB_OFF + RSTAB_SLOTS * 1024, PLIST_OFF = PMAP_OFF + 256;
constexpr int LDS_BYTES = 147456;

struct Args { const float* in[20]; float* out; unsigned char* ws; };
typedef const Args __attribute__((address_space(4)))* cargs_t;
struct Frame {
    LAS unsigned char* lds;
    volatile LAS unsigned* MISC;
    gu32* ctl;
    int wave;
    int vcu, G;
};

typedef unsigned u32x4 __attribute__((ext_vector_type(4)));
typedef unsigned u32x2 __attribute__((ext_vector_type(2)));
typedef float f32x16 __attribute__((ext_vector_type(16)));
typedef short s16x4 __attribute__((ext_vector_type(4)));
using pg8::pk_bf16; using pg8::bf_lo; using pg8::bf_hi;

__device__ __forceinline__ float shx(float v, int m, int lane) { return __int_as_float(__builtin_amdgcn_ds_bpermute((lane ^ m) << 2, __float_as_int(v))); }
__device__ __forceinline__ float wave_sum(float v, int lane) {
#pragma unroll
    for (int o = 1; o < 64; o <<= 1) v += shx(v, o, lane);
    return v;
}
__device__ __forceinline__ int sopq(int v) { asm volatile("" : "+s"(v)); return v; }

__device__ __forceinline__ void tr_item(const float* W, int ldw, int c0, int k0, bf16* WT, int Kd, int drow0, LAS float* scr, int lane, const float* gk = nullptr) {
    const int kr = lane >> 3, c4 = 4 * (lane & 7);
    f32x4 t[16]; float gg[16];
#pragma unroll
    for (int i = 0; i < 16; ++i) t[i] = *(const GAS f32x4*)(W + (size_t)(k0 + 8 * i + kr) * ldw + c0 + c4);
#pragma unroll
    for (int i = 0; i < 16; ++i) gg[i] = gk ? gk[k0 + 8 * i + kr] : 1.0f;
#pragma unroll
    for (int h = 0; h < 2; ++h) {
#pragma unroll
        for (int i = 0; i < 8; ++i) { LAS float* d = scr + (8 * i + kr) * 33 + c4; const f32x4 v = t[8 * h + i]; const float g = gg[8 * h + i]; d[0] = v.x * g; d[1] = v.y * g; d[2] = v.z * g; d[3] = v.w * g; }
        LDS_WAIT(); asm volatile("" ::: "memory");
        const int c = lane & 7;
#pragma unroll
        for (int j = 0; j < 4; ++j) { const int n = (lane >> 3) + 8 * j; const LAS float* sp = scr + (8 * c) * 33 + n;
            v4u o; o.x = pk_bf16(sp[0 * 33], sp[1 * 33]); o.y = pk_bf16(sp[2 * 33], sp[3 * 33]); o.z = pk_bf16(sp[4 * 33], sp[5 * 33]); o.w = pk_bf16(sp[6 * 33], sp[7 * 33]);
            *(GAS v4u*)(WT + (size_t)(drow0 + n) * Kd + k0 + 64 * h + 8 * c) = o; }
        LDS_WAIT(); asm volatile("" ::: "memory");
    }
}
constexpr int I_GU = 8 * 88, I_DN = 22 * 32, I_WO = 8 * 32, I_WIN = 8 * 119, I_ZERO = 1, I_QL = 128  , I_WA = 4 * 32   + 128  , I_WP = 1024;
constexpr int I_LAYER = 6 * I_GU + I_WO + I_WIN + I_ZERO + I_QL + I_WA + I_WP;
static_assert(I_GU == I_DN, "item counts");

__device__ __forceinline__ void prologue_item(cargs_t ka, int it, LAS float* scr, int lane) {
    const float* const __attribute__((address_space(4)))* in = ka->in; unsigned char* ws = ka->ws;
    int l, r;
    if (it < NL * I_WP) { l = it / I_WP; r = I_WA + (it - l * I_WP); }
    else { const int it2 = it - NL * I_WP; l = it2 / (I_LAYER - I_WP); r = it2 - l * (I_LAYER - I_WP); if (r >= I_WA) r += I_WP; }
    unsigned char* wl = ws + WS_W + (size_t)l * LW;
    if (r < I_WA) {
        if (r < 128) { const int kb = r / 32, nb = r % 32; tr_item(in[12] + (size_t)l * 512 * 1024, 1024, 32 * nb, 128 * kb, (bf16*)(wl + O_WA), 512, 32 * nb, scr, lane); return; }
        { const int q = r - 128, head = q >> 4, rt = (q >> 3) & 1, ks = q & 7, rr = lane & 31, h = lane >> 5;
          const float* wuv = in[9] + (size_t)l * 128 * 8 * 64 + (size_t)head * 64 + 32 * rt + rr;
          float v[8];
#pragma unroll
          for (int jj = 0; jj < 8; ++jj) v[jj] = wuv[(size_t)(16 * ks + 8 * h + jj) * 8 * 64];
          v4u o; o.x = pk_bf16(v[0], v[1]); o.y = pk_bf16(v[2], v[3]); o.z = pk_bf16(v[4], v[5]); o.w = pk_bf16(v[6], v[7]);
          *(GAS v4u*)((bf16*)(wl + O_WUV) + ((((size_t)(head * 2 + rt) * 8 + ks) * 32 + rr) * 2 + h) * 8) = o; } return; }
    r -= I_WA;
    if (r < I_WP) {
        const int g = r >> 8, cb = (r >> 4) & 15, ib = r & 15, n = 64 * ib + lane;
        const float* pw = in[10] + (size_t)l * 4 * 128 * 128; const float* ps = in[11] + (size_t)l * 512; const float* wbp = in[13] + (size_t)l * 512 * 1024;
        float a[8];
#pragma unroll
        for (int j = 0; j < 8; ++j) a[j] = 0.f;
#pragma unroll 32
        for (int d = 0; d < 128; ++d) { const float wv = wbp[(size_t)(g * 128 + d) * 1024 + n] * ps[g * 128 + d];
#pragma unroll
            for (int j = 0; j < 8; ++j) a[j] += pw[(size_t)(g * 128 + 8 * cb + j) * 128 + d] * wv; }
        v4u o; o.x = pk_bf16(a[0], a[1]); o.y = pk_bf16(a[2], a[3]); o.z = pk_bf16(a[4], a[5]); o.w = pk_bf16(a[6], a[7]);
        *(GAS v4u*)((bf16*)(wl + O_WP) + (size_t)n * 512 + g * 128 + 8 * cb) = o; return; }
    r -= I_WP;
    if (r < I_QL) {
        const int hh = r >> 4, c = 8 * (r & 15) + (lane >> 3), d0 = 8 * (lane & 7);
        const f32x4* src = (const f32x4*)(in[8] + (size_t)l * 128 * 8 * 64 + (size_t)(c * 8 + hh) * 64 + d0); const f32x4 x = src[0], y = src[1];
        v4u o; o.x = pk_bf16(x.x * QSCALE, x.y * QSCALE); o.y = pk_bf16(x.z * QSCALE, x.w * QSCALE); o.z = pk_bf16(y.x * QSCALE, y.y * QSCALE); o.w = pk_bf16(y.z * QSCALE, y.w * QSCALE);
        *(GAS v4u*)((bf16*)(wl + O_WUK) + ((((size_t)hh * 4 + (c >> 5)) * 4 + (d0 >> 4)) * 64 + (c & 31) + 32 * ((d0 >> 3) & 1)) * 8) = o; return; }
    r -= I_QL;
    if (r < I_GU) { const int kb = r / 88, nb = r % 88, n0 = 32 * nb; tr_item(in[2] + (size_t)l * D * FF, FF, n0, 128 * kb, (bf16*)(wl + O_WGU1), D, 256 * (n0 >> 7) + (n0 & 127), scr, lane, in[1] + (size_t)l * D); return; }
    r -= I_GU;
    if (r < I_GU) { const int kb = r / 88, nb = r % 88, n0 = 32 * nb; tr_item(in[3] + (size_t)l * D * FF, FF, n0, 128 * kb, (bf16*)(wl + O_WGU1), D, 256 * (n0 >> 7) + 128 + (n0 & 127), scr, lane, in[1] + (size_t)l * D); return; }
    r -= I_GU;
    if (r < I_DN) { const int kb = r / 32, nb = r % 32; tr_item(in[4] + (size_t)l * FF * D, D, 32 * nb, 128 * kb, (bf16*)(wl + O_WD1), FF, 32 * nb, scr, lane); return; }
    r -= I_DN;
    if (r < I_GU) { const int kb = r / 88, nb = r % 88, n0 = 32 * nb; tr_item(in[16] + (size_t)l * D * FF, FF, n0, 128 * kb, (bf16*)(wl + O_WGU2), D, 256 * (n0 >> 7) + (n0 & 127), scr, lane, in[15] + (size_t)l * D); return; }
    r -= I_GU;
    if (r < I_GU) { const int kb = r / 88, nb = r % 88, n0 = 32 * nb; tr_item(in[17] + (size_t)l * D * FF, FF, n0, 128 * kb, (bf16*)(wl + O_WGU2), D, 256 * (n0 >> 7) + 128 + (n0 & 127), scr, lane, in[15] + (size_t)l * D); return; }
    r -= I_GU;
    if (r < I_DN) { const int kb = r / 32, nb = r % 32; tr_item(in[18] + (size_t)l * FF * D, D, 32 * nb, 128 * kb, (bf16*)(wl + O_WD2), FF, 32 * nb, scr, lane); return; }
    r -= I_DN;
    if (r < I_WO) { const int kb = r / 32, nb = r % 32; tr_item(in[14] + (size_t)l * D * D, D, 32 * nb, 128 * kb, (bf16*)(wl + O_WO), D, 32 * nb, scr, lane); return; }
    r -= I_WO;
    if (r < I_WIN) {
        const int kb = r / 119, v = 32 * (r % 119); int c0, d0;
        if (v < 512) { c0 = S_Q + v; d0 = Z_Q + v; }
        else if (v < 1024) { c0 = S_QI + (v - 512); d0 = Z_QI + (v - 512); }
        else if (v < 1536) { c0 = S_PI + (v - 1024); d0 = Z_PI + (v - 1024); }
        else if (v < 2560) { c0 = S_GA + (v - 1536); d0 = R_GA + (v - 1536); }
        else if (v < 3584) { c0 = S_GB + (v - 2560); d0 = R_GB + (v - 2560); }
        else if (v < 3712) { c0 = S_CKV + (v - 3584); d0 = Z_CKV + (v - 3584); }
        else { c0 = S_KI + (v - 3712); d0 = Z_KI + (v - 3712); }
        tr_item(in[6] + (size_t)l * D * DIN, DIN, c0, 128 * kb, (bf16*)(wl + O_WIN), D, d0, scr, lane, in[5] + (size_t)l * D); return; }
    r -= I_WIN;
    {
        v4u z; z.x = 0u; z.y = 0u; z.z = 0u; z.w = 0u; GAS v4u* p = (GAS v4u*)((bf16*)(wl + O_WIN) + (size_t)(Z_KI + 96) * D);
        for (int i = lane; i < 32 * D / 8; i += 64) p[i] = z; }
}

__device__ __forceinline__ void xr_init_phase(const float* src, bf16* xr_out, float* ssq, int gw, int NGW, int lane) {
    for (int m0 = gw; m0 < M; m0 += 2 * NGW) {
        f32x4 v[2][4]; float s[2];
#pragma unroll
        for (int r = 0; r < 2; ++r) { const int m = m0 + r * NGW < M ? m0 + r * NGW : m0; const GAS f32x4* xr = (const GAS f32x4*)(src + (size_t)m * D) + lane; s[r] = 0.f;
#pragma unroll
            for (int j = 0; j < 4; ++j) { v[r][j] = xr[64 * j]; s[r] += (v[r][j].x * v[r][j].x + v[r][j].y * v[r][j].y) + (v[r][j].z * v[r][j].z + v[r][j].w * v[r][j].w); } }
#pragma unroll
        for (int r = 0; r < 2; ++r) { const int m = m0 + r * NGW; if (m < M) {
            const float tot = wave_sum(s[r], lane);
            GAS u32x2* x8 = (GAS u32x2*)(xr_out + (size_t)m * D) + lane;
#pragma unroll
            for (int j = 0; j < 4; ++j) { u32x2 q; q.x = pk_bf16(v[r][j].x, v[r][j].y); q.y = pk_bf16(v[r][j].z, v[r][j].w); x8[64 * j] = q; }
            if (lane < 16) ssq[(size_t)m * 16 + lane] = lane == 0 ? tot : 0.f; } }
    }
}
template <class Sched> __device__ __forceinline__ void rstab_fill(LAS unsigned char* lds, const Sched& S, const float* ssq, int tid) {
    LAS unsigned char* pmap = lds + PMAP_OFF; LAS int* plist = (LAS int*)(lds + PLIST_OFF); LAS float* tab = (LAS float*)(lds + RSTAB_OFF);
    if (tid < 256) pmap[tid] = 0xff;
    __syncthreads();
    if (S.G == 256 && S.nM == 256) {
        if (tid < 4) { const int pm = 32 * (S.c & 7) + 8 * tid + ((S.c >> 3) & 7); pmap[pm] = (unsigned char)tid; plist[tid] = pm; }
        if (tid == 0) plist[RSTAB_SLOTS] = 4;
    } else if (tid == 0) { int np = 0; pg8::Unit u;
        for (int i = 0; S.next(i, u); ++i) if (pmap[u.pm] == 0xff && np < RSTAB_SLOTS) { pmap[u.pm] = (unsigned char)np; plist[np] = u.pm; ++np; }
        plist[RSTAB_SLOTS] = np; }
    __syncthreads();
    const int np = plist[RSTAB_SLOTS + (tid >> 16)];
    for (int e = tid; e < np * 256; e += NWAVES * 64) { const int slot = e >> 8, row = e & 255; const size_t m = (size_t)plist[slot] * 256 + row;
        const GAS f32x4* p = (const GAS f32x4*)(ssq + m * 16); const f32x4 a = p[0], b = p[1], c = p[2], d = p[3];
        const float t = (((a.x + a.y) + (a.z + a.w)) + ((b.x + b.y) + (b.z + b.w))) + (((c.x + c.y) + (c.z + c.w)) + ((d.x + d.y) + (d.z + d.w)));
        tab[e] = 1.f / sqrtf(t * (1.f / D) + EPS); }
    __syncthreads();
}
__device__ __forceinline__ void final_norm_phase(const bf16* src, float* out, const float* g, int rbase, int rcnt, int gw, int NGW, int lane, bool poison) {
    f32x4 gv[4];
#pragma unroll
    for (int j = 0; j < 4; ++j) gv[j] = ((const f32x4*)g)[64 * j + lane];
    const float qnan = __builtin_nanf("");
    const int m_end = rbase + rcnt;
    for (int m0 = rbase + gw; m0 < m_end; m0 += 4 * NGW) {
        u32x2 w[4][4];
#pragma unroll
        for (int r = 0; r < 4; ++r) { const int m = m0 + r * NGW < m_end ? m0 + r * NGW : m0; const GAS u32x2* xr = (const GAS u32x2*)(src + (size_t)m * D) + lane;
#pragma unroll
            for (int j = 0; j < 4; ++j) w[r][j] = xr[64 * j]; }
#pragma unroll
        for (int r = 0; r < 4; ++r) { const int m = m0 + r * NGW; if (m < m_end) {
            f32x4 v[4]; float s = 0.f;
#pragma unroll
            for (int j = 0; j < 4; ++j) { v[j].x = bf_lo(w[r][j].x); v[j].y = bf_hi(w[r][j].x); v[j].z = bf_lo(w[r][j].y); v[j].w = bf_hi(w[r][j].y); s += (v[j].x * v[j].x + v[j].y * v[j].y) + (v[j].z * v[j].z + v[j].w * v[j].w); }
            float rstd = 1.f / sqrtf(wave_sum(s, lane) * (1.f / D) + EPS);
            if (poison) rstd = qnan;
            GAS f32x4* o = (GAS f32x4*)(out + (size_t)m * D) + lane;
#pragma unroll
            for (int j = 0; j < 4; ++j) o[64 * j] = v[j] * rstd * gv[j]; } }
    }
}
__device__ __forceinline__ void prep_phase(const bf16* Z, const float* gkv, bf16* CK, bf16* PO, int rbase, int rcnt, int gw, int NGW, int lane) {
    {
        const int sub = lane >> 4, ch = lane & 15;
        float gk[8];
#pragma unroll
        for (int e = 0; e < 8; ++e) gk[e] = gkv[8 * ch + e];
        const int q_end = (rbase + rcnt) / 4;
        for (int r0 = rbase / 4 + gw; r0 < q_end; r0 += 4 * NGW) {
            u32x4 w[4];
#pragma unroll
            for (int q = 0; q < 4; ++q) { const int r4 = r0 + q * NGW < q_end ? r0 + q * NGW : r0; w[q] = *(const GAS u32x4*)(Z + ((size_t)r4 * 4 + sub) * ZP + Z_CKV + 8 * ch); }
#pragma unroll
            for (int q = 0; q < 4; ++q) {
                const int r4 = r0 + q * NGW; if (r4 < q_end) {
                const size_t m = (size_t)r4 * 4 + sub;
                float x[8] = {bf_lo(w[q].x), bf_hi(w[q].x), bf_lo(w[q].y), bf_hi(w[q].y), bf_lo(w[q].z), bf_hi(w[q].z), bf_lo(w[q].w), bf_hi(w[q].w)};
                float s = 0.f;
#pragma unroll
                for (int e = 0; e < 8; ++e) s += x[e] * x[e];
                s += shx(s, 1, lane); s += shx(s, 2, lane); s += shx(s, 4, lane); s += shx(s, 8, lane);
                const float rstd = 1.f / sqrtf(s * (1.f / 128.f) + EPS);
                u32x2 o0, o1; o0.x = pk_bf16(x[0] * rstd * gk[0], x[1] * rstd * gk[1]); o0.y = pk_bf16(x[2] * rstd * gk[2], x[3] * rstd * gk[3]);
                o1.x = pk_bf16(x[4] * rstd * gk[4], x[5] * rstd * gk[5]); o1.y = pk_bf16(x[6] * rstd * gk[6], x[7] * rstd * gk[7]);
                const int pbase = 16 * (ch >> 1) + 4 * (ch & 1);
                *(GAS u32x2*)(CK + m * 128 + pbase) = o0; *(GAS u32x2*)(CK + m * 128 + pbase + 8) = o1; }
            }
        }
    }
    {
        const int wdw = 2 << (lane >> 4);
        const float m4 = wdw >= 4 ? 1.f : 0.f, m8 = wdw >= 8 ? 1.f : 0.f, m16 = wdw >= 16 ? 1.f : 0.f;
        for (int blk = rbase / 8 + gw; blk < (rbase + rcnt) / 8; blk += NGW) {
            const int m0 = 8 * blk, t0 = m0 & (T - 1);
            u32x4 xr[23];
#pragma unroll
            for (int i = 0; i < 23; ++i) { int mr = m0 - 15 + i; mr = mr < m0 - t0 ? m0 - t0 : mr;     xr[i] = *(const GAS u32x4*)(Z + (size_t)mr * ZP + Z_PI + 8 * lane); }
            unsigned ow[8][4];
#pragma unroll
            for (int h = 0; h < 2; ++h) {
                float a[23][4];
#pragma unroll
                for (int i = 0; i < 23; ++i) { const unsigned w0 = h ? xr[i].z : xr[i].x, w1 = h ? xr[i].w : xr[i].y; a[i][0] = bf_lo(w0); a[i][1] = bf_hi(w0); a[i][2] = bf_lo(w1); a[i][3] = bf_hi(w1); }
#pragma unroll
                for (int i = 22; i >= 1; --i)
#pragma unroll
                    for (int e = 0; e < 4; ++e) a[i][e] += a[i - 1][e];
#pragma unroll
                for (int i = 22; i >= 3; --i)
#pragma unroll
                    for (int e = 0; e < 4; ++e) a[i][e] = fmaf(a[i - 2][e], m4, a[i][e]);
#pragma unroll
                for (int i = 22; i >= 7; --i)
#pragma unroll
                    for (int e = 0; e < 4; ++e) a[i][e] = fmaf(a[i - 4][e], m8, a[i][e]);
#pragma unroll
                for (int i = 22; i >= 15; --i)
#pragma unroll
                    for (int e = 0; e < 4; ++e) a[i][e] = fmaf(a[i - 8][e], m16, a[i][e]);
#pragma unroll
                for (int r = 0; r < 8; ++r) {
                    const int t = t0 + r; const int cnt = (t + 1) < wdw ? (t + 1) : wdw;
                    const float inv = 1.f / (float)cnt, nab = -(float)(wdw - cnt);
                    const unsigned s0 = h ? xr[15 + r].z : xr[15 + r].x, s1 = h ? xr[15 + r].w : xr[15 + r].y;
                    ow[r][2 * h] = pk_bf16(fmaf(nab, a[0][0], a[15 + r][0]) * inv - bf_lo(s0), fmaf(nab, a[0][1], a[15 + r][1]) * inv - bf_hi(s0));
                    ow[r][2 * h + 1] = pk_bf16(fmaf(nab, a[0][2], a[15 + r][2]) * inv - bf_lo(s1), fmaf(nab, a[0][3], a[15 + r][3]) * inv - bf_hi(s1));
                }
            }
#pragma unroll
            for (int r = 0; r < 8; ++r) { u32x4 o; o.x = ow[r][0]; o.y = ow[r][1]; o.z = ow[r][2]; o.w = ow[r][3]; *(GAS u32x4*)(PO + (size_t)(m0 + r) * 512 + 8 * lane) = o; }
        }
    }
}

__device__ __forceinline__ bool mix_unit(int i, int vcu, int G, int& b, int& qb) {
    const int U = vcu + i * G; if (U >= BATCH * 64) return false;
    const int ii = U >> 8, r = U & 7; b = (U & 255) >> 3; qb = (ii & 1) ? 16 * (ii >> 1) + 15 - r : 16 * (ii >> 1) + r; return true;
}
__device__ __forceinline__ unsigned fkey(float s) { const unsigned u = __float_as_uint(s); return (u & 0x80000000u) ? ~u : (u | 0x80000000u); }
__device__ __forceinline__ float funkey(unsigned k) { return __uint_as_float((k & 0x80000000u) ? (k & 0x7fffffffu) : ~k); }
__device__ __forceinline__ unsigned half_sum(unsigned v, int hh) {
    v += (unsigned)__builtin_amdgcn_update_dpp(0, (int)v, 0xB1, 0xF, 0xF, false);
    v += (unsigned)__builtin_amdgcn_update_dpp(0, (int)v, 0x4E, 0xF, 0xF, false);
    v += (unsigned)__builtin_amdgcn_update_dpp(0, (int)v, 0x141, 0xF, 0xF, false);
    v += (unsigned)__builtin_amdgcn_update_dpp(0, (int)v, 0x140, 0xF, 0xF, false);
    const unsigned a = __builtin_amdgcn_readlane(v, 0) + __builtin_amdgcn_readlane(v, 16), b = __builtin_amdgcn_readlane(v, 32) + __builtin_amdgcn_readlane(v, 48);
    return hh ? b : a;
}
__device__ __forceinline__ float half_fsum(float v, int hh);
__device__ __forceinline__ float rl_f(float v, int l) { return __uint_as_float((unsigned)__builtin_amdgcn_readlane((int)__float_as_uint(v), l)); }
__device__ __forceinline__ float half_max(float v, int hh) {
    v = fmaxf(v, __builtin_amdgcn_update_dpp(v, v, 0xB1, 0xF, 0xF, false)); v = fmaxf(v, __builtin_amdgcn_update_dpp(v, v, 0x4E, 0xF, 0xF, false));
    v = fmaxf(v, __builtin_amdgcn_update_dpp(v, v, 0x141, 0xF, 0xF, false)); v = fmaxf(v, __builtin_amdgcn_update_dpp(v, v, 0x140, 0xF, 0xF, false));
    const float a = fmaxf(rl_f(v, 0), rl_f(v, 16)), b = fmaxf(rl_f(v, 32), rl_f(v, 48));
    return hh ? b : a;
}
__device__ __forceinline__ float half_fsum(float v, int hh) {
    v += __builtin_amdgcn_update_dpp(0.f, v, 0xB1, 0xF, 0xF, false); v += __builtin_amdgcn_update_dpp(0.f, v, 0x4E, 0xF, 0xF, false);
    v += __builtin_amdgcn_update_dpp(0.f, v, 0x141, 0xF, 0xF, false); v += __builtin_amdgcn_update_dpp(0.f, v, 0x140, 0xF, 0xF, false);
    const float a = rl_f(v, 0) + rl_f(v, 16), b = rl_f(v, 32) + rl_f(v, 48);
    return hh ? b : a;
}
__device__ __forceinline__ float half_min(float v, int hh) {
    v = fminf(v, __builtin_amdgcn_update_dpp(v, v, 0xB1, 0xF, 0xF, false)); v = fminf(v, __builtin_amdgcn_update_dpp(v, v, 0x4E, 0xF, 0xF, false));
    v = fminf(v, __builtin_amdgcn_update_dpp(v, v, 0x141, 0xF, 0xF, false)); v = fminf(v, __builtin_amdgcn_update_dpp(v, v, 0x140, 0xF, 0xF, false));
    const float a = fminf(rl_f(v, 0), rl_f(v, 16)), b = fminf(rl_f(v, 32), rl_f(v, 48));
    return hh ? b : a;
}
constexpr int SEL_STALL = 8;
__device__ __forceinline__ float sel_cand(float lo, float hi, float glo, float ghi) {
    float c = lo + (hi - lo) * (glo * __builtin_amdgcn_rcpf(glo - ghi));
    if (!(c > lo && c < hi)) c = funkey((fkey(lo) >> 1) + (fkey(hi) >> 1) + (fkey(lo) & fkey(hi) & 1u));
    return c;
}

__device__ __forceinline__ void select_unit(LAS unsigned char* kbuf, const bf16* Z, unsigned* MASK, int b, int qb, int wid, int lane_in) {
    int lane = lane_in; asm volatile("" : "+v"(lane));
    const int col = lane & 31, hh = lane >> 5;
    const size_t mb = (size_t)b * T + 32 * qb + 4 * wid;
    const int tql_r = 2 * (col >> 4) + ((col >> 2) & 1), j_r = 4 * ((col >> 3) & 1) + (col & 3);
    bf16x8 qa[4];
#pragma unroll
    for (int s = 0; s < 4; ++s) qa[s] = *(const GAS bf16x8*)(Z + (mb + tql_r) * ZP + Z_QI + j_r * 64 + 16 * s + 8 * hh);
    float wA[8], wB[8];
    { const u32x4 a = *(const GAS u32x4*)(Z + (mb + hh) * ZP + Z_WI), c = *(const GAS u32x4*)(Z + (mb + 2 + hh) * ZP + Z_WI);
      wA[0] = bf_lo(a.x) * IDX_SCALE; wA[1] = bf_hi(a.x) * IDX_SCALE; wA[2] = bf_lo(a.y) * IDX_SCALE; wA[3] = bf_hi(a.y) * IDX_SCALE;
      wA[4] = bf_lo(a.z) * IDX_SCALE; wA[5] = bf_hi(a.z) * IDX_SCALE; wA[6] = bf_lo(a.w) * IDX_SCALE; wA[7] = bf_hi(a.w) * IDX_SCALE;
      wB[0] = bf_lo(c.x) * IDX_SCALE; wB[1] = bf_hi(c.x) * IDX_SCALE; wB[2] = bf_lo(c.y) * IDX_SCALE; wB[3] = bf_hi(c.y) * IDX_SCALE;
      wB[4] = bf_lo(c.z) * IDX_SCALE; wB[5] = bf_hi(c.z) * IDX_SCALE; wB[6] = bf_lo(c.w) * IDX_SCALE; wB[7] = bf_hi(c.w) * IDX_SCALE; }
    const int dA = 32 * qb + 4 * wid + hh - col, dB = dA + 2;
    float sA[64], sB[64];
    const bf16* ksrc = Z + ((size_t)b * T + 32 * wid + (lane >> 3)) * ZP + Z_KI;
#define SEL_DMA_CHUNK(c_) do { _Pragma("unroll") for (int j_ = 0; j_ < 4; ++j_) \
        __builtin_amdgcn_global_load_lds((const unsigned*)(ksrc + ((size_t)(c_) * 256 + 8 * j_) * ZP + 8 * ((lane & 7) ^ ((4 * j_ + (lane >> 4)) & 7))), (LAS unsigned*)(kbuf + ((c_) & 3) * 32768 + (4 * wid + j_) * 1024), 16, 0, 0); } while (0)
    unsigned kof[4];
#pragma unroll
    for (int s = 0; s < 4; ++s) kof[s] = (unsigned)col * 128u + 16u * ((unsigned)(2 * s + hh) ^ (((unsigned)col >> 1) & 7u));
    asm volatile("s_waitcnt lgkmcnt(0)" ::: "memory"); __builtin_amdgcn_s_barrier(); asm volatile("" ::: "memory");
    SEL_DMA_CHUNK(0); if (8 <= qb) SEL_DMA_CHUNK(1); if (16 <= qb) SEL_DMA_CHUNK(2);
#pragma unroll
    for (int kt = 0; kt < 64; ++kt) { sA[kt] = -INFINITY; sB[kt] = -INFINITY; }
#pragma unroll
    for (int c8 = 0; c8 < 8; ++c8) {
        if (8 * c8 <= qb) {
            asm volatile("s_waitcnt vmcnt(0) lgkmcnt(0)" ::: "memory"); __builtin_amdgcn_s_barrier(); asm volatile("" ::: "memory");
            if (c8 + 3 < 8 && 8 * (c8 + 3) <= qb) SEL_DMA_CHUNK(c8 + 3);
            const LAS unsigned char* cb = kbuf + (c8 & 3) * 32768;
            bf16x8 kb[2][4]; f32x16 acc[2];
#pragma unroll
            for (int s = 0; s < 4; ++s) { kb[0][s] = *(const LAS bf16x8*)(cb + kof[s]); kb[1][s] = *(const LAS bf16x8*)(cb + 4096 + kof[s]); }
#pragma unroll
            for (int i = 0; i < 16; ++i) acc[0][i] = 0.f;
#pragma unroll
            for (int s = 0; s < 4; ++s) acc[0] = __builtin_amdgcn_mfma_f32_32x32x16_bf16(qa[s], kb[0][s], acc[0], 0, 0, 0);
            __builtin_amdgcn_sched_barrier(0);
#pragma unroll
            for (int k = 0; k < 8; ++k) {
                const int kt = 8 * c8 + k;
                if (k + 2 < 8) {
#pragma unroll
                    for (int s = 0; s < 4; ++s) kb[k & 1][s] = *(const LAS bf16x8*)(cb + (k + 2) * 4096 + kof[s]);
                }
                if (k + 1 < 8) {
#pragma unroll
                    for (int i = 0; i < 16; ++i) acc[(k + 1) & 1][i] = 0.f;
#pragma unroll
                    for (int s = 0; s < 4; ++s) acc[(k + 1) & 1] = __builtin_amdgcn_mfma_f32_32x32x16_bf16(qa[s], kb[(k + 1) & 1][s], acc[(k + 1) & 1], 0, 0, 0);
                }
                __builtin_amdgcn_sched_barrier(0);
                float sa = 0.f, sb = 0.f, sa1 = 0.f, sb1 = 0.f;
#pragma unroll
                for (int j = 0; j < 4; ++j) {
                    const int ra = __float_as_int(acc[k & 1][j]), rb = __float_as_int(acc[k & 1][8 + j]), rc = __float_as_int(acc[k & 1][4 + j]), rd = __float_as_int(acc[k & 1][12 + j]);
                    const float fa = __int_as_float(ra > 0 ? ra : 0), fb = __int_as_float(rb > 0 ? rb : 0), fc = __int_as_float(rc > 0 ? rc : 0), fd = __int_as_float(rd > 0 ? rd : 0);
                    asm("v_fmac_f32 %0, %1, %2" : "+v"(sa) : "v"(fa), "v"(wA[j]));
                    asm("v_fmac_f32 %0, %1, %2" : "+v"(sb) : "v"(fb), "v"(wB[j]));
                    asm("v_fmac_f32 %0, %1, %2" : "+v"(sa1) : "v"(fc), "v"(wA[4 + j]));
                    asm("v_fmac_f32 %0, %1, %2" : "+v"(sb1) : "v"(fd), "v"(wB[4 + j])); }
                sA[kt] = sa + sa1; sB[kt] = sb + sb1;
                __builtin_amdgcn_sched_barrier(0);
            }
            if (qb < 8 * c8 + 8) {
#pragma unroll
                for (int k = 0; k < 8; ++k) { const int kt = 8 * c8 + k; sA[kt] = (32 * kt <= dA) ? sA[kt] : -INFINITY; sB[kt] = (32 * kt <= dB) ? sB[kt] : -INFINITY; }
            }
        }
    }
#undef SEL_DMA_CHUNK
    float thrA = -3.0e38f, thrB = -3.0e38f;
    if (qb >= 8) {
        float mnA = sA[0], mnB = sB[0], mxA = sA[0], mxB = sB[0];
#pragma unroll
        for (int k = 1; k < 8; ++k) { mnA = fminf(mnA, sA[k]); mnB = fminf(mnB, sB[k]); }
#pragma unroll
        for (int c8 = 0; c8 < 8; ++c8) {
            if (8 * c8 <= qb) {
#pragma unroll
                for (int k = 0; k < 8; ++k) { mxA = fmaxf(mxA, sA[8 * c8 + k]); mxB = fmaxf(mxB, sB[8 * c8 + k]); }
            }
        }
        float loA = half_min(mnA, hh), loB = half_min(mnB, hh);
        float hiA = funkey(fkey(half_max(mxA, hh)) + 1u), hiB = funkey(fkey(half_max(mxB, hh)) + 1u);
        const float nv = (float)(32 * qb + 16);
        float gloA = nv - 256.5f, ghiA = -256.5f, gloB = gloA, ghiB = ghiA;
        int sdA = 0, sdB = 0;
        unsigned nloA = 0x40000000u, nhiA = 0u, nloB = 0x40000000u, nhiB = 0u;
        int stA = 0, stB = 0;
        bool dnA = false, dnB = false, spA = false, spB = false; float mxsA = 0.f, mxsB = 0.f;
        float c0A, c0B;
        { float s1a = 0.f, s2a = 0.f, s1b = 0.f, s2b = 0.f;
#pragma unroll
          for (int c8 = 0; c8 < 7; ++c8) {
              if (c8 < (qb >> 3)) {
#pragma unroll
                  for (int k = 0; k < 8; k += 4) { const float a = sA[8 * c8 + k], b2 = sB[8 * c8 + k]; s1a += a; s2a = fmaf(a, a, s2a); s1b += b2; s2b = fmaf(b2, b2, s2b); }
              }
          }
          s1a = half_fsum(s1a, hh); s2a = half_fsum(s2a, hh); s1b = half_fsum(s1b, hh); s2b = half_fsum(s2b, hh);
          const float rn = __builtin_amdgcn_rcpf((float)(64 * (qb >> 3)));
          const float muA = s1a * rn, muB = s1b * rn, sdA_ = __builtin_amdgcn_sqrtf(fmaxf(s2a * rn - muA * muA, 0.f)), sdB_ = __builtin_amdgcn_sqrtf(fmaxf(s2b * rn - muB * muB, 0.f));
          const float nA_ = (float)(32 * qb + 4 * wid + hh + 1), nB_ = nA_ + 2.f;
          const float zA = 0.4159f * __builtin_amdgcn_logf((nA_ - 256.f) * (1.f / 256.f)), zB = 0.4159f * __builtin_amdgcn_logf((nB_ - 256.f) * (1.f / 256.f));
          c0A = fmaf(zA, sdA_, muA); c0B = fmaf(zB, sdB_, muB); }
#pragma unroll 1
        for (int it = 0; it < 96; ++it) {
            float cA = sel_cand(loA, hiA, gloA, ghiA), cB = sel_cand(loB, hiB, gloB, ghiB);
            if (it == 0) { cA = (c0A > loA && c0A < hiA) ? c0A : cA; cB = (c0B > loB && c0B < hiB) ? c0B : cB; }
            cA = spA ? mxsA : cA; cB = spB ? mxsB : cB;
            unsigned pA = 0u, pB = 0u;
#pragma unroll
            for (int c8 = 0; c8 < 8; ++c8) {
                if (8 * c8 <= qb) {
                    unsigned ba = 0u, bb = 0u, ba2 = 0u, bb2 = 0u;
#pragma unroll
                    for (int k = 0; k < 8; k += 2) { float t0_, t1_, t2_, t3_;
                        asm("v_sub_f32 %4, %8, %12\n\tv_sub_f32 %5, %9, %13\n\tv_sub_f32 %6, %10, %12\n\tv_sub_f32 %7, %11, %13\n\t"
                            "v_alignbit_b32 %0, %0, %4, 31\n\tv_alignbit_b32 %1, %1, %5, 31\n\tv_alignbit_b32 %2, %2, %6, 31\n\tv_alignbit_b32 %3, %3, %7, 31"
                            : "+v"(ba), "+v"(bb), "+v"(ba2), "+v"(bb2), "=&v"(t0_), "=&v"(t1_), "=&v"(t2_), "=&v"(t3_)
                            : "v"(sA[8 * c8 + k]), "v"(sB[8 * c8 + k]), "v"(sA[8 * c8 + k + 1]), "v"(sB[8 * c8 + k + 1]), "v"(cA), "v"(cB)); }
                    pA += (unsigned)__builtin_popcount(ba) + (unsigned)__builtin_popcount(ba2); pB += (unsigned)__builtin_popcount(bb) + (unsigned)__builtin_popcount(bb2);
                }
            }
            const unsigned pk_ = half_sum(pA | (pB << 16), hh), tot_ = 256u * (unsigned)((qb >> 3) + 1);
            const unsigned nA = tot_ - (pk_ & 0xffffu), nB = tot_ - (pk_ >> 16);
            if (!dnA) {
                const float g = (float)nA - 256.5f; const unsigned w0_ = nloA - nhiA;
                if (nA == 256u || (spA && nA > 256u)) { loA = cA; dnA = true; }
                else if (nA > 256u) { loA = cA; nloA = nA; gloA = g; if (sdA > 0) ghiA *= 0.5f; sdA = 1; }
                else { hiA = cA; nhiA = nA; ghiA = g; if (sdA < 0) gloA *= 0.5f; sdA = -1; }
                stA = (nloA - nhiA == w0_) ? stA + 1 : 0;
                if (!dnA && fkey(hiA) - fkey(loA) <= 1u) dnA = true;
            }
            if (!dnB) {
                const float g = (float)nB - 256.5f; const unsigned w0_ = nloB - nhiB;
                if (nB == 256u || (spB && nB > 256u)) { loB = cB; dnB = true; }
                else if (nB > 256u) { loB = cB; nloB = nB; gloB = g; if (sdB > 0) ghiB *= 0.5f; sdB = 1; }
                else { hiB = cB; nhiB = nB; ghiB = g; if (sdB < 0) gloB *= 0.5f; sdB = -1; }
                stB = (nloB - nhiB == w0_) ? stB + 1 : 0;
                if (!dnB && fkey(hiB) - fkey(loB) <= 1u) dnB = true;
            }
            if (__all(dnA && dnB)) break;
            spA = false; spB = false;
            if (__any(!dnA && (stA >= SEL_STALL || nhiA >= 254u))) {
                float m = -INFINITY;
#pragma unroll
                for (int c8 = 0; c8 < 8; ++c8) {
                    if (8 * c8 <= qb) {
#pragma unroll
                        for (int k = 0; k < 8; ++k) { const float a = sA[8 * c8 + k]; m = fmaxf(m, a < hiA ? a : -INFINITY); }
                    }
                }
                mxsA = half_max(m, hh); spA = !dnA && (stA >= SEL_STALL || nhiA >= 254u); stA = spA ? 0 : stA;
            }
            if (__any(!dnB && (stB >= SEL_STALL || nhiB >= 254u))) {
                float m = -INFINITY;
#pragma unroll
                for (int c8 = 0; c8 < 8; ++c8) {
                    if (8 * c8 <= qb) {
#pragma unroll
                        for (int k = 0; k < 8; ++k) { const float a = sB[8 * c8 + k]; m = fmaxf(m, a < hiB ? a : -INFINITY); }
                    }
                }
                mxsB = half_max(m, hh); spB = !dnB && (stB >= SEL_STALL || nhiB >= 254u); stB = spB ? 0 : stB;
            }
        }
        thrA = loA; thrB = loB;
    }
    unsigned w0 = 0u, w1 = 0u, w2 = 0u, w3 = 0u;
    int lane2 = lane; asm volatile("" : "+v"(lane2));
#pragma unroll
    for (int c8 = 0; c8 < 8; ++c8) {
        if (8 * c8 <= qb) {
#pragma unroll
            for (int k = 0; k < 8; ++k) { const int kt = 8 * c8 + k;
                const unsigned long long bA = __ballot(sA[kt] >= thrA), bB = __ballot(sB[kt] >= thrB);
                const bool mine = (lane2 == kt);
                w0 = mine ? (unsigned)bA : w0; w1 = mine ? (unsigned)(bA >> 32) : w1; w2 = mine ? (unsigned)bB : w2; w3 = mine ? (unsigned)(bB >> 32) : w3; }
        }
    }
    GAS unsigned* mo = (GAS unsigned*)MASK + mb * 64 + lane;
    mo[0] = w0; mo[64] = w1; mo[128] = w2; mo[192] = w3;
}

__device__ __forceinline__ unsigned off_b(unsigned row, unsigned ch) { return 256u * row + 16u * (ch ^ (((row & 3u) << 2) | ((row >> 2) & 3u))); }
__device__ __forceinline__ s16x4 vtr(const LAS unsigned char* p) { typedef short v4i16_t __attribute__((ext_vector_type(4))); return __builtin_bit_cast(s16x4, __builtin_amdgcn_ds_read_tr16_b64_v4i16((LAS v4i16_t*)p)); }
template <int LAG  > __device__ __forceinline__ void attn_unit(LAS unsigned char* kbuf, const bf16* Z, const bf16* CK, const bf16* WUK, const bf16* WUV, const unsigned* MASK, bf16* OL, float gm_in, int b, int qb, int wid, int lane_in) {
    int lane = lane_in; asm volatile("" : "+v"(lane));
    const int r32 = lane & 31, hh = lane >> 5, head = wid;
    const size_t m = (size_t)b * T + 32 * qb + r32;
    const int lr = lane >> 4;
    const bf16* gsrc0 = CK + ((size_t)b * T + 32 * wid + lr) * 128;
    LAS unsigned char* ldst0 = kbuf + (32 * wid) * 256;
#define ATT_DMA_STAGE(st_) do { _Pragma("unroll") for (int i_ = 0; i_ < 8; ++i_) { const int ch_ = (lane & 15) ^ ((lr << 2) | (i_ & 3)); \
        __builtin_amdgcn_global_load_lds((const unsigned*)(gsrc0 + (size_t)(st_) * 256 * 128 + i_ * 4 * 128 + 8 * ch_), (LAS unsigned*)(ldst0 + ((st_) & 1) * 65536 + i_ * 1024), 16, 0, 0); } } while (0)
    bf16x8 qb_[4], wa_[16];
#pragma unroll
    for (int s = 0; s < 4; ++s) qb_[s] = *(const GAS bf16x8*)(Z + m * ZP + Z_Q + head * 64 + 16 * s + 8 * hh);
    { const bf16* wk = WUK + ((size_t)head * 16 * 64 + lane) * 8;
#pragma unroll
      for (int f = 0; f < 16; ++f) wa_[f] = *(const GAS bf16x8*)(wk + (size_t)f * 64 * 8); }
    asm volatile("s_waitcnt lgkmcnt(0)" ::: "memory"); __builtin_amdgcn_s_barrier(); asm volatile("" ::: "memory");
    ATT_DMA_STAGE(0);
    bf16x8 qf[8];
    {
#pragma unroll
      for (int rt = 0; rt < 4; ++rt) { f32x16 qa_;
#pragma unroll
          for (int i = 0; i < 16; ++i) qa_[i] = 0.f;
#pragma unroll
          for (int s = 0; s < 4; ++s) qa_ = __builtin_amdgcn_mfma_f32_32x32x16_bf16(wa_[4 * rt + s], qb_[s], qa_, 0, 0, 0);
#pragma unroll
          for (int s2 = 0; s2 < 2; ++s2) { u32x4 pw; pw.x = pk_bf16(qa_[8 * s2 + 0], qa_[8 * s2 + 1]); pw.y = pk_bf16(qa_[8 * s2 + 2], qa_[8 * s2 + 3]); pw.z = pk_bf16(qa_[8 * s2 + 4], qa_[8 * s2 + 5]); pw.w = pk_bf16(qa_[8 * s2 + 6], qa_[8 * s2 + 7]);
              qf[2 * rt + s2] = __builtin_bit_cast(bf16x8, pw); } } }
    const GAS unsigned* mrow = (const GAS unsigned*)MASK + m * 64;
    float mref;
    { const float gm = gm_in;
      float qn0 = 0.f, qn1 = 0.f, qn2 = 0.f, qn3 = 0.f;
#pragma unroll
      for (int s = 0; s < 8; ++s)
#pragma unroll
          for (int e = 0; e < 8; e += 4) { const float x0 = __uint_as_float(((unsigned)(unsigned short)qf[s][e]) << 16), x1 = __uint_as_float(((unsigned)(unsigned short)qf[s][e + 1]) << 16),
                                                     x2 = __uint_as_float(((unsigned)(unsigned short)qf[s][e + 2]) << 16), x3 = __uint_as_float(((unsigned)(unsigned short)qf[s][e + 3]) << 16);
              qn0 = fmaf(x0, x0, qn0); qn1 = fmaf(x1, x1, qn1); qn2 = fmaf(x2, x2, qn2); qn3 = fmaf(x3, x3, qn3); }
      float qn = (qn0 + qn1) + (qn2 + qn3);
      qn += shx(qn, 32, lane);
      mref = fminf(sqrtf(qn) * gm * (1.02f * 11.313708499f), 60.f); }
    const unsigned negm_bits = __float_as_uint(-mref);
    f32x16 zero16;
#pragma unroll
    for (int i = 0; i < 16; ++i) zero16[i] = 0.f;
    f32x16 o[4];
#pragma unroll
    for (int dt = 0; dt < 4; ++dt)
#pragma unroll
        for (int i = 0; i < 16; ++i) o[dt][i] = 0.f;
    float lrun = 0.f;
    const int ns = (qb + 8) >> 3;
    const unsigned q4 = (lane & 15) >> 2, p4 = lane & 3, blk = (lane >> 4) & 1;
    const unsigned fh = (unsigned)r32 & 3u, fl = ((unsigned)r32 >> 2) & 3u;
    const unsigned kl0 = 256u * (unsigned)r32 + 16u * (((unsigned)hh ^ fl) & 3u), kl1 = 256u * (unsigned)r32 + 16u * (((2u + (unsigned)hh) ^ fl) & 3u);
#define ATT_KA(s_) ((((s_) & 1) ? kl1 : kl0) + 64u * ((unsigned)((s_) >> 1) ^ fh))
    const unsigned vb = 256u * (4u * hh + q4) + 8u * (p4 & 1u), cl = 2u * blk + (p4 >> 1);
    const unsigned vlo0 = vb + 16u * ((cl ^ (unsigned)hh) & 3u), vlo1 = vb + 2048u + 16u * ((cl ^ (2u + (unsigned)hh)) & 3u);
    u32x4 mw0 = *(const GAS u32x4*)(mrow), mw1 = *(const GAS u32x4*)(mrow + 4);
    if (LAG) __builtin_amdgcn_s_setprio(1);
    for (int st = 0; st < ns; ++st) {
        asm volatile("s_waitcnt vmcnt(0) lgkmcnt(0)" ::: "memory"); __builtin_amdgcn_s_barrier(); asm volatile("" ::: "memory");
        if (st + 1 < ns) ATT_DMA_STAGE(st + 1);
        const LAS unsigned char* sb = kbuf + (st & 1) * 65536;
        const int klim = (st + 1 < ns) ? 8 : (qb & 7) + 1;
#define ATT_QK(S_, k_) do { bf16x8 kf_[2]; \
        _Pragma("unroll") for (int s_ = 0; s_ < 8; s_ += 2) { kf_[0] = *(const LAS bf16x8*)(sb + (k_) * 8192 + ATT_KA(s_)); kf_[1] = *(const LAS bf16x8*)(sb + (k_) * 8192 + ATT_KA(s_ + 1)); \
            S_ = __builtin_amdgcn_mfma_f32_32x32x16_bf16(kf_[0], qf[s_], S_, 0, 0, 0); S_ = __builtin_amdgcn_mfma_f32_32x32x16_bf16(kf_[1], qf[s_ + 1], S_, 0, 0, 0); } } while (0)
#define ATT_BIAS(S_, w_) do { const unsigned wsh_ = (w_) >> (4 * hh); _Pragma("unroll") for (int i_ = 0; i_ < 16; ++i_) { const int pos_ = (i_ & 3) + 8 * (i_ >> 2); \
            unsigned r_; asm("v_bfe_i32 %0, %1, %4, 1\n\tv_bfi_b32 %0, %0, %2, %3" : "=&v"(r_) : "v"(wsh_), "v"(negm_bits), "s"(0xf149f2cau), "n"(pos_)); S_[i_] = __uint_as_float(r_); } } while (0)
#define ATT_BAR_CORE() do { __builtin_amdgcn_sched_barrier(0); __builtin_amdgcn_s_barrier(); __builtin_amdgcn_sched_barrier(0); } while (0)
#define ATT_PIN_M() asm volatile("" : "+v"(S[0]), "+v"(S[1]), "+v"(o[0]), "+v"(o[1]), "+v"(o[2]), "+v"(o[3]) :: "memory")
#define ATT_PIN_V() asm volatile("" : "+v"(pf[0]), "+v"(pf[1]), "+v"(lrun) :: "memory")
#define ATT_SEG_BAR() do { asm volatile("" ::: "memory"); ATT_BAR_CORE(); asm volatile("" ::: "memory"); } while (0)
#define ATT_WORD(j_) ((j_) < 4 ? mw0[(j_) & 3] : mw1[(j_) & 3])
        if (LAG) ATT_SEG_BAR();
        f32x16 S[2];
        ATT_BIAS(S[0], mw0[0]); ATT_BIAS(S[1], mw0[1]);
        ATT_QK(S[0], 0);
        ATT_PIN_M(); ATT_BAR_CORE(); ATT_PIN_M();
#pragma unroll
        for (int k = 0; k < 8; ++k) {
            if (k >= klim) break;
            const LAS unsigned char* kb = sb + k * 8192;
            const int cur = k & 1, nxt = cur ^ 1;
            float ps = 0.f;
#pragma unroll
            for (int i = 0; i < 16; ++i) { S[cur][i] = __builtin_amdgcn_exp2f(S[cur][i]); ps += S[cur][i]; }
            lrun += ps;
            bf16x8 pf[2];
#pragma unroll
            for (int s = 0; s < 2; ++s) { u32x4 pw; pw.x = pk_bf16(S[cur][8 * s + 0], S[cur][8 * s + 1]); pw.y = pk_bf16(S[cur][8 * s + 2], S[cur][8 * s + 3]); pw.z = pk_bf16(S[cur][8 * s + 4], S[cur][8 * s + 5]); pw.w = pk_bf16(S[cur][8 * s + 6], S[cur][8 * s + 7]); pf[s] = __builtin_bit_cast(bf16x8, pw); }
            const unsigned wsh2 = (k + 2 < 8) ? (ATT_WORD(k + 2) >> (4 * hh)) : 0u;
            if (k == 3) mw0 = *(const GAS u32x4*)(mrow + 8 * (st + 1));
            if (k == 7) mw1 = *(const GAS u32x4*)(mrow + 8 * (st + 1) + 4);
            { bf16x8 ob[16];
              const int QN = (k < 7) ? 8 : 0, NOP = QN + 8; constexpr int AH = 4;
#define ATT_LD(i_) do { if ((i_) < QN) { ob[i_] = *(const LAS bf16x8*)(sb + (k + 1) * 8192 + ATT_KA(i_)); } \
                else { const unsigned j_ = (unsigned)((i_) - QN); \
                    const s16x4 lo_ = vtr(kb + 4096 * (j_ & 1u) + vlo0 + 64u * ((j_ >> 1) ^ q4)); const s16x4 hi_ = vtr(kb + 4096 * (j_ & 1u) + vlo1 + 64u * ((j_ >> 1) ^ q4)); \
                    ob[i_] = __builtin_shufflevector(lo_, hi_, 0, 1, 2, 3, 4, 5, 6, 7); } } while (0)
#define ATT_MM(i_) do { if ((i_) < QN) { S[nxt] = __builtin_amdgcn_mfma_f32_32x32x16_bf16(ob[i_], qf[(i_) < QN ? (i_) : 0], S[nxt], 0, 0, 0); } \
                else { const int j_ = (i_) - QN; o[j_ >> 1] = __builtin_amdgcn_mfma_f32_32x32x16_bf16(ob[i_], pf[j_ & 1], o[j_ >> 1], 0, 0, 0); } } while (0)
#define ATT_BIAS1(i_) do { const int pos_ = ((i_) & 3) + 8 * ((i_) >> 2); unsigned r_; \
                asm("v_bfe_i32 %0, %1, %4, 1\n\tv_bfi_b32 %0, %0, %2, %3" : "=&v"(r_) : "v"(wsh2), "v"(negm_bits), "s"(0xf149f2cau), "n"(pos_)); S[cur][i_] = __uint_as_float(r_); } while (0)
#pragma unroll
              for (int i = 0; i < AH; ++i) ATT_LD(i);
              ATT_PIN_V(); ATT_BAR_CORE(); ATT_PIN_V();
#pragma unroll
              for (int i = 0; i < NOP; ++i) { __builtin_amdgcn_sched_barrier(0); if (i + AH < NOP) ATT_LD(i + AH); ATT_MM(i); if (k + 2 < 8) ATT_BIAS1(i); }
#undef ATT_LD
#undef ATT_MM
#undef ATT_BIAS1
            }
            ATT_PIN_M(); ATT_BAR_CORE(); ATT_PIN_M();
        }
        if (!LAG) ATT_SEG_BAR();
#undef ATT_SEG_BAR
#undef ATT_BAR_CORE
#undef ATT_PIN_M
#undef ATT_WORD
#undef ATT_PIN_V
#undef ATT_QK
#undef ATT_BIAS
#undef ATT_KA
    }
#undef ATT_DMA_STAGE
    if (LAG) __builtin_amdgcn_s_setprio(0);
    lrun += shx(lrun, 32, lane);
    const float inv = 1.f / lrun;
    bf16x8 po[8];
#pragma unroll
    for (int dt = 0; dt < 4; ++dt)
#pragma unroll
        for (int s2 = 0; s2 < 2; ++s2) { u32x4 pw; pw.x = pk_bf16(o[dt][8 * s2 + 0] * inv, o[dt][8 * s2 + 1] * inv); pw.y = pk_bf16(o[dt][8 * s2 + 2] * inv, o[dt][8 * s2 + 3] * inv);
            pw.z = pk_bf16(o[dt][8 * s2 + 4] * inv, o[dt][8 * s2 + 5] * inv); pw.w = pk_bf16(o[dt][8 * s2 + 6] * inv, o[dt][8 * s2 + 7] * inv); po[2 * dt + s2] = __builtin_bit_cast(bf16x8, pw); }
    const bf16* wv = WUV + (((size_t)head * 2 * 8 * 32 + r32) * 2 + hh) * 8;
    bf16* orow = OL + m * 512 + head * 64;
#pragma unroll
    for (int rt = 0; rt < 2; ++rt) { f32x16 at;
#pragma unroll
        for (int i = 0; i < 16; ++i) at[i] = 0.f;
#pragma unroll
        for (int ks = 0; ks < 8; ++ks) { const bf16x8 wa = *(const GAS bf16x8*)(wv + (size_t)(rt * 8 + ks) * 32 * 2 * 8); at = __builtin_amdgcn_mfma_f32_32x32x16_bf16(wa, po[ks], at, 0, 0, 0); }
#pragma unroll
        for (int gp = 0; gp < 2; ++gp) { const int g0 = 2 * gp, g1 = 2 * gp + 1;
            const unsigned a0 = pk_bf16(at[4 * g0], at[4 * g0 + 1]), a1 = pk_bf16(at[4 * g0 + 2], at[4 * g0 + 3]), b0 = pk_bf16(at[4 * g1], at[4 * g1 + 1]), b1 = pk_bf16(at[4 * g1 + 2], at[4 * g1 + 3]);
            const auto s0 = __builtin_amdgcn_permlane32_swap(a0, b0, false, false), s1 = __builtin_amdgcn_permlane32_swap(a1, b1, false, false);
            u32x4 w; w.x = s0[0]; w.y = s1[0]; w.z = s0[1]; w.w = s1[1];
            *(GAS u32x4*)(orow + 32 * rt + 8 * (hh ? g1 : g0)) = w; } }
}

namespace pg8 {
struct EpiResidFinal {
    static constexpr bool PERM = true, AFTER_DRAIN = false;
    const bf16_t* X; int ldc; float* xs; unsigned* cnt; unsigned* bar; float* out; const float* g; LAS float* tab;
    __device__ __forceinline__ void operator()(const f32x4 (&acc)[2][2][4][2], const Unit& u, int wr, int wc, int fr, int fq) const {
        const int lane = fr + 16 * fq, wid = wr * 4 + wc;
        LAS float* P = tab; LAS float* S = tab + 1024; LAS unsigned* flag = (LAS unsigned*)(tab + 1280);
        const char* Xu = (const char*)(X + (size_t)(u.pm * BM + wr * 64) * ldc + u.pn * BM + wc * 32);
        const unsigned lo = (unsigned)(fr * ldc + 8 * fq) * 2u;
        u32x4 b2[2][4][2];
#pragma unroll
        for (int ai = 0; ai < 2; ++ai)
#pragma unroll
            for (int m = 0; m < 4; ++m)
#pragma unroll
                for (int bj = 0; bj < 2; ++bj) b2[ai][m][bj] = *(const u32x4*)(Xu + (size_t)((ai * HALF + m * 16) * ldc + bj * HALF) * 2 + lo);
        f32x4 xv[2][2][4][2];
#pragma unroll
        for (int ai = 0; ai < 2; ++ai) {
#pragma unroll
            for (int m = 0; m < 4; ++m) { float ss = 0.f;
#pragma unroll
                for (int bj = 0; bj < 2; ++bj) { const f32x4 a0 = acc[ai][bj][m][0] * 0.5f, a1 = acc[ai][bj][m][1] * 0.5f; const u32x4 bb = b2[ai][m][bj];
                    const float x0 = bf_lo(bb.x) + a0[0], x1 = bf_hi(bb.x) + a0[1], x2 = bf_lo(bb.y) + a0[2], x3 = bf_hi(bb.y) + a0[3];
                    const float x4 = bf_lo(bb.z) + a1[0], x5 = bf_hi(bb.z) + a1[1], x6 = bf_lo(bb.w) + a1[2], x7 = bf_hi(bb.w) + a1[3];
                    xv[ai][bj][m][0] = (f32x4){x0, x1, x2, x3}; xv[ai][bj][m][1] = (f32x4){x4, x5, x6, x7};
                    ss += ((x0 * x0 + x1 * x1) + (x2 * x2 + x3 * x3)) + ((x4 * x4 + x5 * x5) + (x6 * x6 + x7 * x7)); }
                ss += xlane(ss, 16, lane); ss += xlane(ss, 32, lane);
                if (fq == 0) P[(ai * HALF + wr * 64 + m * 16 + fr) * 4 + wc] = ss; }
            __builtin_amdgcn_sched_barrier(0);
        }
        asm volatile("s_waitcnt lgkmcnt(0)" ::: "memory"); __builtin_amdgcn_s_barrier(); asm volatile("" ::: "memory");
        f32x4 gv[2][2];
#pragma unroll
        for (int bj = 0; bj < 2; ++bj)
#pragma unroll
            for (int n = 0; n < 2; ++n) gv[bj][n] = *(const f32x4*)(g + u.pn * BM + bj * HALF + wc * 32 + 8 * fq + 4 * n);
        const int row = wid * 32 + (lane & 31);
        float* slot = xs + (size_t)(u.pm * BM + row) * 16;
        if (lane < 32) { const f32x4 p = *(const LAS f32x4*)(P + row * 4);
            __hip_atomic_store((unsigned*)(slot + u.pn), __float_as_uint((p[0] + p[1]) + (p[2] + p[3])), __ATOMIC_RELAXED, __HIP_MEMORY_SCOPE_AGENT); }
        asm volatile("s_waitcnt vmcnt(0)" ::: "memory");
        unsigned* cw = cnt + 64 * u.pm;
        if (lane == 0) (void)xb_add(cw, 1u);
        if (wid == 0) {
            XB_SPIN(xb_ld(cw) < 32u, bar);
            const bool dead = xb_ld(cw) < 32u || xb_ld(&bar[XB_TMO]) != 0u;
            __builtin_amdgcn_fence(__ATOMIC_ACQUIRE, "agent");
            if (lane == 0) flag[0] = dead ? 1u : 0u;
        }
        asm volatile("s_waitcnt vmcnt(0) lgkmcnt(0)" ::: "memory"); __builtin_amdgcn_s_barrier(); asm volatile("" ::: "memory");
        const bool bad = flag[0] != 0u;
        if (lane < 32) { float t = 0.f;
#pragma unroll
            for (int q = 0; q < 4; ++q) t += __uint_as_float(__hip_atomic_load((unsigned*)(slot + q), __ATOMIC_RELAXED, __HIP_MEMORY_SCOPE_AGENT));
            S[row] = 1.f / sqrtf(t * (1.f / 1024.f) + 1e-6f); }
        asm volatile("s_waitcnt vmcnt(0) lgkmcnt(0)" ::: "memory"); __builtin_amdgcn_s_barrier(); asm volatile("" ::: "memory");
        const float qnan = __builtin_nanf("");
        float* Ou = out + (size_t)(u.pm * BM + wr * 64 + fr) * ldc + u.pn * BM + wc * 32 + 8 * fq;
#pragma unroll
        for (int ai = 0; ai < 2; ++ai)
#pragma unroll
            for (int m = 0; m < 4; ++m) { float rs = S[ai * HALF + wr * 64 + m * 16 + fr]; if (bad) rs = qnan;
#pragma unroll
                for (int bj = 0; bj < 2; ++bj)
#pragma unroll
                    for (int n = 0; n < 2; ++n) *(f32x4*)(Ou + (size_t)(ai * HALF + m * 16) * ldc + bj * HALF + 4 * n) = xv[ai][bj][m][n] * rs * gv[bj][n]; }
    }
};
}

__device__ __forceinline__ cargs_t kargs() { cargs_t p = (cargs_t)__builtin_amdgcn_kernarg_segment_ptr(); asm volatile("" : "+s"(p)); return p; }
__device__ __forceinline__ int lane_id() { unsigned z = 0u; asm volatile("" : "+v"(z)); int v = (int)__builtin_amdgcn_mbcnt_hi(~0u, __builtin_amdgcn_mbcnt_lo(~0u, z)); asm volatile("" : "+v"(v)); return v; }
__global__ void __launch_bounds__(NWAVES * 64, 2) fwd(Args args_unused) {
    extern __shared__ __attribute__((aligned(16))) unsigned char lds[];
    Frame F;
    F.lds = (LAS unsigned char*)lds;
    F.MISC = (volatile LAS unsigned*)(F.lds + MISC_OFF);
    F.wave = __builtin_amdgcn_readfirstlane((int)threadIdx.x >> 6);
    F.G = gridDim.x; { const int bx = blockIdx.x; F.vcu = (F.G % 8 == 0) ? (bx % 8) * (F.G / 8) + bx / 8 : bx; }
    F.ctl = (gu32*)(kargs()->ws + WS_CTL);
    for (int u = threadIdx.x; u < (LDS_BYTES - LDSCTL_OFF) / 4; u += NWAVES * 64) ((LAS unsigned*)(F.lds + LDSCTL_OFF))[u] = 0u;
    __syncthreads();
    XcdBarrier bar = xcd_barrier_post((unsigned*)(F.ctl + CW_BAR), F.MISC + 8, (unsigned)F.wave);
#define GRID_BAR() xcd_barrier(bar)
    const bool grp_ok = (F.G == 256);
    { const unsigned g_ = (unsigned)blockIdx.x & 7u; (void)grp_barrier_post((unsigned*)(F.ctl + CW_BAR), (unsigned*)(F.ctl + CW_GBAR), F.MISC + 10, (unsigned)F.wave, g_, ((unsigned)F.G - g_ + 7u) >> 3); }
#define GROUP_BAR() do { if (grp_ok) { const unsigned g_ = (unsigned)blockIdx.x & 7u; GrpBarrier gb_; gb_.wv = (unsigned)F.wave; gb_.bar = (unsigned*)(F.ctl + CW_BAR); gb_.gb = (unsigned*)(F.ctl + CW_GBAR); \
        gb_.x = (unsigned)__builtin_amdgcn_readfirstlane((int)xb_xcc_id()); gb_.g = g_; gb_.gsize = ((unsigned)F.G - g_ + 7u) >> 3; gb_.st = F.MISC + 10; grp_barrier(gb_); } else xcd_barrier(bar); } while (0)
    const int gw = F.vcu * NWAVES + F.wave, NGW = F.G * NWAVES;
    const int g_rbase = grp_ok ? ((int)blockIdx.x & 7) * (M / 8) : 0, g_rcnt = grp_ok ? M / 8 : M, g_gw = grp_ok ? ((int)blockIdx.x >> 3) * NWAVES + F.wave : gw, g_ngw = grp_ok ? (F.G >> 3) * NWAVES : NGW;
#define WSP(off) (kargs()->ws + (off))

    {
        LAS float* scr = (LAS float*)(F.lds + RING_OFF + F.wave * 16384);
        const cargs_t a = kargs(); const int lane = lane_id();
        {
        for (int it = sopq(gw); it < NL * I_LAYER; it += NGW) { int ln = lane; asm volatile("" : "+v"(ln)); prologue_item(a, it, scr, ln); }
        xr_init_phase(a->in[0], (bf16*)(a->ws + WS_XR), (float*)(a->ws + WS_SSQ), sopq(gw), NGW, lane_id());
        GRID_BAR(); }
    }
#define GEMM_PHASE(EPI_T, A_, B_, N_, K_, E_) GEMM_PHASE_L(EPI_T, A_, (K_), B_, N_, K_, E_)
#define GEMM_PHASE_L(EPI_T, A_, LDA_, B_, N_, K_, E_) do { const pg8::Gemm g_{(const pg8::bf16_t*)(A_), (const pg8::bf16_t*)(B_), M, (N_), (K_), (LDA_)}; pg8::StaticOrder S_; S_.init(M, (N_), F.G, (int)blockIdx.x); \
        pg8::gemm_phase<EPI_T, pg8::StaticOrder, true, true>(F.lds + RING_OFF, g_, S_, (E_), F.wave); } while (0)

#define GEMM_PHASE_RS(EPI_T, A_, B_, N_, K_, SSQ_, ...) do { const pg8::Gemm g_{(const pg8::bf16_t*)(A_), (const pg8::bf16_t*)(B_), M, (N_), (K_), (K_)}; pg8::StaticOrder S_; S_.init(M, (N_), F.G, (int)blockIdx.x); \
        rstab_fill(F.lds, S_, (SSQ_), F.wave * 64 + lane_id()); \
        const EPI_T E_{__VA_ARGS__, (const LAS float*)(F.lds + RSTAB_OFF), (const LAS unsigned char*)(F.lds + PMAP_OFF)}; \
        pg8::gemm_phase<EPI_T, pg8::StaticOrder, true, true>(F.lds + RING_OFF, g_, S_, E_, F.wave); } while (0)
    for (int fi = 0; fi < 2 * NL; ++fi) {
        const int l = fi >> 1; const bool second = (fi & 1) != 0;
        const size_t wlo = WS_W + (size_t)l * LW;
        { const cargs_t a = kargs(); GEMM_PHASE_RS(pg8::EpiSwiglu, a->ws + WS_XR, a->ws + wlo + (second ? O_WGU2 : O_WGU1), 2 * FF, D, (const float*)(a->ws + WS_SSQ), (pg8::bf16_t*)(a->ws + WS_ZA), ZP); GROUP_BAR(); }
        if (grp_ok && fi == 2 * NL - 1) {
          const cargs_t a = kargs(); const pg8::EpiResidFinal E{(const pg8::bf16_t*)(a->ws + WS_XR), D, (float*)(a->ws + WS_SSQ), (unsigned*)(F.ctl + CW_FIN), (unsigned*)(F.ctl + CW_BAR), a->out, a->in[19], (LAS float*)(F.lds + RSTAB_OFF)};
          GEMM_PHASE_L(pg8::EpiResidFinal, a->ws + WS_ZA, ZP, a->ws + wlo + O_WD2, D, FF, E); }
        else { const cargs_t a = kargs(); const pg8::EpiResid<1> E{(pg8::bf16_t*)(a->ws + WS_XR), D, (float*)(a->ws + WS_SSQ)}; GEMM_PHASE_L(pg8::EpiResid<1>, a->ws + WS_ZA, ZP, a->ws + wlo + (second ? O_WD2 : O_WD1), D, FF, E); GROUP_BAR(); }
        if (!second) {
            { const cargs_t a = kargs(); GEMM_PHASE_RS(pg8::EpiPlainBf16, a->ws + WS_XR, a->ws + wlo + O_WIN, ZN, D, (const float*)(a->ws + WS_SSQ), (pg8::bf16_t*)(a->ws + WS_ZA), ZP, (pg8::bf16_t*)(a->ws + WS_ZA) + ZA, ZP, ZA / 256); GROUP_BAR(); }
            { const cargs_t a = kargs(); const int lane = lane_id();
              prep_phase((const bf16*)(a->ws + WS_ZA), a->in[7] + (size_t)l * 128, (bf16*)(a->ws + WS_CK), (bf16*)(a->ws + WS_PO), sopq(g_rbase), sopq(g_rcnt), sopq(g_gw), sopq(g_ngw), lane);
              {
              int b, qb; for (int i = 0; mix_unit(i, F.vcu, F.G, b, qb); ++i) select_unit(F.lds + RING_OFF, (const bf16*)(a->ws + WS_ZA), (unsigned*)(a->ws + WS_MASK), b, qb, F.wave, lane); }
              asm volatile("s_waitcnt vmcnt(0) lgkmcnt(0)" ::: "memory"); __syncthreads();
              GROUP_BAR(); }
            { const cargs_t a = kargs(); const int tid = F.wave * 64 + lane_id();
              float gm_; { const float* gkv = a->in[7] + (size_t)l * 128; const int ln = tid & 63; gm_ = fmaxf(fabsf(gkv[ln]), fabsf(gkv[ln + 64]));
#pragma unroll
                for (int o = 1; o < 64; o <<= 1) gm_ = fmaxf(gm_, shx(gm_, o, ln)); }
              if (F.wave >= 4) { int b, qb; for (int i = 0; mix_unit(i, F.vcu, F.G, b, qb); ++i) attn_unit<1>(F.lds + RING_OFF, (const bf16*)(a->ws + WS_ZA), (const bf16*)(a->ws + WS_CK), (const bf16*)(a->ws + wlo + O_WUK), (const bf16*)(a->ws + wlo + O_WUV), (const unsigned*)(a->ws + WS_MASK), (bf16*)(a->ws + WS_OL), gm_, b, qb, F.wave, tid & 63); }
              else { int b, qb; for (int i = 0; mix_unit(i, F.vcu, F.G, b, qb); ++i) attn_unit<0>(F.lds + RING_OFF, (const bf16*)(a->ws + WS_ZA), (const bf16*)(a->ws + WS_CK), (const bf16*)(a->ws + wlo + O_WUK), (const bf16*)(a->ws + wlo + O_WUV), (const unsigned*)(a->ws + WS_MASK), (bf16*)(a->ws + WS_OL), gm_, b, qb, F.wave, tid & 63); }
              asm volatile("s_waitcnt vmcnt(0) lgkmcnt(0)" ::: "memory"); __syncthreads();
              GROUP_BAR(); }
            { const cargs_t a = kargs(); const pg8::EpiGate<false> E{(pg8::bf16_t*)(a->ws + WS_ZA), ZP, (const pg8::bf16_t*)(a->ws + WS_ZA) + ZA, ZP}; GEMM_PHASE(pg8::EpiGate<false>, a->ws + WS_OL, a->ws + wlo + O_WA, D, 512, E); }
            { const cargs_t a = kargs(); const pg8::EpiGate<true> E{(pg8::bf16_t*)(a->ws + WS_ZA), ZP, (const pg8::bf16_t*)(a->ws + WS_ZA) + ZA + 1024, ZP}; GEMM_PHASE(pg8::EpiGate<true>, a->ws + WS_PO, a->ws + wlo + O_WP, D, 512, E); GROUP_BAR(); }
            { const cargs_t a = kargs(); const pg8::EpiResid<0> E{(pg8::bf16_t*)(a->ws + WS_XR), D, (float*)(a->ws + WS_SSQ)}; GEMM_PHASE_L(pg8::EpiResid<0>, a->ws + WS_ZA, ZP, a->ws + wlo + O_WO, D, D, E); GROUP_BAR(); }
        }
    }
    if (!grp_ok) {
        const cargs_t a = kargs();
        const bool poison = __hip_atomic_load((gu32*)(F.ctl + CW_BAR + XB_TMO), RLX_AGENT) != 0u;
        final_norm_phase((const bf16*)(a->ws + WS_XR), a->out, a->in[19], sopq(g_rbase), sopq(g_rcnt), sopq(g_gw), sopq(g_ngw), lane_id(), poison);
    }
}

extern "C" void kernel_launch(void* const* d_in, const int* in_sizes, int n_in, void* d_out, int out_size, void* d_ws, size_t ws_size, hipStream_t stream) {
    static int grid = 0;
    if (grid == 0) {
        if (n_in != 20 || in_sizes[0] != M * D || out_size != M * D || ws_size < WS_END) { fprintf(stderr, "kernel_launch: unexpected shapes (n_in %d, in0 %d, out %d, ws %zu); nothing launched\n", n_in, n_in > 0 ? in_sizes[0] : -1, out_size, ws_size); grid = -1; return; }
        int dev = 0, cus = 0, per_cu = 0;
        if (hipGetDevice(&dev) != hipSuccess || hipDeviceGetAttribute(&cus, hipDeviceAttributeMultiprocessorCount, dev) != hipSuccess) { fprintf(stderr, "kernel_launch: device query failed\n"); grid = -1; return; }
        if (hipFuncSetAttribute((const void*)fwd, hipFuncAttributeMaxDynamicSharedMemorySize, LDS_BYTES) != hipSuccess) { fprintf(stderr, "kernel_launch: hipFuncSetAttribute failed\n"); grid = -1; return; }
        if (hipOccupancyMaxActiveBlocksPerMultiprocessor(&per_cu, (const void*)fwd, NWAVES * 64, LDS_BYTES) != hipSuccess || per_cu < 1)
            fprintf(stderr, "kernel_launch: note: occupancy query reports %d workgroups per CU\n", per_cu);
        (void)hipGetLastError();
        grid = cus;
    }
    if (grid < 0) return;
    if (hipMemsetAsync((char*)d_ws + WS_CTL, 0, CTL_ZERO_BYTES, stream) != hipSuccess) { fprintf(stderr, "kernel_launch: hipMemsetAsync failed\n"); return; }
    Args a{};
    for (int i = 0; i < 20; ++i) a.in[i] = (const float*)d_in[i];
    a.out = (float*)d_out; a.ws = (unsigned char*)d_ws;
    hipLaunchKernelGGL(fwd, dim3(grid), dim3(NWAVES * 64), LDS_BYTES, stream, a);
    const hipError_t le = hipPeekAtLastError();
    if (le != hipSuccess) fprintf(stderr, "kernel_launch: launch failed: %s\n", hipGetErrorName(le));
}
```
